# Optimizing an MI355X kernel written in HIP

```python
import jax, jax.numpy as jnp
from jax import lax
import numpy as np


D_MODEL = 1024
BATCH = 2
SEQ = 16384
DEPTH = 2

HEAD_DIM = 64
NSA_HEADS = D_MODEL // 128
NSA_KV_HEADS = 2
NSA_GROUP = NSA_HEADS // NSA_KV_HEADS
CMP_LEN = 32
CMP_STRIDE = 16
CMP_HIDDEN = 4 * HEAD_DIM
SLC_BLOCK = 64
SLC_TOPN = 16
WINDOW = 512
Q_BLOCK = 128
NSA_BRANCHES = 3
POOL_WINDOWS = (2, 4, 8, 16)
POOL_WIDTH = D_MODEL // 4
POOL_GROUP_DIM = POOL_WIDTH // 4
CONV_WIDTH = D_MODEL // 4
CONV_K = 3
N_BRANCHES = 3
NSA_Q_DIM = NSA_HEADS * HEAD_DIM
NSA_KV_DIM = 6 * NSA_KV_HEADS * HEAD_DIM
NSA_GATE_DIM = NSA_HEADS * NSA_BRANCHES
MERGE_GATE_DIM = N_BRANCHES * D_MODEL
IN_SIZES = (NSA_Q_DIM, NSA_KV_DIM, NSA_GATE_DIM, POOL_WIDTH, CONV_WIDTH, CONV_WIDTH, CONV_WIDTH, MERGE_GATE_DIM)
IN_DIM = NSA_Q_DIM + NSA_KV_DIM + NSA_GATE_DIM + POOL_WIDTH + 3 * CONV_WIDTH + MERGE_GATE_DIM
N_EXPERT_GROUPS = 4
EXPERTS_PER_GROUP = 8
N_EXPERTS = N_EXPERT_GROUPS * EXPERTS_PER_GROUP
EXPERT_TOP_K = 2
D_EXPERT = D_MODEL // 4

RMS_EPS = 1e-6
NEG_INF = -1e30
FORCE_SCORE = 1e30

kernel_name = 'nsa_pool_conv_hier_moe_hybrid'


def rms_norm(x, g):
    xf = x.astype(jnp.float32)
    y = xf * lax.rsqrt(jnp.mean(xf * xf, axis=-1, keepdims=True) + RMS_EPS)
    return (y * g.astype(jnp.float32)).astype(x.dtype)


def alibi_slopes(n_heads):
    return jnp.exp2(-8.0 * jnp.arange(1, n_heads + 1, dtype=jnp.float32) / n_heads)


def masked_softmax(s, mask):
    s = jnp.where(mask, s, NEG_INF)
    return jnp.where(mask, jax.nn.softmax(s, axis=-1), 0.0)


def compress_tokens(k, pe, w1, w2):
    B, T, G, Dh = k.shape
    n_sub = CMP_LEN // CMP_STRIDE
    n_cmp = T // CMP_STRIDE - n_sub + 1
    chunks = k.reshape(B, T // CMP_STRIDE, CMP_STRIDE, G, Dh)
    blocks = jnp.concatenate([chunks[:, i:i + n_cmp] for i in range(n_sub)], axis=2)
    blocks = blocks + pe[None, None, :, None, :]
    flat = blocks.transpose(0, 1, 3, 2, 4).reshape(B, n_cmp, G, CMP_LEN * Dh)
    return jax.nn.gelu(flat @ w1) @ w2


def nsa_mixer(q, kv, gate_logits, cmp_pe, cmp_w1, cmp_w2):
    B, T, _ = q.shape
    G, R, Dh = NSA_KV_HEADS, NSA_GROUP, HEAD_DIM
    q = q.reshape(B, T, G, R, Dh)
    kv = kv.reshape(B, T, 6, G, Dh)
    k_cmp = compress_tokens(kv[:, :, 0], cmp_pe[0], cmp_w1[0], cmp_w2[0])
    v_cmp = compress_tokens(kv[:, :, 1], cmp_pe[1], cmp_w1[1], cmp_w2[1])
    n_cmp = k_cmp.shape[1]
    cmp_end = (jnp.arange(n_cmp) * CMP_STRIDE + CMP_LEN - 1).astype(jnp.float32)
    n_slc = T // SLC_BLOCK
    n_sel = min(SLC_TOPN, n_slc)
    ratio = SLC_BLOCK // CMP_STRIDE
    lead = CMP_LEN // CMP_STRIDE - 1
    to_blocks = lambda a: a.reshape(B, n_slc, SLC_BLOCK, G, Dh).transpose(0, 3, 1, 2, 4)
    k_slc, v_slc = to_blocks(kv[:, :, 2]), to_blocks(kv[:, :, 3])
    pad = ((0, 0), (WINDOW, 0), (0, 0), (0, 0))
    k_win, v_win = jnp.pad(kv[:, :, 4], pad), jnp.pad(kv[:, :, 5], pad)
    gates = jax.nn.sigmoid(gate_logits).reshape(B, T, G, R, NSA_BRANCHES)
    slopes = alibi_slopes(NSA_HEADS).reshape(G, R)
    scale = HEAD_DIM ** -0.5
    b_ix = jnp.arange(B)[:, None, None, None]
    g_ix = jnp.arange(G)[None, :, None, None]
    blk_ids = jnp.arange(n_slc)
    n_qb = T // Q_BLOCK

    def block(args):
        qb, qq, gg = args
        t = qb * Q_BLOCK + jnp.arange(Q_BLOCK)
        tf = t.astype(jnp.float32)
        d_c = tf[:, None] - cmp_end[None, :]
        s = jnp.einsum('bqgrd,bcgd->bgrqc', qq, k_cmp).astype(jnp.float32) * scale - slopes[:, :, None, None] * d_c
        p_c = masked_softmax(s, d_c >= 0)
        o_c = jnp.einsum('bgrqc,bcgd->bqgrd', p_c.astype(v_cmp.dtype), v_cmp)
        imp = jnp.pad(p_c.sum(axis=2), ((0, 0), (0, 0), (0, 0), (lead, ratio * n_slc - n_cmp)))
        imp = sum(imp[..., o:o + ratio * n_slc:ratio] for o in range(ratio + lead))
        cur = t // SLC_BLOCK
        valid = blk_ids[None, :] <= cur[:, None]
        forced = (blk_ids[None, :] == 0) | (blk_ids[None, :] == cur[:, None]) | (blk_ids[None, :] == cur[:, None] - 1)
        score = jnp.where(forced, FORCE_SCORE, jnp.where(valid, imp, NEG_INF))
        _, idx = lax.top_k(score, n_sel)
        kb = k_slc[b_ix, g_ix, idx].reshape(B, G, Q_BLOCK, n_sel * SLC_BLOCK, Dh)
        vb = v_slc[b_ix, g_ix, idx].reshape(B, G, Q_BLOCK, n_sel * SLC_BLOCK, Dh)
        pos = (idx[..., None] * SLC_BLOCK + jnp.arange(SLC_BLOCK)).reshape(B, G, Q_BLOCK, n_sel * SLC_BLOCK)
        d_s = (t[:, None] - pos).astype(jnp.float32)
        s = jnp.einsum('bqgrd,bgqkd->bgrqk', qq, kb).astype(jnp.float32) * scale - slopes[None, :, :, None, None] * d_s[:, :, None]
        p_s = masked_softmax(s, (d_s >= 0)[:, :, None])
        o_s = jnp.einsum('bgrqk,bgqkd->bqgrd', p_s.astype(vb.dtype), vb)
        start = qb * Q_BLOCK
        kw = lax.dynamic_slice_in_dim(k_win, start, WINDOW + Q_BLOCK, axis=1)
        vw = lax.dynamic_slice_in_dim(v_win, start, WINDOW + Q_BLOCK, axis=1)
        pos_w = start - WINDOW + jnp.arange(WINDOW + Q_BLOCK)
        d_w = t[:, None] - pos_w[None, :]
        m_w = (pos_w[None, :] >= 0) & (d_w >= 0) & (d_w < WINDOW)
        s = jnp.einsum('bqgrd,bkgd->bgrqk', qq, kw).astype(jnp.float32) * scale - slopes[:, :, None, None] * d_w.astype(jnp.float32)
        p_w = masked_softmax(s, m_w)
        o_w = jnp.einsum('bgrqk,bkgd->bqgrd', p_w.astype(vw.dtype), vw)
        o = gg[..., 0:1] * o_c + gg[..., 1:2] * o_s + gg[..., 2:3] * o_w
        return o.reshape(B, Q_BLOCK, NSA_HEADS * Dh)

    qs = jnp.moveaxis(q.reshape(B, n_qb, Q_BLOCK, G, R, Dh), 1, 0)
    gs = jnp.moveaxis(gates.reshape(B, n_qb, Q_BLOCK, G, R, NSA_BRANCHES), 1, 0)
    out = lax.map(block, (jnp.arange(n_qb), qs, gs))
    return jnp.moveaxis(out, 0, 1).reshape(B, T, NSA_HEADS * Dh)


def pool_mixer(u, w_grp, scale):
    B, T, _ = u.shape
    ug = u.reshape(B, T, len(POOL_WINDOWS), POOL_GROUP_DIM).astype(jnp.float32)
    cs = jnp.pad(jnp.cumsum(ug, axis=1), ((0, 0), (1, 0), (0, 0), (0, 0)))
    t = jnp.arange(T)
    outs = []
    for g, w in enumerate(POOL_WINDOWS):
        lo = jnp.maximum(t + 1 - w, 0)
        cg = cs[:, :, g]
        cnt = (t + 1 - lo).astype(jnp.float32)
        outs.append((cg[:, 1:] - cg[:, lo]) / cnt[None, :, None] - ug[:, :, g])
    pooled = jnp.stack(outs, axis=2).astype(u.dtype)
    mixed = jnp.einsum('btgc,gcd->btgd', pooled, w_grp)
    return mixed.reshape(B, T, POOL_WIDTH) * scale


def short_conv_mixer(h, b_gate, c_gate, conv_w):
    z = c_gate * h
    y = lax.conv_general_dilated(z, conv_w[:, None, :], window_strides=(1,), padding=[(CONV_K - 1, 0)],
                                 dimension_numbers=('NWC', 'WIO', 'NWC'), feature_group_count=z.shape[-1])
    return b_gate * y


def hier_moe(x, wg, bg, we, be, w1, w3, w2):
    B, T, D = x.shape
    n_tok = B * T
    xt = x.reshape(n_tok, D)
    tok = jnp.arange(n_tok)
    g_logits = (xt @ wg + bg).astype(jnp.float32)
    g_prob = jax.nn.softmax(g_logits, axis=-1)
    g_sel = jnp.argmax(g_logits, axis=-1)
    e_logits = (xt @ we + be).astype(jnp.float32).reshape(n_tok, N_EXPERT_GROUPS, EXPERTS_PER_GROUP)
    e_in = e_logits[tok, g_sel]
    top_v, top_i = lax.top_k(e_in, EXPERT_TOP_K)
    top_w = jax.nn.softmax(top_v, axis=-1) * g_prob[tok, g_sel][:, None]
    expert_id = g_sel[:, None] * EXPERTS_PER_GROUP + top_i
    combine = jnp.einsum('nk,nke->ne', top_w, jax.nn.one_hot(expert_id, N_EXPERTS, dtype=jnp.float32)).astype(x.dtype)
    out = jnp.zeros_like(xt)
    for e in range(N_EXPERTS):
        h = jax.nn.silu(xt @ w1[e]) * (xt @ w3[e])
        out = out + combine[:, e:e + 1] * (h @ w2[e])
    return out.reshape(B, T, D)


def setup_inputs(seed: int = 0) -> dict:
    key = jax.random.key(seed)
    ks = jax.random.split(key, 24)
    nrm = lambda k, shape, s: jax.random.normal(k, shape, jnp.float32) * s
    L, D = DEPTH, D_MODEL
    return {
        'x': nrm(ks[0], (BATCH, SEQ, D), 1.0),
        'norm1_g': 1.0 + nrm(ks[1], (L, D), 0.02),
        'w_in': nrm(ks[2], (L, D, IN_DIM), D ** -0.5),
        'cmp_pe': nrm(ks[3], (L, 2, CMP_LEN, HEAD_DIM), 0.1),
        'cmp_w1': nrm(ks[4], (L, 2, CMP_LEN * HEAD_DIM, CMP_HIDDEN), (CMP_LEN * HEAD_DIM) ** -0.5),
        'cmp_w2': nrm(ks[5], (L, 2, CMP_HIDDEN, HEAD_DIM), CMP_HIDDEN ** -0.5),
        'w_nsa_proj': nrm(ks[6], (L, NSA_Q_DIM, D), NSA_Q_DIM ** -0.5),
        'pool_w': nrm(ks[7], (L, len(POOL_WINDOWS), POOL_GROUP_DIM, POOL_GROUP_DIM), POOL_GROUP_DIM ** -0.5),
        'pool_scale': 1.0 + nrm(ks[8], (L, POOL_WIDTH), 0.02),
        'w_pool_proj': nrm(ks[9], (L, POOL_WIDTH, D), POOL_WIDTH ** -0.5),
        'conv_w': nrm(ks[10], (L, CONV_K, CONV_WIDTH), CONV_K ** -0.5),
        'w_conv_proj': nrm(ks[11], (L, CONV_WIDTH, D), CONV_WIDTH ** -0.5),
        'w_o': nrm(ks[12], (L, D, D), D ** -0.5),
        'norm2_g': 1.0 + nrm(ks[13], (L, D), 0.02),
        'router_group_w': nrm(ks[14], (L, D, N_EXPERT_GROUPS), D ** -0.5),
        'router_group_b': nrm(ks[15], (L, N_EXPERT_GROUPS), 0.01),
        'router_expert_w': nrm(ks[16], (L, D, N_EXPERTS), D ** -0.5),
        'router_expert_b': nrm(ks[17], (L, N_EXPERTS), 0.01),
        'expert_w1': nrm(ks[18], (L, N_EXPERTS, D, D_EXPERT), D ** -0.5),
        'expert_w3': nrm(ks[19], (L, N_EXPERTS, D, D_EXPERT), D ** -0.5),
        'expert_w2': nrm(ks[20], (L, N_EXPERTS, D_EXPERT, D), D_EXPERT ** -0.5),
        'final_norm_g': 1.0 + nrm(ks[21], (D,), 0.02),
    }


def reference(x, norm1_g, w_in, cmp_pe, cmp_w1, cmp_w2, w_nsa_proj, pool_w, pool_scale, w_pool_proj,
              conv_w, w_conv_proj, w_o, norm2_g, router_group_w, router_group_b, router_expert_w,
              router_expert_b, expert_w1, expert_w3, expert_w2, final_norm_g):
    B, T, D = x.shape
    split_at = np.cumsum(IN_SIZES)[:-1].tolist()
    h = x
    for l in range(DEPTH):
        xn = rms_norm(h, norm1_g[l])
        proj = xn @ w_in[l]
        q, kv, nsa_g, pool_u, conv_h, conv_b, conv_c, merge_g = jnp.split(proj, split_at, axis=-1)
        y_nsa = nsa_mixer(q, kv, nsa_g, cmp_pe[l], cmp_w1[l], cmp_w2[l]) @ w_nsa_proj[l]
        y_pool = pool_mixer(pool_u, pool_w[l], pool_scale[l]) @ w_pool_proj[l]
        y_conv = short_conv_mixer(conv_h, conv_b, conv_c, conv_w[l]) @ w_conv_proj[l]
        mg = jax.nn.sigmoid(merge_g).reshape(B, T, N_BRANCHES, D)
        merged = mg[:, :, 0] * y_nsa + mg[:, :, 1] * y_pool + mg[:, :, 2] * y_conv
        h = h + merged @ w_o[l]
        h = h + hier_moe(rms_norm(h, norm2_g[l]), router_group_w[l], router_group_b[l],
                         router_expert_w[l], router_expert_b[l], expert_w1[l], expert_w3[l], expert_w2[l])
    return rms_norm(h, final_norm_g)
```

```cpp
#include <hip/hip_runtime.h>
#include <cstdio>
#include <cstdint>

#ifndef MK_PER_PHASE
#define MK_PER_PHASE 1
#endif

#define LAS __attribute__((address_space(3)))
typedef unsigned short bf16;
typedef short bf16x8 __attribute__((ext_vector_type(8)));
typedef float f32x4 __attribute__((ext_vector_type(4)));

constexpr int D = 1024, NB = 2, T = 16384, NTOK = NB * T, DEPTH = 2;
constexpr int IN_DIM = 5400, INP = 5632;
constexpr int NCMP = 1023, NSLC = 256;
constexpr float RMS_EPS = 1e-6f;
constexpr int NEXP = 32, DEXP = 256;
constexpr int MOE_ROWS = 2 * NTOK + NEXP * 256;
constexpr int TP = T + 64;

constexpr size_t MiB = 1u << 20;
constexpr size_t WS_CTL = 0, CTL_BYTES = MiB;
constexpr size_t RA = MiB;
constexpr size_t SZ_Q = (size_t)NTOK * 512 * 2, SZ_KVC = (size_t)8 * TP * 64 * 2, SZ_KV = (size_t)NB * 2 * T * 64 * 2, SZ_C256 = (size_t)NTOK * 256 * 2;
constexpr size_t OFF_Q = RA, OFF_KVC = OFF_Q + SZ_Q, OFF_KS = OFF_KVC + SZ_KVC, OFF_VS = OFF_KS + SZ_KV, OFF_KW = OFF_VS + SZ_KV, OFF_VW = OFF_KW + SZ_KV;
constexpr size_t OFF_PU = OFF_VW + SZ_KV, OFF_CH = OFF_PU + SZ_C256, OFF_CB = OFF_CH + SZ_C256, OFF_CC = OFF_CB + SZ_C256, OFF_NG = OFF_CC + SZ_C256;
constexpr size_t OFF_MG = OFF_NG + (size_t)NTOK * 32 * 4, RA_END = OFF_MG + (size_t)NTOK * 3072 * 2;
constexpr size_t OFF_MERGED = RA;
static_assert(OFF_MERGED + (size_t)NTOK * 1024 * 2 <= OFF_KW, "merged alias");
constexpr size_t OFF_XG = RA, OFF_HMID = OFF_XG + (size_t)MOE_ROWS * 1024 * 2, OFF_YS = OFF_HMID + (size_t)MOE_ROWS * 256 * 2, MOE_END = OFF_YS + (size_t)MOE_ROWS * 1024 * 2;
static_assert(MOE_END <= RA_END, "moe alias");
constexpr size_t RB = RA_END, OFF_XN = RB, OFF_O = RB, OFF_PM = OFF_O + SZ_Q, OFF_CV = OFF_PM + SZ_C256, RB_END = RB + (size_t)NTOK * 1024 * 2;
static_assert(OFF_CV + SZ_C256 <= RB_END, "rb alias");
constexpr size_t RW = RB_END;
constexpr size_t OFF_WIN = RW, OFF_CW1 = OFF_WIN + (size_t)INP * 1024 * 2, OFF_CW2 = OFF_CW1 + (size_t)2 * 256 * 2048 * 2, OFF_CB1 = OFF_CW2 + (size_t)2 * 128 * 256 * 2;
constexpr size_t OFF_WN = OFF_CB1 + 4096, OFF_WP = OFF_WN + (size_t)1024 * 512 * 2, OFF_WC = OFF_WP + (size_t)1024 * 256 * 2, OFF_WO = OFF_WC + (size_t)1024 * 256 * 2;
constexpr size_t OFF_W13 = OFF_WO + (size_t)1024 * 1024 * 2, OFF_W2 = OFF_W13 + (size_t)NEXP * 512 * 1024 * 2, RW_END = OFF_W2 + (size_t)NEXP * 1024 * 256 * 2;
constexpr size_t RS = RW_END;
constexpr size_t OFF_KC = RS, OFF_VC = OFF_KC + (size_t)4 * 1024 * 64 * 2, OFF_HC = OFF_VC + (size_t)4 * 1024 * 64 * 2;
constexpr size_t OFF_TOKE = OFF_HC + (size_t)8192 * 256 * 2, OFF_TOKC = OFF_TOKE + (size_t)NTOK * 8, OFF_TOKS = OFF_TOKC + (size_t)NTOK * 8, OFF_SLOTC = OFF_TOKS + (size_t)NTOK * 8;
constexpr size_t WS_END = OFF_SLOTC + (size_t)MOE_ROWS * 4;
static_assert(WS_END <= (size_t)512 * MiB, "workspace");
constexpr int CW_BAR = 4096;
constexpr int CW_CNT = 16384;
constexpr int CW_CUR = CW_CNT + DEPTH * 32;

constexpr int LDS_BYTES = 147456;
constexpr int MISC_OFF = 143360;

__device__ __forceinline__ float bf2f(unsigned u) { return __builtin_bit_cast(float, u << 16); }
__device__ __forceinline__ unsigned f2bf(float f) { unsigned u = __builtin_bit_cast(unsigned, f); return (u + 0x7fffu + ((u >> 16) & 1u)) >> 16; }
__device__ __forceinline__ unsigned pk2(float lo, float hi) { return f2bf(lo) | (f2bf(hi) << 16); }
__device__ __forceinline__ void st4bf(bf16* p, f32x4 v) { *(uint2*)p = make_uint2(pk2(v.x, v.y), pk2(v.z, v.w)); }
__device__ __forceinline__ f32x4 ld4bf(const bf16* p) { const uint2 u = *(const uint2*)p; return (f32x4){bf2f(u.x & 0xffffu), bf2f(u.x >> 16), bf2f(u.y & 0xffffu), bf2f(u.y >> 16)}; }
__device__ __forceinline__ float sigmoidf(float x) { return 1.f / (1.f + __expf(-x)); }
__device__ __forceinline__ float wave_sum(float v) {
#pragma unroll
    for (int o = 1; o < 64; o <<= 1) v += __shfl_xor(v, o);
    return v;
}
__device__ __forceinline__ float wave_max(float v) {
#pragma unroll
    for (int o = 1; o < 64; o <<= 1) v = fmaxf(v, __shfl_xor(v, o));
    return v;
}
#define WAVE_SYNC() asm volatile("s_waitcnt lgkmcnt(0)" ::: "memory")
__device__ __forceinline__ int otid() { int t = threadIdx.x; asm volatile("" : "+v"(t)); return t; }

#define XB_TMO      128
#define XB_XCNT(j)  (256  + 64 * (j))
#define XB_XSUB(j)  (1280 + 64 * (j))
#define XB_XGEN(j)  (2304 + 64 * (j))
#define XB_TOP      3328
#define XB_TOPGEN   3392
#define XCD_BAR_WORDS 3456
#define XB_SPIN_CAP (1u << 18)
__device__ __forceinline__ unsigned xb_ld(unsigned* p)              { return __hip_atomic_load(p, __ATOMIC_RELAXED, __HIP_MEMORY_SCOPE_AGENT); }
__device__ __forceinline__ unsigned xb_add(unsigned* p, unsigned v) { return __hip_atomic_fetch_add(p, v, __ATOMIC_RELAXED, __HIP_MEMORY_SCOPE_AGENT); }
__device__ __forceinline__ unsigned xb_xcc_id() { return (unsigned)__builtin_amdgcn_s_getreg((3 << 11) | 20) & 0xFu; }
#define XB_SPIN(cond, bar) do { unsigned _sp = 0; while (cond) { __builtin_amdgcn_s_sleep(1); \
    if ((++_sp & 255u) == 0u) { if (xb_ld(&(bar)[XB_TMO])) break; if (_sp > XB_SPIN_CAP) { atomicAdd(&(bar)[XB_TMO], 1u); break; } } } } while (0)
struct XcdBarrier { unsigned* bar; unsigned x; volatile LAS unsigned* st; };
__device__ __forceinline__ XcdBarrier xcd_barrier_post(unsigned* bar, volatile LAS unsigned* st) {
    XcdBarrier b; b.bar = bar; b.x = xb_xcc_id(); b.st = st;
    if (threadIdx.x == 0) (void)xb_add(&bar[XB_XCNT(b.x)], 1u);
    return b;
}
__device__ __forceinline__ void xcd_barrier_complete(unsigned* bar, unsigned x, unsigned& nloc, unsigned& nx) {
    const unsigned G = gridDim.x * gridDim.y * gridDim.z;
    unsigned sum, cnt, mine, sp = 0u;
    for (;;) {
        sum = 0u; cnt = 0u; mine = 0u;
#pragma unroll
        for (unsigned j = 0; j < 16; ++j) { const unsigned c = xb_ld(&bar[XB_XCNT(j)]); sum += c; cnt += (c > 0u) ? 1u : 0u; mine = (j == x) ? c : mine; }
        if (sum == G) break;
        __builtin_amdgcn_s_sleep(1);
        if ((++sp & 255u) == 0u) { if (xb_ld(&bar[XB_TMO])) break; if (sp > XB_SPIN_CAP) { atomicAdd(&bar[XB_TMO], 1u); break; } }
    }
    nloc = mine > 0u ? mine : 1u; nx = cnt > 0u ? cnt : 1u;
}
__device__ __forceinline__ void xcd_barrier(const XcdBarrier& b) {
    asm volatile("s_waitcnt vmcnt(0)" ::: "memory");
    __syncthreads();
    if (threadIdx.x == 0) {
        unsigned* bar = b.bar;
        __builtin_amdgcn_s_waitcnt(0);
        unsigned nloc = b.st[0], nx = b.st[1];
        if (nloc == 0u) { xcd_barrier_complete(bar, b.x, nloc, nx); b.st[0] = nloc; b.st[1] = nx; }
        const unsigned old = xb_add(&bar[XB_XSUB(b.x)], 1u);
        const unsigned gen = old / nloc;
        if (old + 1u == (gen + 1u) * nloc) {
            __builtin_amdgcn_fence(__ATOMIC_RELEASE, "agent");
            asm volatile("s_waitcnt vmcnt(0)" ::: "memory");
            const unsigned og = xb_add(&bar[XB_TOP], 1u);
            const unsigned tg = og / nx;
            if (og + 1u == (tg + 1u) * nx) xb_add(&bar[XB_TOPGEN], 1u);
            else XB_SPIN(xb_ld(&bar[XB_TOPGEN]) == tg, bar);
            __builtin_amdgcn_fence(__ATOMIC_ACQUIRE, "agent");
            xb_add(&bar[XB_XGEN(b.x)], 1u);
            asm volatile("s_waitcnt vmcnt(0)" ::: "memory");
        } else {
            XB_SPIN(xb_ld(&bar[XB_XGEN(b.x)]) == gen, bar);
            __builtin_amdgcn_fence(__ATOMIC_ACQUIRE, "agent");
            asm volatile("s_waitcnt vmcnt(0)" ::: "memory");
        }
    }
    __syncthreads();
}

struct Args { const float* in[22]; float* out; unsigned char* ws; int ph_lo, ph_hi; };
struct Frame {
    unsigned char* lds; unsigned char* ws; unsigned* ctl; float* out;
    const float* in[22];
    int tid, lane, wave, G;
};
#define WSP(T_, off) ((T_*)(F.ws + (off)))
__device__ __forceinline__ Frame launder(const Frame& F0) {
    Frame F = F0;
    asm volatile("" : "+v"(F.tid), "+v"(F.lane));
    return F;
}

__device__ __forceinline__ void gemm_tile_128(f32x4 (&acc)[4][2], const bf16* __restrict__ A, int lda, const bf16* __restrict__ B, int ldb, int K, unsigned char* lds) {
    bf16* As = (bf16*)lds; bf16* Bs = As + 128 * 40;
    const int tid = otid(), lane = tid & 63, wave = tid >> 6, wm = wave >> 2, wn = wave & 3;
    const int lr = tid >> 2, lk = (tid & 3) * 8, fr = lane & 15, fq = lane >> 4;
    const bf16* ap = A + (size_t)lr * lda + lk; const bf16* bp = B + (size_t)lr * ldb + lk;
    uint4 av = *(const uint4*)ap, bv = *(const uint4*)bp;
    for (int k0 = 0; k0 < K; k0 += 32) {
        __syncthreads();
        *(uint4*)(As + lr * 40 + lk) = av; *(uint4*)(Bs + lr * 40 + lk) = bv;
        __syncthreads();
        if (k0 + 32 < K) { av = *(const uint4*)(ap + k0 + 32); bv = *(const uint4*)(bp + k0 + 32); }
        bf16x8 af[4], bfr[2];
#pragma unroll
        for (int i = 0; i < 4; ++i) af[i] = *(const bf16x8*)(As + (wm * 64 + i * 16 + fr) * 40 + fq * 8);
#pragma unroll
        for (int j = 0; j < 2; ++j) bfr[j] = *(const bf16x8*)(Bs + (wn * 32 + j * 16 + fr) * 40 + fq * 8);
#pragma unroll
        for (int i = 0; i < 4; ++i)
#pragma unroll
            for (int j = 0; j < 2; ++j) acc[i][j] = __builtin_amdgcn_mfma_f32_16x16x32_bf16(bfr[j], af[i], acc[i][j], 0, 0, 0);
    }
}
#define ACC_ZERO(a) do { _Pragma("unroll") for (int _i = 0; _i < 4; ++_i) _Pragma("unroll") for (int _j = 0; _j < 2; ++_j) a[_i][_j] = (f32x4){0.f, 0.f, 0.f, 0.f}; } while (0)
#define TILE_FOREACH(acc, m0, n0, BODY) do { const int _t = otid(), _l = _t & 63, _w = _t >> 6; \
    _Pragma("unroll") for (int _i = 0; _i < 4; ++_i) _Pragma("unroll") for (int _j = 0; _j < 2; ++_j) { \
        const int ROW = (m0) + (_w >> 2) * 64 + _i * 16 + (_l & 15); const int COL = (n0) + (_w & 3) * 32 + _j * 16 + (_l >> 4) * 4; f32x4& V = acc[_i][_j]; BODY } } while (0)

__device__ __forceinline__ int map_row(int map, int n) {
    if (map == 0) return n;
    if (map == 1) {
        if (n < 1280) return n;
        if (n < 1304) return 2304 + (n - 1280);
        if (n < 1560) return 1280 + (n - 1304);
        if (n < 2328) return 1536 + (n - 1560);
        return 2560 + (n - 2328);
    }
    if (map == 2) return (n >> 7) * 256 + (n & 127);
    return (n >> 7) * 256 + 128 + (n & 127);
}
__device__ __forceinline__ void xpose_tile(const float* __restrict__ src, int K, int Ns, bf16* dst, int map, int k0, int n0, float* tile) {
    const int tid = otid();
    { const int nl = tid & 63, ks = tid >> 6, n = n0 + nl;
      for (int kk = ks; kk < 64; kk += 8) tile[kk * 65 + nl] = (n < Ns) ? src[(size_t)(k0 + kk) * Ns + n] : 0.f; }
    __syncthreads();
    { const int kl = tid & 63, ns = tid >> 6;
      for (int nn = ns; nn < 64; nn += 8) { const int n = n0 + nn; if (n < Ns) dst[(size_t)map_row(map, n) * K + k0 + kl] = (bf16)f2bf(tile[kl * 65 + nn]); } }
    __syncthreads();
}
__device__ __forceinline__ void xpose_matrix(const Frame& F, const float* src, int K, int Ns, bf16* dst, int map, int nbatch = 1, size_t sstride = 0, size_t dstride = 0) {
    const int nkt = K / 64, nnt = (Ns + 63) / 64, per = nkt * nnt;
    for (int it = blockIdx.x; it < per * nbatch; it += F.G) { const int bt = it / per, r = it % per;
        xpose_tile(src + (size_t)bt * sstride, K, Ns, dst + (size_t)bt * dstride, map, (r % nkt) * 64, (r / nkt) * 64, (float*)F.lds); }
}
__device__ __forceinline__ void phase_weights(const Frame& F0, int l) { const Frame F = launder(F0);
    bf16* WIN = WSP(bf16, OFF_WIN);
    for (size_t i = (size_t)blockIdx.x * 512 + F.tid; i < (size_t)(2560 - 2328) * 1024 / 2; i += (size_t)F.G * 512) ((unsigned*)(WIN + (size_t)2328 * 1024))[i] = 0u;
    for (size_t i = (size_t)blockIdx.x * 512 + F.tid; i < (size_t)2 * 64 * 256 / 2; i += (size_t)F.G * 512) WSP(unsigned, OFF_CW2)[(i / 8192) * 16384 + 8192 + (i % 8192)] = 0u;
    __syncthreads();
    xpose_matrix(F, F.in[2] + (size_t)l * 1024 * IN_DIM, 1024, IN_DIM, WIN, 1);
    for (int s = 0; s < 2; ++s) {
        xpose_matrix(F, F.in[4] + ((size_t)l * 2 + s) * 2048 * 256, 2048, 256, WSP(bf16, OFF_CW1) + (size_t)s * 256 * 2048, 0);
        xpose_matrix(F, F.in[5] + ((size_t)l * 2 + s) * 256 * 64, 256, 64, WSP(bf16, OFF_CW2) + (size_t)s * 128 * 256, 0);
    }
    xpose_matrix(F, F.in[6] + (size_t)l * 512 * 1024, 512, 1024, WSP(bf16, OFF_WN), 0);
    xpose_matrix(F, F.in[9] + (size_t)l * 256 * 1024, 256, 1024, WSP(bf16, OFF_WP), 0);
    xpose_matrix(F, F.in[11] + (size_t)l * 256 * 1024, 256, 1024, WSP(bf16, OFF_WC), 0);
    xpose_matrix(F, F.in[12] + (size_t)l * 1024 * 1024, 1024, 1024, WSP(bf16, OFF_WO), 0);
    xpose_matrix(F, F.in[18] + (size_t)l * NEXP * 1024 * 256, 1024, 256, WSP(bf16, OFF_W13), 2, NEXP, (size_t)1024 * 256, (size_t)512 * 1024);
    xpose_matrix(F, F.in[19] + (size_t)l * NEXP * 1024 * 256, 1024, 256, WSP(bf16, OFF_W13), 3, NEXP, (size_t)1024 * 256, (size_t)512 * 1024);
    xpose_matrix(F, F.in[20] + (size_t)l * NEXP * 256 * 1024, 256, 1024, WSP(bf16, OFF_W2), 0, NEXP, (size_t)256 * 1024, (size_t)1024 * 256);
    for (int it = blockIdx.x * 8 + F.wave; it < 8; it += F.G * 8) {
        const int s = it >> 2, j = (it & 3) * 64 + F.lane;
        const float* pe = F.in[3] + ((size_t)l * 2 + s) * 2048; const float* w1 = F.in[4] + ((size_t)l * 2 + s) * 2048 * 256;
        float a = 0.f;
        for (int k = 0; k < 2048; ++k) a += pe[k] * w1[(size_t)k * 256 + j];
        WSP(float, OFF_CB1)[s * 256 + j] = a;
    }
}

template <bool FINAL> __device__ __forceinline__ void phase_norm(const Frame& F0, int l, const float* g) { const Frame F = launder(F0);
    const int gw = blockIdx.x * 8 + F.wave, NGW = F.G * 8;
    const int* toks = WSP(int, OFF_TOKS); const bf16* ys = WSP(bf16, OFF_YS); bf16* xn = WSP(bf16, OFF_XN);
    for (int n = gw; n < NTOK; n += NGW) {
        f32x4 v[4]; float ss = 0.f;
        if (l == 0) {
            const f32x4* xr = (const f32x4*)(F.in[0] + (size_t)n * D) + F.lane;
#pragma unroll
            for (int j = 0; j < 4; ++j) v[j] = xr[64 * j];
        } else {
            const f32x4* hr = (const f32x4*)(F.out + (size_t)n * D) + F.lane;
            const int s0 = toks[n * 2], s1 = toks[n * 2 + 1];
            const bf16* y0 = ys + (size_t)s0 * D + F.lane * 4; const bf16* y1 = ys + (size_t)s1 * D + F.lane * 4;
#pragma unroll
            for (int j = 0; j < 4; ++j) v[j] = hr[64 * j] + ld4bf(y0 + 256 * j) + ld4bf(y1 + 256 * j);
        }
#pragma unroll
        for (int j = 0; j < 4; ++j) ss += (v[j].x * v[j].x + v[j].y * v[j].y) + (v[j].z * v[j].z + v[j].w * v[j].w);
        const float rs = 1.f / sqrtf(wave_sum(ss) * (1.f / D) + RMS_EPS);
        f32x4* orow = (f32x4*)(F.out + (size_t)n * D) + F.lane;
#pragma unroll
        for (int j = 0; j < 4; ++j) {
            const f32x4 gg = ((const f32x4*)g)[F.lane + 64 * j];
            const f32x4 y = v[j] * rs * gg;
            if (FINAL) orow[64 * j] = y;
            else { orow[64 * j] = v[j]; st4bf(xn + (size_t)n * D + F.lane * 4 + 256 * j, y); }
        }
    }
}

__device__ __forceinline__ void epi_inproj(const Frame& F, int row, int col, f32x4 v) {
    if (col < 512) { st4bf(WSP(bf16, OFF_Q) + (size_t)row * 512 + col, v); }
    else if (col < 1280) {
        const int c = col - 512, s = c >> 7, g = (c >> 6) & 1, d = c & 63, b = row >> 14, t = row & (T - 1);
        bf16* dst;
        if (s < 2) dst = WSP(bf16, OFF_KVC) + ((size_t)((b * 2 + g) * 2 + s) * TP + t) * 64 + d;
        else dst = WSP(bf16, OFF_KS + (size_t)(s - 2) * SZ_KV) + ((size_t)(b * 2 + g) * T + t) * 64 + d;
        st4bf(dst, v);
    }
    else if (col < 1536) { st4bf(WSP(bf16, OFF_PU) + (size_t)row * 256 + (col - 1280), v); }
    else if (col < 2304) { const int c = col - 1536; st4bf(WSP(bf16, OFF_CH + (size_t)(c >> 8) * SZ_C256) + (size_t)row * 256 + (c & 255), v); }
    else if (col < 2560) { const int c = col - 2304; if (c < 32) *(f32x4*)(WSP(float, OFF_NG) + (size_t)row * 32 + c) = (f32x4){sigmoidf(v.x), sigmoidf(v.y), sigmoidf(v.z), sigmoidf(v.w)}; }
    else { st4bf(WSP(bf16, OFF_MG) + (size_t)row * 3072 + (col - 2560), (f32x4){sigmoidf(v.x), sigmoidf(v.y), sigmoidf(v.z), sigmoidf(v.w)}); }
}
__device__ __forceinline__ void phase_inproj(const Frame& F0) { const Frame F = launder(F0);
    const bf16* XN = WSP(bf16, OFF_XN); const bf16* W = WSP(bf16, OFF_WIN);
    constexpr int NT = INP / 128, MT = NTOK / 128;
    for (int it = blockIdx.x; it < MT * NT; it += F.G) {
        const int mt = it / NT, nt = it % NT;
        f32x4 acc[4][2]; ACC_ZERO(acc);
        gemm_tile_128(acc, XN + (size_t)mt * 128 * D, D, W + (size_t)nt * 128 * D, D, D, F.lds);
        TILE_FOREACH(acc, mt * 128, nt * 128, { epi_inproj(F, ROW, COL, V); });
    }
}

__device__ __forceinline__ float gelu_tanh(float x) { const float u = 0.7978845608028654f * (x + 0.044715f * x * x * x); return 0.5f * x * (1.f + tanhf(u)); }
__device__ __forceinline__ void phase_cmp1(const Frame& F0) { const Frame F = launder(F0);
    const bf16* KVC = WSP(bf16, OFF_KVC); bf16* HC = WSP(bf16, OFF_HC); const float* cb1 = WSP(float, OFF_CB1);
    for (int it = blockIdx.x; it < 64 * 2; it += F.G) {
        const int mt = it >> 1, nt = it & 1, plane = mt >> 3, i0 = (mt & 7) * 128, s = plane & 1;
        f32x4 acc[4][2]; ACC_ZERO(acc);
        gemm_tile_128(acc, KVC + (size_t)plane * TP * 64 + (size_t)i0 * 1024, 1024, WSP(bf16, OFF_CW1) + (size_t)s * 256 * 2048 + (size_t)nt * 128 * 2048, 2048, 2048, F.lds);
        TILE_FOREACH(acc, mt * 128, nt * 128, {
            const f32x4 bb = *(const f32x4*)(cb1 + s * 256 + COL);
            st4bf(HC + (size_t)ROW * 256 + COL, (f32x4){gelu_tanh(V.x + bb.x), gelu_tanh(V.y + bb.y), gelu_tanh(V.z + bb.z), gelu_tanh(V.w + bb.w)}); });
    }
}
__device__ __forceinline__ void phase_cmp2(const Frame& F0) { const Frame F = launder(F0);
    const bf16* HC = WSP(bf16, OFF_HC);
    for (int it = blockIdx.x; it < 64; it += F.G) {
        const int mt = it, plane = mt >> 3, s = plane & 1, bg = plane >> 1;
        f32x4 acc[4][2]; ACC_ZERO(acc);
        gemm_tile_128(acc, HC + (size_t)mt * 128 * 256, 256, WSP(bf16, OFF_CW2) + (size_t)s * 128 * 256, 256, 256, F.lds);
        bf16* dst = WSP(bf16, s == 0 ? OFF_KC : OFF_VC) + (size_t)bg * 1024 * 64;
        TILE_FOREACH(acc, (mt & 7) * 128, 0, { if (COL < 64) { f32x4 o = V; if (ROW == 1023) o = o * 0.f; st4bf(dst + (size_t)ROW * 64 + COL, o); } });
    }
}

__device__ __forceinline__ void phase_poolconv(const Frame& F0, int l) { const Frame F = launder(F0);
    float* pw = (float*)F.lds;
    float* ps = (float*)(F.lds + 65536) + F.wave * 64;
    const float* pwg = F.in[7] + (size_t)l * 4 * 64 * 64;
    for (int i = F.tid; i < 4 * 64 * 64; i += 512) pw[i] = pwg[i];
    __syncthreads();
    const bf16* PU = WSP(bf16, OFF_PU); const bf16* CH = WSP(bf16, OFF_CH); const bf16* CBp = WSP(bf16, OFF_CB); const bf16* CC = WSP(bf16, OFF_CC);
    bf16* PM = WSP(bf16, OFF_PM); bf16* CV = WSP(bf16, OFF_CV);
    const float* pscale = F.in[8] + (size_t)l * 256; const float* cw = F.in[10] + (size_t)l * 3 * 256;
    for (int n = blockIdx.x * 8 + F.wave; n < NTOK; n += F.G * 8) {
        const int t = n & (T - 1);
#pragma unroll
        for (int g = 0; g < 4; ++g) {
            const int w = 2 << g, cnt = (t + 1 < w) ? (t + 1) : w;
            const float u0 = bf2f(PU[(size_t)n * 256 + g * 64 + F.lane]);
            float s = u0;
            for (int i = 1; i < cnt; ++i) s += bf2f(PU[(size_t)(n - i) * 256 + g * 64 + F.lane]);
            ps[F.lane] = s / (float)cnt - u0;
            WAVE_SYNC();
            float a = 0.f;
#pragma unroll 8
            for (int c = 0; c < 64; ++c) a += ps[c] * pw[(g * 64 + c) * 64 + F.lane];
            PM[(size_t)n * 256 + g * 64 + F.lane] = (bf16)f2bf(a * pscale[g * 64 + F.lane]);
            WAVE_SYNC();
        }
        {
            const int c0 = F.lane * 4; f32x4 y = {0.f, 0.f, 0.f, 0.f};
#pragma unroll
            for (int k = 0; k < 3; ++k) { const int tt = t - 2 + k; if (tt >= 0) { const size_t r = (size_t)(n - 2 + k) * 256 + c0;
                y += *(const f32x4*)(cw + k * 256 + c0) * ld4bf(CC + r) * ld4bf(CH + r); } }
            st4bf(CV + (size_t)n * 256 + c0, y * ld4bf(CBp + (size_t)n * 256 + c0));
        }
    }
}

__device__ __forceinline__ void dot4(const bf16* krow, const float* qs, float (&acc)[4]) {
#pragma unroll
    for (int c = 0; c < 8; ++c) {
        const uint4 kv = ((const uint4*)krow)[c];
        const float k0 = bf2f(kv.x & 0xffffu), k1 = bf2f(kv.x >> 16), k2 = bf2f(kv.y & 0xffffu), k3 = bf2f(kv.y >> 16), k4 = bf2f(kv.z & 0xffffu), k5 = bf2f(kv.z >> 16), k6 = bf2f(kv.w & 0xffffu), k7 = bf2f(kv.w >> 16);
#pragma unroll
        for (int r = 0; r < 4; ++r) { const float* q = qs + r * 64 + c * 8;
            acc[r] += (k0 * q[0] + k1 * q[1]) + (k2 * q[2] + k3 * q[3]) + (k4 * q[4] + k5 * q[5]) + (k6 * q[6] + k7 * q[7]); }
    }
}
__device__ __forceinline__ void softmax4(float* sc, int n, int lane) {
#pragma unroll
    for (int r = 0; r < 4; ++r) {
        float* s = sc + r * 1024; float m = -INFINITY;
        for (int c = lane; c < n; c += 64) m = fmaxf(m, s[c]);
        m = wave_max(m);
        float sum = 0.f;
        for (int c = lane; c < n; c += 64) { const float e = __expf(s[c] - m); s[c] = e; sum += e; }
        sum = wave_sum(sum);
        const float inv = 1.f / sum;
        for (int c = lane; c < n; c += 64) s[c] *= inv;
    }
}
__device__ __forceinline__ void phase_attn_valu(const Frame& F0) { const Frame F = launder(F0);
    float* sc = (float*)(F.lds + F.wave * 17472); float* qs = sc + 4096; int* sel = (int*)(qs + 256);
    const int lane = F.lane;
    const bf16* Q = WSP(bf16, OFF_Q); const float* NG = WSP(float, OFF_NG); bf16* O = WSP(bf16, OFF_O);
    for (int task = blockIdx.x * 8 + F.wave; task < 2 * NTOK; task += F.G * 8) {
        const int bg = task >> 14, t = task & (T - 1), b = bg >> 1, g = bg & 1, n = b * T + t;
        { const f32x4 q4 = ld4bf(Q + (size_t)n * 512 + g * 256 + lane * 4); *(f32x4*)(qs + lane * 4) = q4; }
        WAVE_SYNC();
        float slope[4];
#pragma unroll
        for (int r = 0; r < 4; ++r) slope[r] = exp2f(-(float)(g * 4 + r + 1));
        const int ncv = (t >= 31) ? ((t - 31) >> 4) + 1 : 0;
        const bf16* kc = WSP(bf16, OFF_KC) + (size_t)bg * 1024 * 64; const bf16* vc = WSP(bf16, OFF_VC) + (size_t)bg * 1024 * 64;
        for (int c = lane; c < ncv; c += 64) {
            float a[4] = {0.f, 0.f, 0.f, 0.f}; dot4(kc + (size_t)c * 64, qs, a);
            const float dist = (float)(t - (16 * c + 31));
#pragma unroll
            for (int r = 0; r < 4; ++r) sc[r * 1024 + c] = a[r] * 0.125f - slope[r] * dist;
        }
        WAVE_SYNC();
        float oc[4] = {0.f, 0.f, 0.f, 0.f};
        if (ncv > 0) {
            softmax4(sc, ncv, lane);
            WAVE_SYNC();
            for (int c = 0; c < ncv; ++c) { const float v = bf2f(vc[(size_t)c * 64 + lane]);
#pragma unroll
                for (int r = 0; r < 4; ++r) oc[r] += sc[r * 1024 + c] * v; }
            WAVE_SYNC();
            for (int c = lane; c < ncv; c += 64) sc[c] = (sc[c] + sc[1024 + c]) + (sc[2048 + c] + sc[3072 + c]);
        }
        WAVE_SYNC();
        const int cur = t >> 6;
        float val[4];
#pragma unroll
        for (int i = 0; i < 4; ++i) {
            const int j = lane + 64 * i; float imp = 0.f;
#pragma unroll
            for (int o = 0; o < 5; ++o) { const int c = 4 * j + o - 1; if (c >= 0 && c < ncv) imp += sc[c]; }
            const bool forced = (j == 0) || (j == cur) || (j == cur - 1), valid = (j <= cur);
            val[i] = forced ? 1e30f : (valid ? imp : -1e30f);
        }
        WAVE_SYNC();
        int nsel = 0;
        for (int it = 0; it < 16; ++it) {
            float bv = val[0]; int bj = lane;
#pragma unroll
            for (int i = 1; i < 4; ++i) if (val[i] > bv) { bv = val[i]; bj = lane + 64 * i; }
#pragma unroll
            for (int o = 1; o < 64; o <<= 1) { const float ov = __shfl_xor(bv, o); const int oj = __shfl_xor(bj, o); if (ov > bv || (ov == bv && oj < bj)) { bv = ov; bj = oj; } }
            if (bv < -1e29f) break;
            if (lane == 0) sel[nsel] = bj;
            ++nsel;
#pragma unroll
            for (int i = 0; i < 4; ++i) if (bj == lane + 64 * i) val[i] = -INFINITY;
        }
        WAVE_SYNC();
        const bf16* ks = WSP(bf16, OFF_KS) + (size_t)bg * T * 64; const bf16* vs = WSP(bf16, OFF_VS) + (size_t)bg * T * 64;
        for (int i = 0; i < nsel; ++i) {
            const int pos = sel[i] * 64 + lane;
            float a[4] = {0.f, 0.f, 0.f, 0.f}; dot4(ks + (size_t)pos * 64, qs, a);
            const float dist = (float)(t - pos);
#pragma unroll
            for (int r = 0; r < 4; ++r) sc[r * 1024 + i * 64 + lane] = (pos <= t) ? a[r] * 0.125f - slope[r] * dist : -INFINITY;
        }
        WAVE_SYNC();
        softmax4(sc, nsel * 64, lane);
        WAVE_SYNC();
        float os[4] = {0.f, 0.f, 0.f, 0.f};
        for (int i = 0; i < nsel; ++i) { const bf16* vb = vs + (size_t)sel[i] * 64 * 64 + lane;
            for (int k = 0; k < 64; ++k) { const float v = bf2f(vb[k * 64]);
#pragma unroll
                for (int r = 0; r < 4; ++r) os[r] += sc[r * 1024 + i * 64 + k] * v; } }
        WAVE_SYNC();
        const bf16* kw = WSP(bf16, OFF_KW) + (size_t)bg * T * 64; const bf16* vw = WSP(bf16, OFF_VW) + (size_t)bg * T * 64;
        const int lo = (t >= 511) ? t - 511 : 0, nk = t - lo + 1;
        for (int i = lane; i < nk; i += 64) {
            const int pos = lo + i;
            float a[4] = {0.f, 0.f, 0.f, 0.f}; dot4(kw + (size_t)pos * 64, qs, a);
            const float dist = (float)(t - pos);
#pragma unroll
            for (int r = 0; r < 4; ++r) sc[r * 1024 + i] = a[r] * 0.125f - slope[r] * dist;
        }
        WAVE_SYNC();
        softmax4(sc, nk, lane);
        WAVE_SYNC();
        float ow[4] = {0.f, 0.f, 0.f, 0.f};
        for (int i = 0; i < nk; ++i) { const float v = bf2f(vw[(size_t)(lo + i) * 64 + lane]);
#pragma unroll
            for (int r = 0; r < 4; ++r) ow[r] += sc[r * 1024 + i] * v; }
        WAVE_SYNC();
        const float* ng = NG + (size_t)n * 32 + g * 12;
#pragma unroll
        for (int r = 0; r < 4; ++r) O[(size_t)n * 512 + g * 256 + r * 64 + lane] = (bf16)f2bf(ng[r * 3] * oc[r] + ng[r * 3 + 1] * os[r] + ng[r * 3 + 2] * ow[r]);
    }
}

__device__ __forceinline__ void phase_merge(const Frame& F0) { const Frame F = launder(F0);
    const bf16* MG = WSP(bf16, OFF_MG); bf16* MERGED = WSP(bf16, OFF_MERGED);
    for (int it = blockIdx.x; it < (NTOK / 128) * 8; it += F.G) {
        const int mt = it >> 3, nt = it & 7;
        f32x4 outv[4][2]; ACC_ZERO(outv);
#pragma unroll
        for (int src = 0; src < 3; ++src) {
            const bf16* A = src == 0 ? WSP(bf16, OFF_O) : src == 1 ? WSP(bf16, OFF_PM) : WSP(bf16, OFF_CV);
            const bf16* B = src == 0 ? WSP(bf16, OFF_WN) : src == 1 ? WSP(bf16, OFF_WP) : WSP(bf16, OFF_WC);
            const int K = src == 0 ? 512 : 256;
            f32x4 acc[4][2]; ACC_ZERO(acc);
            gemm_tile_128(acc, A + (size_t)mt * 128 * K, K, B + (size_t)nt * 128 * K, K, K, F.lds);
            const int tq = otid(), l = tq & 63, w = tq >> 6;
#pragma unroll
            for (int i = 0; i < 4; ++i)
#pragma unroll
                for (int j = 0; j < 2; ++j) { const int row = mt * 128 + (w >> 2) * 64 + i * 16 + (l & 15), col = nt * 128 + (w & 3) * 32 + j * 16 + (l >> 4) * 4;
                    outv[i][j] += ld4bf(MG + (size_t)row * 3072 + src * 1024 + col) * acc[i][j]; }
        }
        TILE_FOREACH(outv, mt * 128, nt * 128, { st4bf(MERGED + (size_t)ROW * 1024 + COL, V); });
    }
}
__device__ __forceinline__ void phase_wo(const Frame& F0) { const Frame F = launder(F0);
    const bf16* MERGED = WSP(bf16, OFF_MERGED);
    for (int it = blockIdx.x; it < (NTOK / 128) * 8; it += F.G) {
        const int mt = it >> 3, nt = it & 7;
        f32x4 acc[4][2]; ACC_ZERO(acc);
        gemm_tile_128(acc, MERGED + (size_t)mt * 128 * 1024, 1024, WSP(bf16, OFF_WO) + (size_t)nt * 128 * 1024, 1024, 1024, F.lds);
        TILE_FOREACH(acc, mt * 128, nt * 128, { f32x4* p = (f32x4*)(F.out + (size_t)ROW * 1024 + COL); *p = *p + V; });
    }
}

__device__ __forceinline__ void phase_router(const Frame& F0, int l) { const Frame F = launder(F0);
    int* hist = (int*)F.lds;
    if (F.tid < 32) hist[F.tid] = 0;
    __syncthreads();
    const float* g2 = F.in[13] + (size_t)l * D; const float* wg = F.in[14] + (size_t)l * D * 4; const float* bgp = F.in[15] + (size_t)l * 4;
    const float* we = F.in[16] + (size_t)l * D * 32; const float* be = F.in[17] + (size_t)l * 32;
    bf16* xn = WSP(bf16, OFF_XN); int* toke = WSP(int, OFF_TOKE); float* tokc = WSP(float, OFF_TOKC);
    for (int n = blockIdx.x * 8 + F.wave; n < NTOK; n += F.G * 8) {
        f32x4 v[4]; float ss = 0.f;
        const f32x4* hr = (const f32x4*)(F.out + (size_t)n * D) + F.lane;
#pragma unroll
        for (int j = 0; j < 4; ++j) { v[j] = hr[64 * j]; ss += (v[j].x * v[j].x + v[j].y * v[j].y) + (v[j].z * v[j].z + v[j].w * v[j].w); }
        const float rs = 1.f / sqrtf(wave_sum(ss) * (1.f / D) + RMS_EPS);
        float gl[4] = {0.f, 0.f, 0.f, 0.f};
#pragma unroll
        for (int j = 0; j < 4; ++j) {
            v[j] = v[j] * rs * ((const f32x4*)g2)[F.lane + 64 * j];
            st4bf(xn + (size_t)n * D + F.lane * 4 + 256 * j, v[j]);
#pragma unroll
            for (int q = 0; q < 4; ++q) {
                const int k = F.lane * 4 + 256 * j + q; const float x = v[j][q];
                const f32x4 w4 = *(const f32x4*)(wg + (size_t)k * 4);
                gl[0] += x * w4.x; gl[1] += x * w4.y; gl[2] += x * w4.z; gl[3] += x * w4.w;
            }
        }
        int gs = 0;
#pragma unroll
        for (int i = 0; i < 4; ++i) gl[i] = wave_sum(gl[i]) + bgp[i];
        float gm = gl[0];
#pragma unroll
        for (int i = 1; i < 4; ++i) if (gl[i] > gm) { gm = gl[i]; gs = i; }
        float gsum = 0.f;
#pragma unroll
        for (int i = 0; i < 4; ++i) gsum += __expf(gl[i] - gm);
        const float gp = 1.f / gsum;
        gs = __builtin_amdgcn_readfirstlane(gs);
        float el[8] = {0.f, 0.f, 0.f, 0.f, 0.f, 0.f, 0.f, 0.f};
#pragma unroll
        for (int j = 0; j < 4; ++j)
#pragma unroll
            for (int q = 0; q < 4; ++q) {
                const int k = F.lane * 4 + 256 * j + q; const float x = v[j][q];
                const f32x4 u0 = *(const f32x4*)(we + (size_t)k * 32 + gs * 8), u1 = *(const f32x4*)(we + (size_t)k * 32 + gs * 8 + 4);
                el[0] += x * u0.x; el[1] += x * u0.y; el[2] += x * u0.z; el[3] += x * u0.w; el[4] += x * u1.x; el[5] += x * u1.y; el[6] += x * u1.z; el[7] += x * u1.w;
            }
        float v0 = -INFINITY, v1 = -INFINITY; int i0 = 0, i1 = 0;
#pragma unroll
        for (int i = 0; i < 8; ++i) {
            const float ev = wave_sum(el[i]) + be[gs * 8 + i];
            if (ev > v0) { v1 = v0; i1 = i0; v0 = ev; i0 = i; } else if (ev > v1) { v1 = ev; i1 = i; }
        }
        const float e1 = __expf(v1 - v0), w0 = 1.f / (1.f + e1), w1 = e1 * w0;
        if (F.lane == 0) {
            const int ea = gs * 8 + i0, eb = gs * 8 + i1;
            toke[n * 2] = ea; toke[n * 2 + 1] = eb; tokc[n * 2] = w0 * gp; tokc[n * 2 + 1] = w1 * gp;
            atomicAdd(&hist[ea], 1); atomicAdd(&hist[eb], 1);
        }
    }
    __syncthreads();
    if (F.tid < 32 && hist[F.tid]) atomicAdd(F.ctl + CW_CNT + l * 32 + F.tid, (unsigned)hist[F.tid]);
}

__device__ __forceinline__ void moe_offsets(const Frame& F, int l, int* off) {
    if (F.tid == 0) { int a = 0; for (int e = 0; e < NEXP; ++e) { off[e] = a; const int c = (int)__hip_atomic_load(F.ctl + CW_CNT + l * 32 + e, __ATOMIC_RELAXED, __HIP_MEMORY_SCOPE_AGENT); a += (c + 255) & ~255; } off[NEXP] = a; }
    __syncthreads();
}
__device__ __forceinline__ void phase_dispatch(const Frame& F0, int l) { const Frame F = launder(F0);
    int* off = (int*)F.lds; int* hist = off + 64; int* base = hist + 32; int* pslot = base + 32; int* ptok = pslot + 512;
    moe_offsets(F, l, off);
    const int* toke = WSP(int, OFF_TOKE); const float* tokc = WSP(float, OFF_TOKC); int* toks = WSP(int, OFF_TOKS); float* slotc = WSP(float, OFF_SLOTC);
    const bf16* xn = WSP(bf16, OFF_XN); bf16* xg = WSP(bf16, OFF_XG);
    for (int ch = blockIdx.x; ch < NTOK / 256; ch += F.G) {
        if (F.tid < 32) hist[F.tid] = 0;
        __syncthreads();
        const int pr = ch * 512 + F.tid, e = toke[pr];
        const int r = atomicAdd(&hist[e], 1);
        __syncthreads();
        if (F.tid < 32) base[F.tid] = hist[F.tid] ? (int)atomicAdd(F.ctl + CW_CUR + l * 32 + F.tid, (unsigned)hist[F.tid]) : 0;
        __syncthreads();
        const int slot = off[e] + base[e] + r;
        toks[pr] = slot; slotc[slot] = tokc[pr]; pslot[F.tid] = slot; ptok[F.tid] = pr >> 1;
        __syncthreads();
        for (int i = F.wave; i < 512; i += 8) {
            const uint4* s = (const uint4*)(xn + (size_t)ptok[i] * D) + F.lane; uint4* d = (uint4*)(xg + (size_t)pslot[i] * D) + F.lane;
            d[0] = s[0]; d[64] = s[64];
        }
        __syncthreads();
    }
}
__device__ __forceinline__ int moe_expert_of(const int* off, int row) { int e = 0;
#pragma unroll 1
    for (int i = 1; i < NEXP; ++i) if (row >= off[i]) e = i;
    return e; }
__device__ __forceinline__ float siluf(float x) { return x / (1.f + __expf(-x)); }
__device__ __forceinline__ void phase_moe1(const Frame& F0, int l) { const Frame F = launder(F0);
    int* off = (int*)(F.lds + 32768); moe_offsets(F, l, off);
    const bf16* xg = WSP(bf16, OFF_XG); bf16* hmid = WSP(bf16, OFF_HMID);
    const int ntile = off[NEXP] / 128;
    for (int it = blockIdx.x; it < ntile * 2; it += F.G) {
        const int rt = it >> 1, u = it & 1, e = moe_expert_of(off, rt * 128);
        const bf16* B = WSP(bf16, OFF_W13) + ((size_t)e * 512 + u * 256) * 1024;
        f32x4 a1[4][2], a3[4][2]; ACC_ZERO(a1); ACC_ZERO(a3);
        gemm_tile_128(a1, xg + (size_t)rt * 128 * 1024, 1024, B, 1024, 1024, F.lds);
        gemm_tile_128(a3, xg + (size_t)rt * 128 * 1024, 1024, B + (size_t)128 * 1024, 1024, 1024, F.lds);
#pragma unroll
        for (int i = 0; i < 4; ++i)
#pragma unroll
            for (int j = 0; j < 2; ++j) { const f32x4 x = a1[i][j], y = a3[i][j]; a1[i][j] = (f32x4){siluf(x.x) * y.x, siluf(x.y) * y.y, siluf(x.z) * y.z, siluf(x.w) * y.w}; }
        TILE_FOREACH(a1, rt * 128, u * 128, { st4bf(hmid + (size_t)ROW * 256 + COL, V); });
    }
}
__device__ __forceinline__ void phase_moe2(const Frame& F0, int l) { const Frame F = launder(F0);
    int* off = (int*)(F.lds + 32768); moe_offsets(F, l, off);
    const bf16* hmid = WSP(bf16, OFF_HMID); bf16* ys = WSP(bf16, OFF_YS); const float* slotc = WSP(float, OFF_SLOTC);
    const int ntile = off[NEXP] / 128;
    for (int it = blockIdx.x; it < ntile * 8; it += F.G) {
        const int rt = it >> 3, ct = it & 7, e = moe_expert_of(off, rt * 128);
        f32x4 acc[4][2]; ACC_ZERO(acc);
        gemm_tile_128(acc, hmid + (size_t)rt * 128 * 256, 256, WSP(bf16, OFF_W2) + ((size_t)e * 1024 + ct * 128) * 256, 256, 256, F.lds);
        TILE_FOREACH(acc, rt * 128, ct * 128, { st4bf(ys + (size_t)ROW * 1024 + COL, V * slotc[ROW]); });
    }
}

constexpr int PPL = 11;
constexpr int NPHASE = DEPTH * PPL + 1;
__global__ void __launch_bounds__(512, 2) nsa_fwd(Args args) {
    extern __shared__ __attribute__((aligned(16))) unsigned char lds[];
    Frame F;
    F.lds = lds; F.ws = args.ws; F.ctl = (unsigned*)(args.ws + WS_CTL); F.out = args.out;
#pragma unroll
    for (int i = 0; i < 22; ++i) F.in[i] = args.in[i];
    F.tid = threadIdx.x; F.lane = F.tid & 63; F.wave = __builtin_amdgcn_readfirstlane(F.tid >> 6); F.G = gridDim.x;
    volatile LAS unsigned* MISC = (volatile LAS unsigned*)((LAS unsigned char*)lds + MISC_OFF);
    if (F.tid < 32) MISC[F.tid] = 0u;
    __syncthreads();
    const int lo = args.ph_lo, hi = args.ph_hi;
    XcdBarrier bar; bar.bar = F.ctl + CW_BAR; bar.x = 0; bar.st = MISC + 8;
    if (hi - lo > 1) bar = xcd_barrier_post(F.ctl + CW_BAR, MISC + 8);
#ifndef ONLY
#define ONLY -1
#endif
#ifndef PMASK
#define PMASK 0xFFF
#endif
#define IN(k) (lo <= (k) && (k) < hi && ((PMASK >> ((k) == DEPTH * PPL ? 11 : (k) % PPL)) & 1))
#define SEAM(k) do { if (IN(k) && IN((k) + 1)) xcd_barrier(bar); else __syncthreads(); } while (0)
#pragma unroll 1
    for (int l = 0; l < DEPTH; ++l) {
        const int p0 = l * PPL;
        if (IN(p0 + 0)) { phase_weights(F, l); phase_norm<false>(F, l, F.in[1] + (size_t)l * D); } SEAM(p0 + 0);
        if (IN(p0 + 1)) { phase_inproj(F); } SEAM(p0 + 1);
        if (IN(p0 + 2)) { phase_cmp1(F); __syncthreads(); phase_poolconv(F, l); } SEAM(p0 + 2);
        if (IN(p0 + 3)) { phase_cmp2(F); } SEAM(p0 + 3);
        if (IN(p0 + 4)) { phase_attn_valu(F); } SEAM(p0 + 4);
        if (IN(p0 + 5)) { phase_merge(F); } SEAM(p0 + 5);
        if (IN(p0 + 6)) { phase_wo(F); } SEAM(p0 + 6);
        if (IN(p0 + 7)) { phase_router(F, l); } SEAM(p0 + 7);
        if (IN(p0 + 8)) { phase_dispatch(F, l); } SEAM(p0 + 8);
        if (IN(p0 + 9)) { phase_moe1(F, l); } SEAM(p0 + 9);
        if (IN(p0 + 10)) { phase_moe2(F, l); } SEAM(p0 + 10);
    }
    if (IN(DEPTH * PPL)) phase_norm<true>(F, DEPTH, F.in[21]);
#undef IN
#undef SEAM
}

extern "C" void kernel_launch(void* const* d_in, const int* in_sizes, int n_in, void* d_out, int out_size, void* d_ws, size_t ws_size, hipStream_t stream) {
    static int grid = 0;
    if (grid == 0) {
        if (n_in != 22 || out_size != NTOK * D || ws_size < WS_END) { fprintf(stderr, "kernel_launch: unexpected shapes (n_in %d out %d ws %zu, need %zu)\n", n_in, out_size, ws_size, (size_t)WS_END); grid = -1; return; }
        int dev = 0, cus = 0;
        if (hipGetDevice(&dev) != hipSuccess || hipDeviceGetAttribute(&cus, hipDeviceAttributeMultiprocessorCount, dev) != hipSuccess) { grid = -1; return; }
        if (hipFuncSetAttribute((const void*)nsa_fwd, hipFuncAttributeMaxDynamicSharedMemorySize, LDS_BYTES) != hipSuccess) { fprintf(stderr, "kernel_launch: hipFuncSetAttribute failed\n"); grid = -1; return; }
        int per_cu = 0;
        if (hipOccupancyMaxActiveBlocksPerMultiprocessor(&per_cu, (const void*)nsa_fwd, 512, LDS_BYTES) != hipSuccess || per_cu < 1) fprintf(stderr, "kernel_launch: occupancy query says %d\n", per_cu);
        (void)hipGetLastError();
        grid = cus;
    }
    if (grid < 0) return;
    (void)hipMemsetAsync((char*)d_ws + WS_CTL, 0, CTL_BYTES, stream);
    Args a{};
    for (int i = 0; i < 22; ++i) a.in[i] = (const float*)d_in[i];
    a.out = (float*)d_out; a.ws = (unsigned char*)d_ws;
#if MK_PER_PHASE
    for (int p = 0; p < NPHASE; ++p) { a.ph_lo = p; a.ph_hi = p + 1; hipLaunchKernelGGL(nsa_fwd, dim3(grid), dim3(512), LDS_BYTES, stream, a); }
#else
    a.ph_lo = 0; a.ph_hi = NPHASE;
    hipLaunchKernelGGL(nsa_fwd, dim3(grid), dim3(512), LDS_BYTES, stream, a);
#endif
}
```

```cpp
#include <hip/hip_runtime.h>
#include <cstdio>
#include <cstdint>

#ifndef MK_PER_PHASE
#define MK_PER_PHASE 0
#endif

#define LAS __attribute__((address_space(3)))
typedef unsigned short bf16;
typedef short bf16x8 __attribute__((ext_vector_type(8)));
typedef float f32x4 __attribute__((ext_vector_type(4)));

constexpr int D = 1024, NB = 2, T = 16384, NTOK = NB * T, DEPTH = 2;
constexpr int IN_DIM = 5400, INP = 5632;
constexpr int NCMP = 1023, NSLC = 256;
constexpr float RMS_EPS = 1e-6f;
constexpr int NEXP = 32, DEXP = 256;
constexpr int MOE_ROWS = 2 * NTOK + NEXP * 256;
constexpr int TP = T + 64;

constexpr size_t MiB = 1u << 20;
constexpr size_t WS_CTL = 0, CTL_BYTES = MiB;
constexpr size_t RA = MiB;
constexpr size_t SZ_Q = (size_t)NTOK * 512 * 2, SZ_KVC = (size_t)8 * TP * 64 * 2, SZ_KV = (size_t)NB * 2 * T * 64 * 2, SZ_C256 = (size_t)NTOK * 256 * 2;
constexpr size_t OFF_Q = RA, OFF_KVC = OFF_Q + SZ_Q, OFF_KS = OFF_KVC + SZ_KVC, OFF_VS = OFF_KS + SZ_KV, OFF_KW = OFF_VS + SZ_KV, OFF_VW = OFF_KW + SZ_KV;
constexpr size_t OFF_PU = OFF_VW + SZ_KV, OFF_CH = OFF_PU + SZ_C256, OFF_CB = OFF_CH + SZ_C256, OFF_CC = OFF_CB + SZ_C256, OFF_NG = OFF_CC + SZ_C256;
constexpr size_t OFF_MG = OFF_NG + (size_t)NTOK * 32 * 4, RA_END = OFF_MG + (size_t)NTOK * 3072 * 2;
constexpr size_t OFF_MERGED = RA;
static_assert(OFF_MERGED + (size_t)NTOK * 1024 * 2 <= OFF_KW, "merged alias");
constexpr size_t OFF_XG = RA, OFF_HMID = OFF_XG + (size_t)MOE_ROWS * 1024 * 2, OFF_YS = OFF_HMID + (size_t)MOE_ROWS * 256 * 2, MOE_END = OFF_YS + (size_t)MOE_ROWS * 1024 * 2;
static_assert(MOE_END <= RA_END, "moe alias");
constexpr size_t RB = RA_END, OFF_XN = RB, OFF_O = RB, OFF_PM = OFF_O + SZ_Q, OFF_CV = OFF_PM + SZ_C256, RB_END = RB + (size_t)NTOK * 1024 * 2;
static_assert(OFF_CV + SZ_C256 <= RB_END, "rb alias");
constexpr size_t RW = RB_END;
constexpr size_t OFF_WIN = RW, OFF_CW1 = OFF_WIN + (size_t)INP * 1024 * 2, OFF_CW2 = OFF_CW1 + (size_t)2 * 256 * 2048 * 2, OFF_CB1 = OFF_CW2 + (size_t)2 * 128 * 256 * 2;
constexpr size_t OFF_WN = OFF_CB1 + 4096, OFF_WP = OFF_WN + (size_t)1024 * 512 * 2, OFF_WC = OFF_WP + (size_t)1024 * 256 * 2, OFF_WO = OFF_WC + (size_t)1024 * 256 * 2;
constexpr size_t OFF_W13 = OFF_WO + (size_t)1024 * 1024 * 2, OFF_W2 = OFF_W13 + (size_t)NEXP * 512 * 1024 * 2, RW_END = OFF_W2 + (size_t)NEXP * 1024 * 256 * 2;
constexpr size_t RS = RW_END;
constexpr size_t OFF_KC = RS, OFF_VC = OFF_KC + (size_t)4 * 1024 * 64 * 2, OFF_HC = OFF_VC + (size_t)4 * 1024 * 64 * 2;
constexpr size_t OFF_TOKE = OFF_HC + (size_t)8192 * 256 * 2, OFF_TOKC = OFF_TOKE + (size_t)NTOK * 8, OFF_TOKS = OFF_TOKC + (size_t)NTOK * 8, OFF_SLOTC = OFF_TOKS + (size_t)NTOK * 8;
constexpr size_t WS_END = OFF_SLOTC + (size_t)MOE_ROWS * 4;
static_assert(WS_END <= (size_t)512 * MiB, "workspace");
constexpr int CW_BAR = 4096;
constexpr int CW_CNT = 16384;
constexpr int CW_CUR = CW_CNT + DEPTH * 32;

constexpr int LDS_BYTES = 147456;
constexpr int MISC_OFF = 143360;

__device__ __forceinline__ float bf2f(unsigned u) { return __builtin_bit_cast(float, u << 16); }
__device__ __forceinline__ unsigned f2bf(float f) { unsigned u = __builtin_bit_cast(unsigned, f); return (u + 0x7fffu + ((u >> 16) & 1u)) >> 16; }
__device__ __forceinline__ unsigned pk2(float lo, float hi) { return f2bf(lo) | (f2bf(hi) << 16); }
__device__ __forceinline__ void st4bf(bf16* p, f32x4 v) { *(uint2*)p = make_uint2(pk2(v.x, v.y), pk2(v.z, v.w)); }
__device__ __forceinline__ f32x4 ld4bf(const bf16* p) { const uint2 u = *(const uint2*)p; return (f32x4){bf2f(u.x & 0xffffu), bf2f(u.x >> 16), bf2f(u.y & 0xffffu), bf2f(u.y >> 16)}; }
__device__ __forceinline__ float sigmoidf(float x) { return 1.f / (1.f + __expf(-x)); }
__device__ __forceinline__ float wave_sum(float v) {
#pragma unroll
    for (int o = 1; o < 64; o <<= 1) v += __shfl_xor(v, o);
    return v;
}
__device__ __forceinline__ float wave_max(float v) {
#pragma unroll
    for (int o = 1; o < 64; o <<= 1) v = fmaxf(v, __shfl_xor(v, o));
    return v;
}
#define WAVE_SYNC() asm volatile("s_waitcnt lgkmcnt(0)" ::: "memory")
__device__ __forceinline__ int otid() { int t = threadIdx.x; asm volatile("" : "+v"(t)); return t; }

#define XB_TMO      128
#define XB_XCNT(j)  (256  + 64 * (j))
#define XB_XSUB(j)  (1280 + 64 * (j))
#define XB_XGEN(j)  (2304 + 64 * (j))
#define XB_TOP      3328
#define XB_TOPGEN   3392
#define XCD_BAR_WORDS 3456
#define XB_SPIN_CAP (1u << 18)
__device__ __forceinline__ unsigned xb_ld(unsigned* p)              { return __hip_atomic_load(p, __ATOMIC_RELAXED, __HIP_MEMORY_SCOPE_AGENT); }
__device__ __forceinline__ unsigned xb_add(unsigned* p, unsigned v) { return __hip_atomic_fetch_add(p, v, __ATOMIC_RELAXED, __HIP_MEMORY_SCOPE_AGENT); }
__device__ __forceinline__ unsigned xb_xcc_id() { return (unsigned)__builtin_amdgcn_s_getreg((3 << 11) | 20) & 0xFu; }
#define XB_SPIN(cond, bar) do { unsigned _sp = 0; while (cond) { __builtin_amdgcn_s_sleep(1); \
    if ((++_sp & 255u) == 0u) { if (xb_ld(&(bar)[XB_TMO])) break; if (_sp > XB_SPIN_CAP) { atomicAdd(&(bar)[XB_TMO], 1u); break; } } } } while (0)
struct XcdBarrier { unsigned* bar; unsigned x; volatile LAS unsigned* st; };
__device__ __forceinline__ XcdBarrier xcd_barrier_post(unsigned* bar, volatile LAS unsigned* st) {
    XcdBarrier b; b.bar = bar; b.x = xb_xcc_id(); b.st = st;
    if (threadIdx.x == 0) (void)xb_add(&bar[XB_XCNT(b.x)], 1u);
    return b;
}
__device__ __forceinline__ void xcd_barrier_complete(unsigned* bar, unsigned x, unsigned& nloc, unsigned& nx) {
    const unsigned G = gridDim.x * gridDim.y * gridDim.z;
    unsigned sum, cnt, mine, sp = 0u;
    for (;;) {
        sum = 0u; cnt = 0u; mine = 0u;
#pragma unroll
        for (unsigned j = 0; j < 16; ++j) { const unsigned c = xb_ld(&bar[XB_XCNT(j)]); sum += c; cnt += (c > 0u) ? 1u : 0u; mine = (j == x) ? c : mine; }
        if (sum == G) break;
        __builtin_amdgcn_s_sleep(1);
        if ((++sp & 255u) == 0u) { if (xb_ld(&bar[XB_TMO])) break; if (sp > XB_SPIN_CAP) { atomicAdd(&bar[XB_TMO], 1u); break; } }
    }
    nloc = mine > 0u ? mine : 1u; nx = cnt > 0u ? cnt : 1u;
}
__device__ __forceinline__ void xcd_barrier(const XcdBarrier& b) {
    asm volatile("s_waitcnt vmcnt(0)" ::: "memory");
    __syncthreads();
    if (threadIdx.x == 0) {
        unsigned* bar = b.bar;
        __builtin_amdgcn_s_waitcnt(0);
        unsigned nloc = b.st[0], nx = b.st[1];
        if (nloc == 0u) { xcd_barrier_complete(bar, b.x, nloc, nx); b.st[0] = nloc; b.st[1] = nx; }
        const unsigned old = xb_add(&bar[XB_XSUB(b.x)], 1u);
        const unsigned gen = old / nloc;
        if (old + 1u == (gen + 1u) * nloc) {
            __builtin_amdgcn_fence(__ATOMIC_RELEASE, "agent");
            asm volatile("s_waitcnt vmcnt(0)" ::: "memory");
            const unsigned og = xb_add(&bar[XB_TOP], 1u);
            const unsigned tg = og / nx;
            if (og + 1u == (tg + 1u) * nx) xb_add(&bar[XB_TOPGEN], 1u);
            else XB_SPIN(xb_ld(&bar[XB_TOPGEN]) == tg, bar);
            __builtin_amdgcn_fence(__ATOMIC_ACQUIRE, "agent");
            xb_add(&bar[XB_XGEN(b.x)], 1u);
            asm volatile("s_waitcnt vmcnt(0)" ::: "memory");
        } else {
            XB_SPIN(xb_ld(&bar[XB_XGEN(b.x)]) == gen, bar);
            __builtin_amdgcn_fence(__ATOMIC_ACQUIRE, "agent");
            asm volatile("s_waitcnt vmcnt(0)" ::: "memory");
        }
    }
    __syncthreads();
}

struct Args { const float* in[22]; float* out; unsigned char* ws; int ph_lo, ph_hi; };
struct Frame {
    unsigned char* lds; unsigned char* ws; unsigned* ctl; float* out;
    const float* in[22];
    int tid, lane, wave, G;
};
#define WSP(T_, off) ((T_*)(F.ws + (off)))
__device__ __forceinline__ Frame launder(const Frame& F0) {
    Frame F = F0;
    asm volatile("" : "+v"(F.tid), "+v"(F.lane));
    return F;
}

__device__ __forceinline__ void gemm_tile_128(f32x4 (&acc)[4][2], const bf16* __restrict__ A, int lda, const bf16* __restrict__ B, int ldb, int K, unsigned char* lds) {
    bf16* As = (bf16*)lds; bf16* Bs = As + 128 * 40;
    const int tid = otid(), lane = tid & 63, wave = tid >> 6, wm = wave >> 2, wn = wave & 3;
    const int lr = tid >> 2, lk = (tid & 3) * 8, fr = lane & 15, fq = lane >> 4;
    const bf16* ap = A + (size_t)lr * lda + lk; const bf16* bp = B + (size_t)lr * ldb + lk;
    uint4 av = *(const uint4*)ap, bv = *(const uint4*)bp;
    for (int k0 = 0; k0 < K; k0 += 32) {
        __syncthreads();
        *(uint4*)(As + lr * 40 + lk) = av; *(uint4*)(Bs + lr * 40 + lk) = bv;
        __syncthreads();
        if (k0 + 32 < K) { av = *(const uint4*)(ap + k0 + 32); bv = *(const uint4*)(bp + k0 + 32); }
        bf16x8 af[4], bfr[2];
#pragma unroll
        for (int i = 0; i < 4; ++i) af[i] = *(const bf16x8*)(As + (wm * 64 + i * 16 + fr) * 40 + fq * 8);
#pragma unroll
        for (int j = 0; j < 2; ++j) bfr[j] = *(const bf16x8*)(Bs + (wn * 32 + j * 16 + fr) * 40 + fq * 8);
#pragma unroll
        for (int i = 0; i < 4; ++i)
#pragma unroll
            for (int j = 0; j < 2; ++j) acc[i][j] = __builtin_amdgcn_mfma_f32_16x16x32_bf16(bfr[j], af[i], acc[i][j], 0, 0, 0);
    }
}
#define ACC_ZERO(a) do { _Pragma("unroll") for (int _i = 0; _i < 4; ++_i) _Pragma("unroll") for (int _j = 0; _j < 2; ++_j) a[_i][_j] = (f32x4){0.f, 0.f, 0.f, 0.f}; } while (0)
#define TILE_FOREACH(acc, m0, n0, BODY) do { const int _t = otid(), _l = _t & 63, _w = _t >> 6; \
    _Pragma("unroll") for (int _i = 0; _i < 4; ++_i) _Pragma("unroll") for (int _j = 0; _j < 2; ++_j) { \
        const int ROW = (m0) + (_w >> 2) * 64 + _i * 16 + (_l & 15); const int COL = (n0) + (_w & 3) * 32 + _j * 16 + (_l >> 4) * 4; f32x4& V = acc[_i][_j]; BODY } } while (0)

__device__ __forceinline__ int map_row(int map, int n) {
    if (map == 0) return n;
    if (map == 1) {
        if (n < 1280) return n;
        if (n < 1304) return 2304 + (n - 1280);
        if (n < 1560) return 1280 + (n - 1304);
        if (n < 2328) return 1536 + (n - 1560);
        return 2560 + (n - 2328);
    }
    if (map == 2) return (n >> 7) * 256 + (n & 127);
    return (n >> 7) * 256 + 128 + (n & 127);
}
__device__ __forceinline__ void xpose_tile(const float* __restrict__ src, int K, int Ns, bf16* dst, int map, int k0, int n0, float* tile) {
    const int tid = otid();
    { const int nl = tid & 63, ks = tid >> 6, n = n0 + nl;
      for (int kk = ks; kk < 64; kk += 8) tile[kk * 65 + nl] = (n < Ns) ? src[(size_t)(k0 + kk) * Ns + n] : 0.f; }
    __syncthreads();
    { const int kl = tid & 63, ns = tid >> 6;
      for (int nn = ns; nn < 64; nn += 8) { const int n = n0 + nn; if (n < Ns) dst[(size_t)map_row(map, n) * K + k0 + kl] = (bf16)f2bf(tile[kl * 65 + nn]); } }
    __syncthreads();
}
__device__ __forceinline__ void xpose_matrix(const Frame& F, const float* src, int K, int Ns, bf16* dst, int map, int nbatch = 1, size_t sstride = 0, size_t dstride = 0) {
    const int nkt = K / 64, nnt = (Ns + 63) / 64, per = nkt * nnt;
    for (int it = blockIdx.x; it < per * nbatch; it += F.G) { const int bt = it / per, r = it % per;
        xpose_tile(src + (size_t)bt * sstride, K, Ns, dst + (size_t)bt * dstride, map, (r % nkt) * 64, (r / nkt) * 64, (float*)F.lds); }
}
__device__ __forceinline__ void phase_weights(const Frame& F0, int l) { const Frame F = launder(F0);
    bf16* WIN = WSP(bf16, OFF_WIN);
    for (size_t i = (size_t)blockIdx.x * 512 + F.tid; i < (size_t)(2560 - 2328) * 1024 / 2; i += (size_t)F.G * 512) ((unsigned*)(WIN + (size_t)2328 * 1024))[i] = 0u;
    for (size_t i = (size_t)blockIdx.x * 512 + F.tid; i < (size_t)2 * 64 * 256 / 2; i += (size_t)F.G * 512) WSP(unsigned, OFF_CW2)[(i / 8192) * 16384 + 8192 + (i % 8192)] = 0u;
    __syncthreads();
    xpose_matrix(F, F.in[2] + (size_t)l * 1024 * IN_DIM, 1024, IN_DIM, WIN, 1);
    for (int s = 0; s < 2; ++s) {
        xpose_matrix(F, F.in[4] + ((size_t)l * 2 + s) * 2048 * 256, 2048, 256, WSP(bf16, OFF_CW1) + (size_t)s * 256 * 2048, 0);
        xpose_matrix(F, F.in[5] + ((size_t)l * 2 + s) * 256 * 64, 256, 64, WSP(bf16, OFF_CW2) + (size_t)s * 128 * 256, 0);
    }
    xpose_matrix(F, F.in[6] + (size_t)l * 512 * 1024, 512, 1024, WSP(bf16, OFF_WN), 0);
    xpose_matrix(F, F.in[9] + (size_t)l * 256 * 1024, 256, 1024, WSP(bf16, OFF_WP), 0);
    xpose_matrix(F, F.in[11] + (size_t)l * 256 * 1024, 256, 1024, WSP(bf16, OFF_WC), 0);
    xpose_matrix(F, F.in[12] + (size_t)l * 1024 * 1024, 1024, 1024, WSP(bf16, OFF_WO), 0);
    xpose_matrix(F, F.in[18] + (size_t)l * NEXP * 1024 * 256, 1024, 256, WSP(bf16, OFF_W13), 2, NEXP, (size_t)1024 * 256, (size_t)512 * 1024);
    xpose_matrix(F, F.in[19] + (size_t)l * NEXP * 1024 * 256, 1024, 256, WSP(bf16, OFF_W13), 3, NEXP, (size_t)1024 * 256, (size_t)512 * 1024);
    xpose_matrix(F, F.in[20] + (size_t)l * NEXP * 256 * 1024, 256, 1024, WSP(bf16, OFF_W2), 0, NEXP, (size_t)256 * 1024, (size_t)1024 * 256);
    for (int it = blockIdx.x * 8 + F.wave; it < 8; it += F.G * 8) {
        const int s = it >> 2, j = (it & 3) * 64 + F.lane;
        const float* pe = F.in[3] + ((size_t)l * 2 + s) * 2048; const float* w1 = F.in[4] + ((size_t)l * 2 + s) * 2048 * 256;
        float a = 0.f;
        for (int k = 0; k < 2048; ++k) a += pe[k] * w1[(size_t)k * 256 + j];
        WSP(float, OFF_CB1)[s * 256 + j] = a;
    }
}

template <bool FINAL> __device__ __forceinline__ void phase_norm(const Frame& F0, int l, const float* g) { const Frame F = launder(F0);
    const int gw = blockIdx.x * 8 + F.wave, NGW = F.G * 8;
    const int* toks = WSP(int, OFF_TOKS); const bf16* ys = WSP(bf16, OFF_YS); bf16* xn = WSP(bf16, OFF_XN);
    for (int n = gw; n < NTOK; n += NGW) {
        f32x4 v[4]; float ss = 0.f;
        if (l == 0) {
            const f32x4* xr = (const f32x4*)(F.in[0] + (size_t)n * D) + F.lane;
#pragma unroll
            for (int j = 0; j < 4; ++j) v[j] = xr[64 * j];
        } else {
            const f32x4* hr = (const f32x4*)(F.out + (size_t)n * D) + F.lane;
            const int s0 = toks[n * 2], s1 = toks[n * 2 + 1];
            const bf16* y0 = ys + (size_t)s0 * D + F.lane * 4; const bf16* y1 = ys + (size_t)s1 * D + F.lane * 4;
#pragma unroll
            for (int j = 0; j < 4; ++j) v[j] = hr[64 * j] + ld4bf(y0 + 256 * j) + ld4bf(y1 + 256 * j);
        }
#pragma unroll
        for (int j = 0; j < 4; ++j) ss += (v[j].x * v[j].x + v[j].y * v[j].y) + (v[j].z * v[j].z + v[j].w * v[j].w);
        const float rs = 1.f / sqrtf(wave_sum(ss) * (1.f / D) + RMS_EPS);
        f32x4* orow = (f32x4*)(F.out + (size_t)n * D) + F.lane;
#pragma unroll
        for (int j = 0; j < 4; ++j) {
            const f32x4 gg = ((const f32x4*)g)[F.lane + 64 * j];
            const f32x4 y = v[j] * rs * gg;
            if (FINAL) orow[64 * j] = y;
            else { orow[64 * j] = v[j]; st4bf(xn + (size_t)n * D + F.lane * 4 + 256 * j, y); }
        }
    }
}

__device__ __forceinline__ void epi_inproj(const Frame& F, int row, int col, f32x4 v) {
    if (col < 512) { st4bf(WSP(bf16, OFF_Q) + (size_t)row * 512 + col, v); }
    else if (col < 1280) {
        const int c = col - 512, s = c >> 7, g = (c >> 6) & 1, d = c & 63, b = row >> 14, t = row & (T - 1);
        bf16* dst;
        if (s < 2) dst = WSP(bf16, OFF_KVC) + ((size_t)((b * 2 + g) * 2 + s) * TP + t) * 64 + d;
        else dst = WSP(bf16, OFF_KS + (size_t)(s - 2) * SZ_KV) + ((size_t)(b * 2 + g) * T + t) * 64 + d;
        st4bf(dst, v);
    }
    else if (col < 1536) { st4bf(WSP(bf16, OFF_PU) + (size_t)row * 256 + (col - 1280), v); }
    else if (col < 2304) { const int c = col - 1536; st4bf(WSP(bf16, OFF_CH + (size_t)(c >> 8) * SZ_C256) + (size_t)row * 256 + (c & 255), v); }
    else if (col < 2560) { const int c = col - 2304; if (c < 32) *(f32x4*)(WSP(float, OFF_NG) + (size_t)row * 32 + c) = (f32x4){sigmoidf(v.x), sigmoidf(v.y), sigmoidf(v.z), sigmoidf(v.w)}; }
    else { st4bf(WSP(bf16, OFF_MG) + (size_t)row * 3072 + (col - 2560), (f32x4){sigmoidf(v.x), sigmoidf(v.y), sigmoidf(v.z), sigmoidf(v.w)}); }
}
__device__ __forceinline__ void phase_inproj(const Frame& F0) { const Frame F = launder(F0);
    const bf16* XN = WSP(bf16, OFF_XN); const bf16* W = WSP(bf16, OFF_WIN);
    constexpr int NT = INP / 128, MT = NTOK / 128;
    for (int it = blockIdx.x; it < MT * NT; it += F.G) {
        const int mt = it / NT, nt = it % NT;
        f32x4 acc[4][2]; ACC_ZERO(acc);
        gemm_tile_128(acc, XN + (size_t)mt * 128 * D, D, W + (size_t)nt * 128 * D, D, D, F.lds);
        TILE_FOREACH(acc, mt * 128, nt * 128, { epi_inproj(F, ROW, COL, V); });
    }
}

__device__ __forceinline__ float gelu_tanh(float x) { const float u = 0.7978845608028654f * (x + 0.044715f * x * x * x); return 0.5f * x * (1.f + tanhf(u)); }
__device__ __forceinline__ void phase_cmp1(const Frame& F0) { const Frame F = launder(F0);
    const bf16* KVC = WSP(bf16, OFF_KVC); bf16* HC = WSP(bf16, OFF_HC); const float* cb1 = WSP(float, OFF_CB1);
    for (int it = blockIdx.x; it < 64 * 2; it += F.G) {
        const int mt = it >> 1, nt = it & 1, plane = mt >> 3, i0 = (mt & 7) * 128, s = plane & 1;
        f32x4 acc[4][2]; ACC_ZERO(acc);
        gemm_tile_128(acc, KVC + (size_t)plane * TP * 64 + (size_t)i0 * 1024, 1024, WSP(bf16, OFF_CW1) + (size_t)s * 256 * 2048 + (size_t)nt * 128 * 2048, 2048, 2048, F.lds);
        TILE_FOREACH(acc, mt * 128, nt * 128, {
            const f32x4 bb = *(const f32x4*)(cb1 + s * 256 + COL);
            st4bf(HC + (size_t)ROW * 256 + COL, (f32x4){gelu_tanh(V.x + bb.x), gelu_tanh(V.y + bb.y), gelu_tanh(V.z + bb.z), gelu_tanh(V.w + bb.w)}); });
    }
}
__device__ __forceinline__ void phase_cmp2(const Frame& F0) { const Frame F = launder(F0);
    const bf16* HC = WSP(bf16, OFF_HC);
    for (int it = blockIdx.x; it < 64; it += F.G) {
        const int mt = it, plane = mt >> 3, s = plane & 1, bg = plane >> 1;
        f32x4 acc[4][2]; ACC_ZERO(acc);
        gemm_tile_128(acc, HC + (size_t)mt * 128 * 256, 256, WSP(bf16, OFF_CW2) + (size_t)s * 128 * 256, 256, 256, F.lds);
        bf16* dst = WSP(bf16, s == 0 ? OFF_KC : OFF_VC) + (size_t)bg * 1024 * 64;
        TILE_FOREACH(acc, (mt & 7) * 128, 0, { if (COL < 64) { f32x4 o = V; if (ROW == 1023) o = o * 0.f; st4bf(dst + (size_t)ROW * 64 + COL, o); } });
    }
}

__device__ __forceinline__ void phase_poolconv(const Frame& F0, int l) { const Frame F = launder(F0);
    float* pw = (float*)F.lds;
    float* ps = (float*)(F.lds + 65536) + F.wave * 64;
    const float* pwg = F.in[7] + (size_t)l * 4 * 64 * 64;
    for (int i = F.tid; i < 4 * 64 * 64; i += 512) pw[i] = pwg[i];
    __syncthreads();
    const bf16* PU = WSP(bf16, OFF_PU); const bf16* CH = WSP(bf16, OFF_CH); const bf16* CBp = WSP(bf16, OFF_CB); const bf16* CC = WSP(bf16, OFF_CC);
    bf16* PM = WSP(bf16, OFF_PM); bf16* CV = WSP(bf16, OFF_CV);
    const float* pscale = F.in[8] + (size_t)l * 256; const float* cw = F.in[10] + (size_t)l * 3 * 256;
    for (int n = blockIdx.x * 8 + F.wave; n < NTOK; n += F.G * 8) {
        const int t = n & (T - 1);
#pragma unroll
        for (int g = 0; g < 4; ++g) {
            const int w = 2 << g, cnt = (t + 1 < w) ? (t + 1) : w;
            const float u0 = bf2f(PU[(size_t)n * 256 + g * 64 + F.lane]);
            float s = u0;
            for (int i = 1; i < cnt; ++i) s += bf2f(PU[(size_t)(n - i) * 256 + g * 64 + F.lane]);
            ps[F.lane] = s / (float)cnt - u0;
            WAVE_SYNC();
            float a = 0.f;
#pragma unroll 8
            for (int c = 0; c < 64; ++c) a += ps[c] * pw[(g * 64 + c) * 64 + F.lane];
            PM[(size_t)n * 256 + g * 64 + F.lane] = (bf16)f2bf(a * pscale[g * 64 + F.lane]);
            WAVE_SYNC();
        }
        {
            const int c0 = F.lane * 4; f32x4 y = {0.f, 0.f, 0.f, 0.f};
#pragma unroll
            for (int k = 0; k < 3; ++k) { const int tt = t - 2 + k; if (tt >= 0) { const size_t r = (size_t)(n - 2 + k) * 256 + c0;
                y += *(const f32x4*)(cw + k * 256 + c0) * ld4bf(CC + r) * ld4bf(CH + r); } }
            st4bf(CV + (size_t)n * 256 + c0, y * ld4bf(CBp + (size_t)n * 256 + c0));
        }
    }
}

__device__ __forceinline__ void dot4(const bf16* krow, const float* qs, float (&acc)[4]) {
#pragma unroll
    for (int c = 0; c < 8; ++c) {
        const uint4 kv = ((const uint4*)krow)[c];
        const float k0 = bf2f(kv.x & 0xffffu), k1 = bf2f(kv.x >> 16), k2 = bf2f(kv.y & 0xffffu), k3 = bf2f(kv.y >> 16), k4 = bf2f(kv.z & 0xffffu), k5 = bf2f(kv.z >> 16), k6 = bf2f(kv.w & 0xffffu), k7 = bf2f(kv.w >> 16);
#pragma unroll
        for (int r = 0; r < 4; ++r) { const float* q = qs + r * 64 + c * 8;
            acc[r] += (k0 * q[0] + k1 * q[1]) + (k2 * q[2] + k3 * q[3]) + (k4 * q[4] + k5 * q[5]) + (k6 * q[6] + k7 * q[7]); }
    }
}
__device__ __forceinline__ void softmax4(float* sc, int n, int lane) {
#pragma unroll
    for (int r = 0; r < 4; ++r) {
        float* s = sc + r * 1024; float m = -INFINITY;
        for (int c = lane; c < n; c += 64) m = fmaxf(m, s[c]);
        m = wave_max(m);
        float sum = 0.f;
        for (int c = lane; c < n; c += 64) { const float e = __expf(s[c] - m); s[c] = e; sum += e; }
        sum = wave_sum(sum);
        const float inv = 1.f / sum;
        for (int c = lane; c < n; c += 64) s[c] *= inv;
    }
}
__device__ __forceinline__ void phase_attn_valu(const Frame& F0) { const Frame F = launder(F0);
    float* sc = (float*)(F.lds + F.wave * 17472); float* qs = sc + 4096; int* sel = (int*)(qs + 256);
    const int lane = F.lane;
    const bf16* Q = WSP(bf16, OFF_Q); const float* NG = WSP(float, OFF_NG); bf16* O = WSP(bf16, OFF_O);
    for (int task = blockIdx.x * 8 + F.wave; task < 2 * NTOK; task += F.G * 8) {
        const int bg = task >> 14, t = task & (T - 1), b = bg >> 1, g = bg & 1, n = b * T + t;
        { const f32x4 q4 = ld4bf(Q + (size_t)n * 512 + g * 256 + lane * 4); *(f32x4*)(qs + lane * 4) = q4; }
        WAVE_SYNC();
        float slope[4];
#pragma unroll
        for (int r = 0; r < 4; ++r) slope[r] = exp2f(-(float)(g * 4 + r + 1));
        const int ncv = (t >= 31) ? ((t - 31) >> 4) + 1 : 0;
        const bf16* kc = WSP(bf16, OFF_KC) + (size_t)bg * 1024 * 64; const bf16* vc = WSP(bf16, OFF_VC) + (size_t)bg * 1024 * 64;
        for (int c = lane; c < ncv; c += 64) {
            float a[4] = {0.f, 0.f, 0.f, 0.f}; dot4(kc + (size_t)c * 64, qs, a);
            const float dist = (float)(t - (16 * c + 31));
#pragma unroll
            for (int r = 0; r < 4; ++r) sc[r * 1024 + c] = a[r] * 0.125f - slope[r] * dist;
        }
        WAVE_SYNC();
        float oc[4] = {0.f, 0.f, 0.f, 0.f};
        if (ncv > 0) {
            softmax4(sc, ncv, lane);
            WAVE_SYNC();
            for (int c = 0; c < ncv; ++c) { const float v = bf2f(vc[(size_t)c * 64 + lane]);
#pragma unroll
                for (int r = 0; r < 4; ++r) oc[r] += sc[r * 1024 + c] * v; }
            WAVE_SYNC();
            for (int c = lane; c < ncv; c += 64) sc[c] = (sc[c] + sc[1024 + c]) + (sc[2048 + c] + sc[3072 + c]);
        }
        WAVE_SYNC();
        const int cur = t >> 6;
        float val[4];
#pragma unroll
        for (int i = 0; i < 4; ++i) {
            const int j = lane + 64 * i; float imp = 0.f;
#pragma unroll
            for (int o = 0; o < 5; ++o) { const int c = 4 * j + o - 1; if (c >= 0 && c < ncv) imp += sc[c]; }
            const bool forced = (j == 0) || (j == cur) || (j == cur - 1), valid = (j <= cur);
            val[i] = forced ? 1e30f : (valid ? imp : -1e30f);
        }
        WAVE_SYNC();
        int nsel = 0;
        for (int it = 0; it < 16; ++it) {
            float bv = val[0]; int bj = lane;
#pragma unroll
            for (int i = 1; i < 4; ++i) if (val[i] > bv) { bv = val[i]; bj = lane + 64 * i; }
#pragma unroll
            for (int o = 1; o < 64; o <<= 1) { const float ov = __shfl_xor(bv, o); const int oj = __shfl_xor(bj, o); if (ov > bv || (ov == bv && oj < bj)) { bv = ov; bj = oj; } }
            if (bv < -1e29f) break;
            if (lane == 0) sel[nsel] = bj;
            ++nsel;
#pragma unroll
            for (int i = 0; i < 4; ++i) if (bj == lane + 64 * i) val[i] = -INFINITY;
        }
        WAVE_SYNC();
        const bf16* ks = WSP(bf16, OFF_KS) + (size_t)bg * T * 64; const bf16* vs = WSP(bf16, OFF_VS) + (size_t)bg * T * 64;
        for (int i = 0; i < nsel; ++i) {
            const int pos = sel[i] * 64 + lane;
            float a[4] = {0.f, 0.f, 0.f, 0.f}; dot4(ks + (size_t)pos * 64, qs, a);
            const float dist = (float)(t - pos);
#pragma unroll
            for (int r = 0; r < 4; ++r) sc[r * 1024 + i * 64 + lane] = (pos <= t) ? a[r] * 0.125f - slope[r] * dist : -INFINITY;
        }
        WAVE_SYNC();
        softmax4(sc, nsel * 64, lane);
        WAVE_SYNC();
        float os[4] = {0.f, 0.f, 0.f, 0.f};
        for (int i = 0; i < nsel; ++i) { const bf16* vb = vs + (size_t)sel[i] * 64 * 64 + lane;
            for (int k = 0; k < 64; ++k) { const float v = bf2f(vb[k * 64]);
#pragma unroll
                for (int r = 0; r < 4; ++r) os[r] += sc[r * 1024 + i * 64 + k] * v; } }
        WAVE_SYNC();
        const bf16* kw = WSP(bf16, OFF_KW) + (size_t)bg * T * 64; const bf16* vw = WSP(bf16, OFF_VW) + (size_t)bg * T * 64;
        const int lo = (t >= 511) ? t - 511 : 0, nk = t - lo + 1;
        for (int i = lane; i < nk; i += 64) {
            const int pos = lo + i;
            float a[4] = {0.f, 0.f, 0.f, 0.f}; dot4(kw + (size_t)pos * 64, qs, a);
            const float dist = (float)(t - pos);
#pragma unroll
            for (int r = 0; r < 4; ++r) sc[r * 1024 + i] = a[r] * 0.125f - slope[r] * dist;
        }
        WAVE_SYNC();
        softmax4(sc, nk, lane);
        WAVE_SYNC();
        float ow[4] = {0.f, 0.f, 0.f, 0.f};
        for (int i = 0; i < nk; ++i) { const float v = bf2f(vw[(size_t)(lo + i) * 64 + lane]);
#pragma unroll
            for (int r = 0; r < 4; ++r) ow[r] += sc[r * 1024 + i] * v; }
        WAVE_SYNC();
        const float* ng = NG + (size_t)n * 32 + g * 12;
#pragma unroll
        for (int r = 0; r < 4; ++r) O[(size_t)n * 512 + g * 256 + r * 64 + lane] = (bf16)f2bf(ng[r * 3] * oc[r] + ng[r * 3 + 1] * os[r] + ng[r * 3 + 2] * ow[r]);
    }
}

__device__ __forceinline__ void phase_merge(const Frame& F0) { const Frame F = launder(F0);
    const bf16* MG = WSP(bf16, OFF_MG); bf16* MERGED = WSP(bf16, OFF_MERGED);
    for (int it = blockIdx.x; it < (NTOK / 128) * 8; it += F.G) {
        const int mt = it >> 3, nt = it & 7;
        f32x4 outv[4][2]; ACC_ZERO(outv);
#pragma unroll
        for (int src = 0; src < 3; ++src) {
            const bf16* A = src == 0 ? WSP(bf16, OFF_O) : src == 1 ? WSP(bf16, OFF_PM) : WSP(bf16, OFF_CV);
            const bf16* B = src == 0 ? WSP(bf16, OFF_WN) : src == 1 ? WSP(bf16, OFF_WP) : WSP(bf16, OFF_WC);
            const int K = src == 0 ? 512 : 256;
            f32x4 acc[4][2]; ACC_ZERO(acc);
            gemm_tile_128(acc, A + (size_t)mt * 128 * K, K, B + (size_t)nt * 128 * K, K, K, F.lds);
            const int tq = otid(), l = tq & 63, w = tq >> 6;
#pragma unroll
            for (int i = 0; i < 4; ++i)
#pragma unroll
                for (int j = 0; j < 2; ++j) { const int row = mt * 128 + (w >> 2) * 64 + i * 16 + (l & 15), col = nt * 128 + (w & 3) * 32 + j * 16 + (l >> 4) * 4;
                    outv[i][j] += ld4bf(MG + (size_t)row * 3072 + src * 1024 + col) * acc[i][j]; }
        }
        TILE_FOREACH(outv, mt * 128, nt * 128, { st4bf(MERGED + (size_t)ROW * 1024 + COL, V); });
    }
}
__device__ __forceinline__ void phase_wo(const Frame& F0) { const Frame F = launder(F0);
    const bf16* MERGED = WSP(bf16, OFF_MERGED);
    for (int it = blockIdx.x; it < (NTOK / 128) * 8; it += F.G) {
        const int mt = it >> 3, nt = it & 7;
        f32x4 acc[4][2]; ACC_ZERO(acc);
        gemm_tile_128(acc, MERGED + (size_t)mt * 128 * 1024, 1024, WSP(bf16, OFF_WO) + (size_t)nt * 128 * 1024, 1024, 1024, F.lds);
        TILE_FOREACH(acc, mt * 128, nt * 128, { f32x4* p = (f32x4*)(F.out + (size_t)ROW * 1024 + COL); *p = *p + V; });
    }
}

__device__ __forceinline__ void phase_router(const Frame& F0, int l) { const Frame F = launder(F0);
    int* hist = (int*)F.lds;
    if (F.tid < 32) hist[F.tid] = 0;
    __syncthreads();
    const float* g2 = F.in[13] + (size_t)l * D; const float* wg = F.in[14] + (size_t)l * D * 4; const float* bgp = F.in[15] + (size_t)l * 4;
    const float* we = F.in[16] + (size_t)l * D * 32; const float* be = F.in[17] + (size_t)l * 32;
    bf16* xn = WSP(bf16, OFF_XN); int* toke = WSP(int, OFF_TOKE); float* tokc = WSP(float, OFF_TOKC);
    for (int n = blockIdx.x * 8 + F.wave; n < NTOK; n += F.G * 8) {
        f32x4 v[4]; float ss = 0.f;
        const f32x4* hr = (const f32x4*)(F.out + (size_t)n * D) + F.lane;
#pragma unroll
        for (int j = 0; j < 4; ++j) { v[j] = hr[64 * j]; ss += (v[j].x * v[j].x + v[j].y * v[j].y) + (v[j].z * v[j].z + v[j].w * v[j].w); }
        const float rs = 1.f / sqrtf(wave_sum(ss) * (1.f / D) + RMS_EPS);
        float gl[4] = {0.f, 0.f, 0.f, 0.f};
#pragma unroll
        for (int j = 0; j < 4; ++j) {
            v[j] = v[j] * rs * ((const f32x4*)g2)[F.lane + 64 * j];
            st4bf(xn + (size_t)n * D + F.lane * 4 + 256 * j, v[j]);
#pragma unroll
            for (int q = 0; q < 4; ++q) {
                const int k = F.lane * 4 + 256 * j + q; const float x = v[j][q];
                const f32x4 w4 = *(const f32x4*)(wg + (size_t)k * 4);
                gl[0] += x * w4.x; gl[1] += x * w4.y; gl[2] += x * w4.z; gl[3] += x * w4.w;
            }
        }
        int gs = 0;
#pragma unroll
        for (int i = 0; i < 4; ++i) gl[i] = wave_sum(gl[i]) + bgp[i];
        float gm = gl[0];
#pragma unroll
        for (int i = 1; i < 4; ++i) if (gl[i] > gm) { gm = gl[i]; gs = i; }
        float gsum = 0.f;
#pragma unroll
        for (int i = 0; i < 4; ++i) gsum += __expf(gl[i] - gm);
        const float gp = 1.f / gsum;
        gs = __builtin_amdgcn_readfirstlane(gs);
        float el[8] = {0.f, 0.f, 0.f, 0.f, 0.f, 0.f, 0.f, 0.f};
#pragma unroll
        for (int j = 0; j < 4; ++j)
#pragma unroll
            for (int q = 0; q < 4; ++q) {
                const int k = F.lane * 4 + 256 * j + q; const float x = v[j][q];
                const f32x4 u0 = *(const f32x4*)(we + (size_t)k * 32 + gs * 8), u1 = *(const f32x4*)(we + (size_t)k * 32 + gs * 8 + 4);
                el[0] += x * u0.x; el[1] += x * u0.y; el[2] += x * u0.z; el[3] += x * u0.w; el[4] += x * u1.x; el[5] += x * u1.y; el[6] += x * u1.z; el[7] += x * u1.w;
            }
        float v0 = -INFINITY, v1 = -INFINITY; int i0 = 0, i1 = 0;
#pragma unroll
        for (int i = 0; i < 8; ++i) {
            const float ev = wave_sum(el[i]) + be[gs * 8 + i];
            if (ev > v0) { v1 = v0; i1 = i0; v0 = ev; i0 = i; } else if (ev > v1) { v1 = ev; i1 = i; }
        }
        const float e1 = __expf(v1 - v0), w0 = 1.f / (1.f + e1), w1 = e1 * w0;
        if (F.lane == 0) {
            const int ea = gs * 8 + i0, eb = gs * 8 + i1;
            toke[n * 2] = ea; toke[n * 2 + 1] = eb; tokc[n * 2] = w0 * gp; tokc[n * 2 + 1] = w1 * gp;
            atomicAdd(&hist[ea], 1); atomicAdd(&hist[eb], 1);
        }
    }
    __syncthreads();
    if (F.tid < 32 && hist[F.tid]) atomicAdd(F.ctl + CW_CNT + l * 32 + F.tid, (unsigned)hist[F.tid]);
}

__device__ __forceinline__ void moe_offsets(const Frame& F, int l, int* off) {
    if (F.tid == 0) { int a = 0; for (int e = 0; e < NEXP; ++e) { off[e] = a; const int c = (int)__hip_atomic_load(F.ctl + CW_CNT + l * 32 + e, __ATOMIC_RELAXED, __HIP_MEMORY_SCOPE_AGENT); a += (c + 255) & ~255; } off[NEXP] = a; }
    __syncthreads();
}
__device__ __forceinline__ void phase_dispatch(const Frame& F0, int l) { const Frame F = launder(F0);
    int* off = (int*)F.lds; int* hist = off + 64; int* base = hist + 32; int* pslot = base + 32; int* ptok = pslot + 512;
    moe_offsets(F, l, off);
    const int* toke = WSP(int, OFF_TOKE); const float* tokc = WSP(float, OFF_TOKC); int* toks = WSP(int, OFF_TOKS); float* slotc = WSP(float, OFF_SLOTC);
    const bf16* xn = WSP(bf16, OFF_XN); bf16* xg = WSP(bf16, OFF_XG);
    for (int ch = blockIdx.x; ch < NTOK / 256; ch += F.G) {
        if (F.tid < 32) hist[F.tid] = 0;
        __syncthreads();
        const int pr = ch * 512 + F.tid, e = toke[pr];
        const int r = atomicAdd(&hist[e], 1);
        __syncthreads();
        if (F.tid < 32) base[F.tid] = hist[F.tid] ? (int)atomicAdd(F.ctl + CW_CUR + l * 32 + F.tid, (unsigned)hist[F.tid]) : 0;
        __syncthreads();
        const int slot = off[e] + base[e] + r;
        toks[pr] = slot; slotc[slot] = tokc[pr]; pslot[F.tid] = slot; ptok[F.tid] = pr >> 1;
        __syncthreads();
        for (int i = F.wave; i < 512; i += 8) {
            const uint4* s = (const uint4*)(xn + (size_t)ptok[i] * D) + F.lane; uint4* d = (uint4*)(xg + (size_t)pslot[i] * D) + F.lane;
            d[0] = s[0]; d[64] = s[64];
        }
        __syncthreads();
    }
}
__device__ __forceinline__ int moe_expert_of(const int* off, int row) { int e = 0;
#pragma unroll 1
    for (int i = 1; i < NEXP; ++i) if (row >= off[i]) e = i;
    return e; }
__device__ __forceinline__ float siluf(float x) { return x / (1.f + __expf(-x)); }
__device__ __forceinline__ void phase_moe1(const Frame& F0, int l) { const Frame F = launder(F0);
    int* off = (int*)(F.lds + 32768); moe_offsets(F, l, off);
    const bf16* xg = WSP(bf16, OFF_XG); bf16* hmid = WSP(bf16, OFF_HMID);
    const int ntile = off[NEXP] / 128;
    for (int it = blockIdx.x; it < ntile * 2; it += F.G) {
        const int rt = it >> 1, u = it & 1, e = moe_expert_of(off, rt * 128);
        const bf16* B = WSP(bf16, OFF_W13) + ((size_t)e * 512 + u * 256) * 1024;
        f32x4 a1[4][2], a3[4][2]; ACC_ZERO(a1); ACC_ZERO(a3);
        gemm_tile_128(a1, xg + (size_t)rt * 128 * 1024, 1024, B, 1024, 1024, F.lds);
        gemm_tile_128(a3, xg + (size_t)rt * 128 * 1024, 1024, B + (size_t)128 * 1024, 1024, 1024, F.lds);
#pragma unroll
        for (int i = 0; i < 4; ++i)
#pragma unroll
            for (int j = 0; j < 2; ++j) { const f32x4 x = a1[i][j], y = a3[i][j]; a1[i][j] = (f32x4){siluf(x.x) * y.x, siluf(x.y) * y.y, siluf(x.z) * y.z, siluf(x.w) * y.w}; }
        TILE_FOREACH(a1, rt * 128, u * 128, { st4bf(hmid + (size_t)ROW * 256 + COL, V); });
    }
}
__device__ __forceinline__ void phase_moe2(const Frame& F0, int l) { const Frame F = launder(F0);
    int* off = (int*)(F.lds + 32768); moe_offsets(F, l, off);
    const bf16* hmid = WSP(bf16, OFF_HMID); bf16* ys = WSP(bf16, OFF_YS); const float* slotc = WSP(float, OFF_SLOTC);
    const int ntile = off[NEXP] / 128;
    for (int it = blockIdx.x; it < ntile * 8; it += F.G) {
        const int rt = it >> 3, ct = it & 7, e = moe_expert_of(off, rt * 128);
        f32x4 acc[4][2]; ACC_ZERO(acc);
        gemm_tile_128(acc, hmid + (size_t)rt * 128 * 256, 256, WSP(bf16, OFF_W2) + ((size_t)e * 1024 + ct * 128) * 256, 256, 256, F.lds);
        TILE_FOREACH(acc, rt * 128, ct * 128, { st4bf(ys + (size_t)ROW * 1024 + COL, V * slotc[ROW]); });
    }
}

constexpr int PPL = 11;
constexpr int NPHASE = DEPTH * PPL + 1;
__global__ void __launch_bounds__(512, 2) nsa_fwd(Args args) {
    extern __shared__ __attribute__((aligned(16))) unsigned char lds[];
    Frame F;
    F.lds = lds; F.ws = args.ws; F.ctl = (unsigned*)(args.ws + WS_CTL); F.out = args.out;
#pragma unroll
    for (int i = 0; i < 22; ++i) F.in[i] = args.in[i];
    F.tid = threadIdx.x; F.lane = F.tid & 63; F.wave = __builtin_amdgcn_readfirstlane(F.tid >> 6); F.G = gridDim.x;
    volatile LAS unsigned* MISC = (volatile LAS unsigned*)((LAS unsigned char*)lds + MISC_OFF);
    if (F.tid < 32) MISC[F.tid] = 0u;
    __syncthreads();
    const int lo = args.ph_lo, hi = args.ph_hi;
    XcdBarrier bar; bar.bar = F.ctl + CW_BAR; bar.x = 0; bar.st = MISC + 8;
    if (hi - lo > 1) bar = xcd_barrier_post(F.ctl + CW_BAR, MISC + 8);
#ifndef ONLY
#define ONLY -1
#endif
#ifndef PMASK
#define PMASK 0xFFF
#endif
#define IN(k) (lo <= (k) && (k) < hi && ((PMASK >> ((k) == DEPTH * PPL ? 11 : (k) % PPL)) & 1))
#define SEAM(k) do { if (IN(k) && IN((k) + 1)) xcd_barrier(bar); else __syncthreads(); } while (0)
#pragma unroll 1
    for (int l = 0; l < DEPTH; ++l) {
        const int p0 = l * PPL;
        if (IN(p0 + 0)) { phase_weights(F, l); phase_norm<false>(F, l, F.in[1] + (size_t)l * D); } SEAM(p0 + 0);
        if (IN(p0 + 1)) { phase_inproj(F); } SEAM(p0 + 1);
        if (IN(p0 + 2)) { phase_cmp1(F); __syncthreads(); phase_poolconv(F, l); } SEAM(p0 + 2);
        if (IN(p0 + 3)) { phase_cmp2(F); } SEAM(p0 + 3);
        if (IN(p0 + 4)) { phase_attn_valu(F); } SEAM(p0 + 4);
        if (IN(p0 + 5)) { phase_merge(F); } SEAM(p0 + 5);
        if (IN(p0 + 6)) { phase_wo(F); } SEAM(p0 + 6);
        if (IN(p0 + 7)) { phase_router(F, l); } SEAM(p0 + 7);
        if (IN(p0 + 8)) { phase_dispatch(F, l); } SEAM(p0 + 8);
        if (IN(p0 + 9)) { phase_moe1(F, l); } SEAM(p0 + 9);
        if (IN(p0 + 10)) { phase_moe2(F, l); } SEAM(p0 + 10);
    }
    if (IN(DEPTH * PPL)) phase_norm<true>(F, DEPTH, F.in[21]);
#undef IN
#undef SEAM
}

extern "C" void kernel_launch(void* const* d_in, const int* in_sizes, int n_in, void* d_out, int out_size, void* d_ws, size_t ws_size, hipStream_t stream) {
    static int grid = 0;
    if (grid == 0) {
        if (n_in != 22 || out_size != NTOK * D || ws_size < WS_END) { fprintf(stderr, "kernel_launch: unexpected shapes (n_in %d out %d ws %zu, need %zu)\n", n_in, out_size, ws_size, (size_t)WS_END); grid = -1; return; }
        int dev = 0, cus = 0;
        if (hipGetDevice(&dev) != hipSuccess || hipDeviceGetAttribute(&cus, hipDeviceAttributeMultiprocessorCount, dev) != hipSuccess) { grid = -1; return; }
        if (hipFuncSetAttribute((const void*)nsa_fwd, hipFuncAttributeMaxDynamicSharedMemorySize, LDS_BYTES) != hipSuccess) { fprintf(stderr, "kernel_launch: hipFuncSetAttribute failed\n"); grid = -1; return; }
        int per_cu = 0;
        if (hipOccupancyMaxActiveBlocksPerMultiprocessor(&per_cu, (const void*)nsa_fwd, 512, LDS_BYTES) != hipSuccess || per_cu < 1) fprintf(stderr, "kernel_launch: occupancy query says %d\n", per_cu);
        (void)hipGetLastError();
        grid = cus;
    }
    if (grid < 0) return;
    (void)hipMemsetAsync((char*)d_ws + WS_CTL, 0, CTL_BYTES, stream);
    Args a{};
    for (int i = 0; i < 22; ++i) a.in[i] = (const float*)d_in[i];
    a.out = (float*)d_out; a.ws = (unsigned char*)d_ws;
#if MK_PER_PHASE
    for (int p = 0; p < NPHASE; ++p) { a.ph_lo = p; a.ph_hi = p + 1; hipLaunchKernelGGL(nsa_fwd, dim3(grid), dim3(512), LDS_BYTES, stream, a); }
#else
    a.ph_lo = 0; a.ph_hi = NPHASE;
    hipLaunchKernelGGL(nsa_fwd, dim3(grid), dim3(512), LDS_BYTES, stream, a);
#endif
}
```

```cpp
#include <hip/hip_runtime.h>
#include <cstdio>
#include <cstdint>

#ifndef USE_PG8
#define USE_PG8 31
#endif
#ifndef ATTN_MFMA
#define ATTN_MFMA 1
#endif
#ifndef MK_PER_PHASE
#define MK_PER_PHASE 0
#endif

#define LAS __attribute__((address_space(3)))
typedef unsigned short bf16;
typedef short bf16x8 __attribute__((ext_vector_type(8)));
typedef float f32x4 __attribute__((ext_vector_type(4)));
typedef unsigned u32x4 __attribute__((ext_vector_type(4)));

constexpr int D = 1024, NB = 2, T = 16384, NTOK = NB * T, DEPTH = 2;
constexpr int IN_DIM = 5400, INP = 5632;
constexpr int NCMP = 1023, NSLC = 256;
constexpr float RMS_EPS = 1e-6f;
constexpr int NEXP = 32, DEXP = 256;
constexpr int MOE_ROWS = 2 * NTOK + NEXP * 256;
constexpr int TP = T + 64;

constexpr size_t MiB = 1u << 20;
constexpr size_t WS_CTL = 0, CTL_BYTES = MiB;
constexpr size_t RA = MiB;
constexpr size_t SZ_Q = (size_t)NTOK * 512 * 2, SZ_KVC = (size_t)8 * TP * 64 * 2, SZ_KV = (size_t)NB * 2 * T * 64 * 2, SZ_C256 = (size_t)NTOK * 256 * 2;
constexpr size_t OFF_Q = RA, OFF_KVC = OFF_Q + SZ_Q, OFF_KS = OFF_KVC + SZ_KVC, OFF_VS = OFF_KS + SZ_KV, OFF_KW = OFF_VS + SZ_KV, OFF_VW = OFF_KW + SZ_KV;
constexpr size_t OFF_PU = OFF_VW + SZ_KV, OFF_CH = OFF_PU + SZ_C256, OFF_CB = OFF_CH + SZ_C256, OFF_CC = OFF_CB + SZ_C256, OFF_NG = OFF_CC + SZ_C256;
constexpr size_t OFF_MG = OFF_NG + (size_t)NTOK * 32 * 4, RA_END = OFF_MG + (size_t)NTOK * 3072 * 2;
constexpr size_t OFF_MERGED = RA;
static_assert(OFF_MERGED + (size_t)NTOK * 1024 * 2 <= OFF_KW, "merged alias");
constexpr size_t OFF_XG = RA, OFF_HMID = OFF_XG + (size_t)MOE_ROWS * 1024 * 2, OFF_YS = OFF_HMID + (size_t)MOE_ROWS * 256 * 2, MOE_END = OFF_YS + (size_t)MOE_ROWS * 1024 * 2;
static_assert(MOE_END <= RA_END, "moe alias");
constexpr size_t RB = RA_END, OFF_XN = RB, OFF_O = RB, OFF_PM = OFF_O + SZ_Q, OFF_CV = OFF_PM + SZ_C256, RB_END = RB + (size_t)NTOK * 1024 * 2;
static_assert(OFF_CV + SZ_C256 <= RB_END, "rb alias");
constexpr size_t RW = RB_END;
constexpr size_t OFF_WIN = RW, OFF_CW1 = OFF_WIN + (size_t)INP * 1024 * 2, OFF_CW2 = OFF_CW1 + (size_t)2 * 256 * 2048 * 2, OFF_CB1 = OFF_CW2 + (size_t)2 * 128 * 256 * 2;
constexpr size_t OFF_WN = OFF_CB1 + 4096, OFF_WP = OFF_WN + (size_t)1024 * 512 * 2, OFF_WC = OFF_WP + (size_t)1024 * 256 * 2, OFF_WO = OFF_WC + (size_t)1024 * 256 * 2;
constexpr size_t OFF_W13 = OFF_WO + (size_t)1024 * 1024 * 2, OFF_W2 = OFF_W13 + (size_t)NEXP * 512 * 1024 * 2, RW_END = OFF_W2 + (size_t)NEXP * 1024 * 256 * 2;
constexpr size_t RS = RW_END;
constexpr size_t OFF_KC = RS, OFF_VC = OFF_KC + (size_t)4 * 1024 * 64 * 2, OFF_HC = OFF_VC + (size_t)4 * 1024 * 64 * 2;
constexpr size_t OFF_TOKE = OFF_HC + (size_t)8192 * 256 * 2, OFF_TOKC = OFF_TOKE + (size_t)NTOK * 8, OFF_TOKS = OFF_TOKC + (size_t)NTOK * 8, OFF_SLOTC = OFF_TOKS + (size_t)NTOK * 8;
constexpr size_t WS_END = OFF_SLOTC + (size_t)MOE_ROWS * 4;
static_assert(WS_END <= (size_t)512 * MiB, "workspace");
constexpr int CW_BAR = 4096;
constexpr int CW_CNT = 16384;
constexpr int CW_CUR = CW_CNT + DEPTH * 32;

constexpr int LDS_BYTES = 147456;
constexpr int MISC_OFF = 143360;

__device__ __forceinline__ float bf2f(unsigned u) { return __builtin_bit_cast(float, u << 16); }
__device__ __forceinline__ unsigned f2bf(float f) { unsigned u = __builtin_bit_cast(unsigned, f); return (u + 0x7fffu + ((u >> 16) & 1u)) >> 16; }
__device__ __forceinline__ unsigned pk2(float lo, float hi) { return f2bf(lo) | (f2bf(hi) << 16); }
__device__ __forceinline__ void st4bf(bf16* p, f32x4 v) { *(uint2*)p = make_uint2(pk2(v.x, v.y), pk2(v.z, v.w)); }
__device__ __forceinline__ f32x4 ld4bf(const bf16* p) { const uint2 u = *(const uint2*)p; return (f32x4){bf2f(u.x & 0xffffu), bf2f(u.x >> 16), bf2f(u.y & 0xffffu), bf2f(u.y >> 16)}; }
__device__ __forceinline__ float sigmoidf(float x) { return 1.f / (1.f + __expf(-x)); }
__device__ __forceinline__ float siluf(float x) { return x / (1.f + __expf(-x)); }
__device__ __forceinline__ float wave_sum(float v) {
#pragma unroll
    for (int o = 1; o < 64; o <<= 1) v += __shfl_xor(v, o);
    return v;
}
__device__ __forceinline__ float wave_max(float v) {
#pragma unroll
    for (int o = 1; o < 64; o <<= 1) v = fmaxf(v, __shfl_xor(v, o));
    return v;
}
__device__ __forceinline__ int swap23(int k) { return (k & 3) | ((k & 4) << 1) | ((k & 8) >> 1); }
#define WAVE_SYNC() asm volatile("s_waitcnt lgkmcnt(0)" ::: "memory")
__device__ __forceinline__ int otid() { int t = threadIdx.x; asm volatile("" : "+v"(t)); return t; }

#define XB_TMO      128
#define XB_XCNT(j)  (256  + 64 * (j))
#define XB_XSUB(j)  (1280 + 64 * (j))
#define XB_XGEN(j)  (2304 + 64 * (j))
#define XB_TOP      3328
#define XB_TOPGEN   3392
#define XCD_BAR_WORDS 3456
#define XB_SPIN_CAP (1u << 18)
__device__ __forceinline__ unsigned xb_ld(unsigned* p)              { return __hip_atomic_load(p, __ATOMIC_RELAXED, __HIP_MEMORY_SCOPE_AGENT); }
__device__ __forceinline__ unsigned xb_add(unsigned* p, unsigned v) { return __hip_atomic_fetch_add(p, v, __ATOMIC_RELAXED, __HIP_MEMORY_SCOPE_AGENT); }
__device__ __forceinline__ unsigned xb_xcc_id() { return (unsigned)__builtin_amdgcn_s_getreg((3 << 11) | 20) & 0xFu; }
#define XB_SPIN(cond, bar) do { unsigned _sp = 0; while (cond) { __builtin_amdgcn_s_sleep(1); \
    if ((++_sp & 255u) == 0u) { if (xb_ld(&(bar)[XB_TMO])) break; if (_sp > XB_SPIN_CAP) { atomicAdd(&(bar)[XB_TMO], 1u); break; } } } } while (0)
struct XcdBarrier { unsigned* bar; unsigned x; volatile LAS unsigned* st; };
__device__ __forceinline__ XcdBarrier xcd_barrier_post(unsigned* bar, volatile LAS unsigned* st) {
    XcdBarrier b; b.bar = bar; b.x = xb_xcc_id(); b.st = st;
    if (threadIdx.x == 0) (void)xb_add(&bar[XB_XCNT(b.x)], 1u);
    return b;
}
__device__ __forceinline__ void xcd_barrier_complete(unsigned* bar, unsigned x, unsigned& nloc, unsigned& nx) {
    const unsigned G = gridDim.x * gridDim.y * gridDim.z;
    unsigned sum, cnt, mine, sp = 0u;
    for (;;) {
        sum = 0u; cnt = 0u; mine = 0u;
#pragma unroll
        for (unsigned j = 0; j < 16; ++j) { const unsigned c = xb_ld(&bar[XB_XCNT(j)]); sum += c; cnt += (c > 0u) ? 1u : 0u; mine = (j == x) ? c : mine; }
        if (sum == G) break;
        __builtin_amdgcn_s_sleep(1);
        if ((++sp & 255u) == 0u) { if (xb_ld(&bar[XB_TMO])) break; if (sp > XB_SPIN_CAP) { atomicAdd(&bar[XB_TMO], 1u); break; } }
    }
    nloc = mine > 0u ? mine : 1u; nx = cnt > 0u ? cnt : 1u;
}
__device__ __forceinline__ void xcd_barrier(const XcdBarrier& b) {
    asm volatile("s_waitcnt vmcnt(0)" ::: "memory");
    __syncthreads();
    if (threadIdx.x == 0) {
        unsigned* bar = b.bar; unsigned bx = b.x;
        asm volatile("" : "+s"(bar), "+s"(bx));
        __builtin_amdgcn_s_waitcnt(0);
        unsigned nloc = b.st[0], nx = b.st[1];
        if (nloc == 0u) { xcd_barrier_complete(bar, bx, nloc, nx); b.st[0] = nloc; b.st[1] = nx; }
        const unsigned old = xb_add(&bar[XB_XSUB(bx)], 1u);
        const unsigned gen = old / nloc;
        if (old + 1u == (gen + 1u) * nloc) {
            __builtin_amdgcn_fence(__ATOMIC_RELEASE, "agent");
            asm volatile("s_waitcnt vmcnt(0)" ::: "memory");
            const unsigned og = xb_add(&bar[XB_TOP], 1u);
            const unsigned tg = og / nx;
            if (og + 1u == (tg + 1u) * nx) xb_add(&bar[XB_TOPGEN], 1u);
            else XB_SPIN(xb_ld(&bar[XB_TOPGEN]) == tg, bar);
            __builtin_amdgcn_fence(__ATOMIC_ACQUIRE, "agent");
            xb_add(&bar[XB_XGEN(bx)], 1u);
            asm volatile("s_waitcnt vmcnt(0)" ::: "memory");
        } else {
            XB_SPIN(xb_ld(&bar[XB_XGEN(bx)]) == gen, bar);
            __builtin_amdgcn_fence(__ATOMIC_ACQUIRE, "agent");
            asm volatile("s_waitcnt vmcnt(0)" ::: "memory");
        }
    }
    __syncthreads();
}

struct Args { const float* in[22]; float* out; unsigned char* ws; int ph_lo, ph_hi; };
struct Frame {
    LAS unsigned char* lds; unsigned char* ws; unsigned* ctl; float* out;
    const float* in[22];
    int tid, lane, wave, G;
};
#define WSP(T_, off) ((T_*)(F.ws + (off)))
__device__ __forceinline__ Frame launder(const Frame& F0) {
    Frame F = F0;
    asm volatile("" : "+v"(F.tid), "+v"(F.lane));
    return F;
}

__device__ __forceinline__ void gemm_tile_128(f32x4 (&acc)[4][2], const bf16* __restrict__ A, int lda, const bf16* __restrict__ B, int ldb, int K, LAS unsigned char* lds) {
    LAS bf16* As = (LAS bf16*)lds; LAS bf16* Bs = As + 128 * 40;
    const int tid = otid(), lane = tid & 63, wave = tid >> 6, wm = wave >> 2, wn = wave & 3;
    const int lr = tid >> 2, lk = (tid & 3) * 8, fr = lane & 15, fq = lane >> 4;
    const bf16* ap = A + (size_t)lr * lda + lk; const bf16* bp = B + (size_t)lr * ldb + lk;
    u32x4 av = *(const u32x4*)ap, bv = *(const u32x4*)bp;
    for (int k0 = 0; k0 < K; k0 += 32) {
        __syncthreads();
        *(LAS u32x4*)(As + lr * 40 + lk) = av; *(LAS u32x4*)(Bs + lr * 40 + lk) = bv;
        __syncthreads();
        if (k0 + 32 < K) { av = *(const u32x4*)(ap + k0 + 32); bv = *(const u32x4*)(bp + k0 + 32); }
        bf16x8 af[4], bfr[2];
#pragma unroll
        for (int i = 0; i < 4; ++i) af[i] = *(const LAS bf16x8*)(As + (wm * 64 + i * 16 + fr) * 40 + fq * 8);
#pragma unroll
        for (int j = 0; j < 2; ++j) bfr[j] = *(const LAS bf16x8*)(Bs + (wn * 32 + j * 16 + fr) * 40 + fq * 8);
#pragma unroll
        for (int i = 0; i < 4; ++i)
#pragma unroll
            for (int j = 0; j < 2; ++j) acc[i][j] = __builtin_amdgcn_mfma_f32_16x16x32_bf16(bfr[j], af[i], acc[i][j], 0, 0, 0);
    }
}
#define ACC_ZERO(a) do { _Pragma("unroll") for (int _i = 0; _i < 4; ++_i) _Pragma("unroll") for (int _j = 0; _j < 2; ++_j) a[_i][_j] = (f32x4){0.f, 0.f, 0.f, 0.f}; } while (0)
#define TILE_FOREACH(acc, m0, n0, BODY) do { const int _t = otid(), _l = _t & 63, _w = _t >> 6; \
    _Pragma("unroll") for (int _i = 0; _i < 4; ++_i) _Pragma("unroll") for (int _j = 0; _j < 2; ++_j) { \
        const int ROW = (m0) + (_w >> 2) * 64 + _i * 16 + (_l & 15); const int COL = (n0) + (_w & 3) * 32 + _j * 16 + (_l >> 4) * 4; f32x4& V = acc[_i][_j]; BODY } } while (0)


namespace pg8 {
#define PG8_LAS __attribute__((address_space(3)))
typedef unsigned short bf16_t;
constexpr int BM = 256, BK = 64, HALF = 128, HTB = HALF * BK * 2  , STAGE_BYTES = 8 * HTB, NXCD = 8, WGM = 8;
__host__ __device__ __forceinline__ int lds_byte(int r, int c) { const int st = (r >> 4) * 2 + (c >> 5), rr = r & 15, cc = c & 31, ob = rr * 64 + cc * 2; return st * 1024 + (ob ^ (((ob >> 9) & 1) << 5)); }
__host__ __device__ __forceinline__ void stage_rc(int b, int& R, int& C) { const int st = b / 1024, sb = b % 1024, swz = sb ^ (((sb >> 9) & 1) << 5); R = (st >> 1) * 16 + swz / 64; C = (st & 1) * 32 + (swz % 64) / 2; }
__host__ __device__ __forceinline__ int perm32(int rho) { const int n = rho >> 4, i = rho & 15; return 8 * (i >> 2) + 4 * n + (i & 3); }
struct Unit { int pm, pn, e; };
struct Gemm { const bf16_t* A; const bf16_t* Bt; int lda, ldb, K; };
struct StaticOrder {
    int nM, nN, nwg, G, c;
    __device__ void init(int M, int N, int G_, int c_) { nM = M / BM; nN = N / BM; nwg = nM * nN; G = G_; c = c_; }
    __device__ bool next(int i, Unit& u) const {
        const long L = (long)i * G + c; if (L >= nwg) return false;
        int wgid = (int)L; { const int q = nwg / NXCD, r = nwg % NXCD, xcd = wgid % NXCD, off = wgid / NXCD; wgid = (xcd < r ? xcd * (q + 1) : r * (q + 1) + (xcd - r) * q) + off; }
        const int nig = WGM * nN, gid = wgid / nig, fm = gid * WGM, gsz = (nM - fm) < WGM ? (nM - fm) : WGM;
        u.pm = fm + ((wgid % nig) % gsz); u.pn = (wgid % nig) / gsz; u.e = 0; return true;
    }
    __device__ __forceinline__ const char* a_ptr(const Gemm& g, const Unit& u) const { return (const char*)g.A + (size_t)u.pm * BM * g.lda * 2; }
    __device__ __forceinline__ const char* b_ptr(const Gemm& g, const Unit& u) const { return (const char*)g.Bt + (size_t)u.pn * BM * g.ldb * 2; }
    __device__ __forceinline__ void a_ready(const Unit&) const {}
    __device__ __forceinline__ void done(const Unit&) const {}
};
struct MoeOrder {
    const PG8_LAS int* off; int ncol, G, c; size_t bexp;
    __device__ bool next(int i, Unit& u) const {
        const int L = i * G + c; if (L >= (off[32] >> 8) * ncol) return false;
        u.pm = L / ncol; u.pn = L % ncol; int e = 0;
#pragma unroll 1
        for (int j = 1; j < 32; ++j) if (u.pm * BM >= off[j]) e = j;
        u.e = e; return true;
    }
    __device__ __forceinline__ const char* a_ptr(const Gemm& g, const Unit& u) const { return (const char*)g.A + (size_t)u.pm * BM * g.lda * 2; }
    __device__ __forceinline__ const char* b_ptr(const Gemm& g, const Unit& u) const { return (const char*)g.Bt + (size_t)u.e * bexp + (size_t)u.pn * BM * g.ldb * 2; }
    __device__ __forceinline__ void a_ready(const Unit&) const {}
    __device__ __forceinline__ void done(const Unit&) const {}
};
__device__ __forceinline__ u32x4 pack8(f32x4 a, f32x4 b) { u32x4 w; w.x = pk2(a.x, a.y); w.y = pk2(a.z, a.w); w.z = pk2(b.x, b.y); w.w = pk2(b.z, b.w); return w; }
__device__ __forceinline__ f32x4 sig4(f32x4 v) { return (f32x4){sigmoidf(v.x), sigmoidf(v.y), sigmoidf(v.z), sigmoidf(v.w)}; }
__device__ __forceinline__ void unpack8(u32x4 w, f32x4& a, f32x4& b) { a = (f32x4){bf2f(w.x & 0xffffu), bf2f(w.x >> 16), bf2f(w.y & 0xffffu), bf2f(w.y >> 16)}; b = (f32x4){bf2f(w.z & 0xffffu), bf2f(w.z >> 16), bf2f(w.w & 0xffffu), bf2f(w.w >> 16)}; }

struct EpiInproj {
    static constexpr bool PERM = true, AFTER_DRAIN = false; unsigned char* ws;
    __device__ __forceinline__ void operator()(const f32x4 (&acc)[2][2][4][2], const Unit& u, int wr, int wc, int fr, int fq) const {
        const int row0 = u.pm * BM + wr * 64 + fr, pn = u.pn;
#pragma unroll
        for (int ai = 0; ai < 2; ++ai)
#pragma unroll
            for (int m = 0; m < 4; ++m) { const int row = row0 + ai * HALF + m * 16;
#pragma unroll
                for (int bj = 0; bj < 2; ++bj) { const int cc = bj * HALF + wc * 32 + fq * 8; const f32x4 v0 = acc[ai][bj][m][0], v1 = acc[ai][bj][m][1];
                    if (pn < 2) *(u32x4*)((bf16*)(ws + OFF_Q) + (size_t)row * 512 + pn * 256 + cc) = pack8(v0, v1);
                    else if (pn < 5) { const int s = (pn - 2) * 2 + bj, g = wc >> 1, d = (wc & 1) * 32 + fq * 8, b = row >> 14, t = row & (T - 1);
                        bf16* dst = (s < 2) ? (bf16*)(ws + OFF_KVC) + ((size_t)((b * 2 + g) * 2 + s) * TP + t) * 64 + d : (bf16*)(ws + OFF_KS + (size_t)(s - 2) * SZ_KV) + ((size_t)(b * 2 + g) * T + t) * 64 + d;
                        if (ATTN_MFMA && (s == 3 || s == 5)) {
                            bf16* vb = (bf16*)(ws + OFF_KS + (size_t)(s - 2) * SZ_KV) + ((size_t)(b * 2 + g) * (T / 64) + (t >> 6)) * 4096 + (size_t)d * 64 + (t & 48) + swap23(t & 15);
                            const u32x4 w = pack8(v0, v1);
                            vb[0] = (bf16)(w.x & 0xffffu); vb[64] = (bf16)(w.x >> 16); vb[128] = (bf16)(w.y & 0xffffu); vb[192] = (bf16)(w.y >> 16);
                            vb[256] = (bf16)(w.z & 0xffffu); vb[320] = (bf16)(w.z >> 16); vb[384] = (bf16)(w.w & 0xffffu); vb[448] = (bf16)(w.w >> 16);
                        } else *(u32x4*)dst = pack8(v0, v1); }
                    else if (pn < 9) *(u32x4*)((bf16*)(ws + OFF_PU + (size_t)(pn - 5) * SZ_C256) + (size_t)row * 256 + cc) = pack8(v0, v1);
                    else if (pn == 9) { if (cc < 32) { float* p = (float*)(ws + OFF_NG) + (size_t)row * 32 + cc; *(f32x4*)p = sig4(v0); *(f32x4*)(p + 4) = sig4(v1); } }
                    else *(u32x4*)((bf16*)(ws + OFF_MG) + (size_t)row * 3072 + (pn - 10) * 256 + cc) = pack8(sig4(v0), sig4(v1));
                } }
    }
};
template <bool FIRST> struct EpiMerge {
    static constexpr bool PERM = true, AFTER_DRAIN = false; bf16* merged; const bf16* gate;
    __device__ __forceinline__ void operator()(const f32x4 (&acc)[2][2][4][2], const Unit& u, int wr, int wc, int fr, int fq) const {
        const int row0 = u.pm * BM + wr * 64 + fr;
#pragma unroll
        for (int ai = 0; ai < 2; ++ai)
#pragma unroll
            for (int m = 0; m < 4; ++m) { const int row = row0 + ai * HALF + m * 16;
#pragma unroll
                for (int bj = 0; bj < 2; ++bj) { const int col = u.pn * BM + bj * HALF + wc * 32 + fq * 8;
                    f32x4 g0, g1; unpack8(*(const u32x4*)(gate + (size_t)row * 3072 + col), g0, g1);
                    f32x4 o0 = g0 * acc[ai][bj][m][0], o1 = g1 * acc[ai][bj][m][1];
                    bf16* p = merged + (size_t)row * 1024 + col;
                    if (!FIRST) { f32x4 p0, p1; unpack8(*(const u32x4*)p, p0, p1); o0 += p0; o1 += p1; }
                    *(u32x4*)p = pack8(o0, o1); }
                if (!FIRST && (m & 1)) asm volatile("" ::: "memory"); }
    }
};
struct EpiWo {
    static constexpr bool PERM = false, AFTER_DRAIN = false; float* out;
    __device__ __forceinline__ void operator()(const f32x4 (&acc)[2][2][4][2], const Unit& u, int wr, int wc, int fr, int fq) const {
        const int row0 = u.pm * BM + wr * 64 + fr;
#pragma unroll
        for (int ai = 0; ai < 2; ++ai)
#pragma unroll
            for (int m = 0; m < 4; ++m) { float* rowp = out + (size_t)(row0 + ai * HALF + m * 16) * 1024 + u.pn * BM + wc * 32 + fq * 4;
#pragma unroll
                for (int bj = 0; bj < 2; ++bj)
#pragma unroll
                    for (int n = 0; n < 2; ++n) { f32x4* p = (f32x4*)(rowp + bj * HALF + n * 16); *p = *p + acc[ai][bj][m][n]; } }
    }
};
struct EpiMoe1 {
    static constexpr bool PERM = true, AFTER_DRAIN = false; bf16* hmid;
    __device__ __forceinline__ void operator()(const f32x4 (&acc)[2][2][4][2], const Unit& u, int wr, int wc, int fr, int fq) const {
        const int row0 = u.pm * BM + wr * 64 + fr;
#pragma unroll
        for (int ai = 0; ai < 2; ++ai)
#pragma unroll
            for (int m = 0; m < 4; ++m) { const int row = row0 + ai * HALF + m * 16;
                f32x4 o[2];
#pragma unroll
                for (int n = 0; n < 2; ++n) { const f32x4 x = acc[ai][0][m][n], y = acc[ai][1][m][n]; o[n] = (f32x4){siluf(x.x) * y.x, siluf(x.y) * y.y, siluf(x.z) * y.z, siluf(x.w) * y.w}; }
                *(u32x4*)(hmid + (size_t)row * 256 + u.pn * HALF + wc * 32 + fq * 8) = pack8(o[0], o[1]); }
    }
};
struct EpiMoe2 {
    static constexpr bool PERM = true, AFTER_DRAIN = false; bf16* ys; const float* slotc;
    __device__ __forceinline__ void operator()(const f32x4 (&acc)[2][2][4][2], const Unit& u, int wr, int wc, int fr, int fq) const {
        const int row0 = u.pm * BM + wr * 64 + fr;
#pragma unroll
        for (int ai = 0; ai < 2; ++ai)
#pragma unroll
            for (int m = 0; m < 4; ++m) { const int row = row0 + ai * HALF + m * 16; const float c = slotc[row];
#pragma unroll
                for (int bj = 0; bj < 2; ++bj) *(u32x4*)(ys + (size_t)row * 1024 + u.pn * BM + bj * HALF + wc * 32 + fq * 8) = pack8(acc[ai][bj][m][0] * c, acc[ai][bj][m][1] * c); }
    }
};
template <class Epi, class Sched, bool ALIGN_EPI = false, bool SP2 = false>
__device__ __forceinline__ void gemm_phase(PG8_LAS unsigned char* lds, const Gemm g, const Sched& S, const Epi& E) {
    const int tid = otid(), wid = __builtin_amdgcn_readfirstlane(tid >> 6), lane = tid & 63, wr = wid >> 2, wc = wid & 3, fr = lane & 15, fq = lane >> 4;
    int Kq = g.K; asm volatile("" : "+s"(Kq));
    const int K = Kq, nt = K / BK;
    unsigned voffA[2], voffB[2];
#pragma unroll
    for (int i = 0; i < 2; ++i) { int R, C; stage_rc(tid * 16 + i * 8192, R, C); const int Rb = Epi::PERM ? ((R & ~31) + perm32(R & 31)) : R;
        voffA[i] = (unsigned)(R * g.lda + C) * 2u; voffB[i] = (unsigned)(Rb * g.ldb + C) * 2u; }
    const size_t kstep = (size_t)(BK * 2);
    const size_t hstepA = (size_t)HALF * g.lda * 2, hstepB = (size_t)HALF * g.ldb * 2;
    const unsigned ldsw = (unsigned)wid * 1024u;
    const int aoff = lds_byte(wr * 64 + fr, fq * 8), boff = lds_byte(wc * 32 + fr, fq * 8);
#define PG8_SA(b, h) (((b) * 2 + (h)) * HTB)
#define PG8_SB(b, h) ((4 + (b) * 2 + (h)) * HTB)
#define PG8_STAGE(bufoff, gbase, voff) do { _Pragma("unroll") for (int _i = 0; _i < 2; ++_i) \
        __builtin_amdgcn_global_load_lds((const unsigned*)((const char*)(gbase) + (voff)[_i]), (PG8_LAS unsigned*)(lds + (bufoff) + ldsw + _i * 8192), 16, 0, 0); } while (0)
#define PG8_LDA(dst, b, h) do { _Pragma("unroll") for (int m = 0; m < 4; ++m) _Pragma("unroll") for (int k = 0; k < 2; ++k) dst[m][k] = *(const PG8_LAS bf16x8*)(lds + PG8_SA(b, h) + aoff + m * 2048 + k * 1024); } while (0)
#define PG8_LDB(dst, b, h) do { _Pragma("unroll") for (int n = 0; n < 2; ++n) _Pragma("unroll") for (int k = 0; k < 2; ++k) dst[n][k] = *(const PG8_LAS bf16x8*)(lds + PG8_SB(b, h) + boff + n * 2048 + k * 1024); } while (0)
#define PG8_MMA(ai, bj, At, Bt) do { __builtin_amdgcn_s_setprio(1); _Pragma("unroll") for (int m = 0; m < 4; ++m) _Pragma("unroll") for (int n = 0; n < 2; ++n) _Pragma("unroll") for (int k = 0; k < 2; ++k) \
        acc[ai][bj][m][n] = __builtin_amdgcn_mfma_f32_16x16x32_bf16(Bt[n][k], At[m][k], acc[ai][bj][m][n], 0, 0, 0); __builtin_amdgcn_s_setprio(0); } while (0)
#define PG8_WAIT_V(n) asm volatile("s_waitcnt vmcnt(" #n ")" ::: "memory")
#define PG8_WAIT_L(n) asm volatile("s_waitcnt lgkmcnt(" #n ")" ::: "memory")
#define PG8_BAR __builtin_amdgcn_s_barrier()
#define PG8_SCHED __builtin_amdgcn_sched_barrier(0)
    Unit cur, nxt; int ui = 0;
    if (!S.next(0, cur)) return;
    f32x4 acc[2][2][4][2];
#pragma unroll
    for (int a = 0; a < 2; ++a)
#pragma unroll
        for (int b = 0; b < 2; ++b)
#pragma unroll
            for (int m = 0; m < 4; ++m)
#pragma unroll
                for (int n = 0; n < 2; ++n) acc[a][b][m][n] = (f32x4){0.f, 0.f, 0.f, 0.f};
    bf16x8 At[4][2], B0[2][2], B1[2][2];
    const char* cA = S.a_ptr(g, cur); const char* cB = S.b_ptr(g, cur);
    S.a_ready(cur);
    if constexpr (SP2) {
        PG8_STAGE(PG8_SB(0, 0), cB, voffB); PG8_STAGE(PG8_SB(0, 1), cB + hstepB, voffB); PG8_STAGE(PG8_SA(0, 0), cA, voffA); PG8_STAGE(PG8_SA(0, 1), cA + hstepA, voffA);
        if (wr == 1) PG8_BAR;
        PG8_WAIT_V(2); PG8_BAR;
        PG8_STAGE(PG8_SB(1, 0), cB + kstep, voffB); PG8_STAGE(PG8_SA(1, 0), cA + kstep, voffA); PG8_STAGE(PG8_SB(1, 1), cB + hstepB + kstep, voffB);
        PG8_WAIT_V(6); PG8_BAR;
    } else {
        PG8_STAGE(PG8_SB(0, 0), cB, voffB); PG8_STAGE(PG8_SA(0, 0), cA, voffA); PG8_STAGE(PG8_SB(0, 1), cB + hstepB, voffB); PG8_STAGE(PG8_SA(0, 1), cA + hstepA, voffA);
        if (wr == 1) PG8_BAR;
        PG8_WAIT_V(4); PG8_BAR;
        PG8_STAGE(PG8_SB(1, 0), cB + kstep, voffB); PG8_STAGE(PG8_SA(1, 0), cA + kstep, voffA); PG8_STAGE(PG8_SB(1, 1), cB + hstepB + kstep, voffB);
        PG8_WAIT_V(6); PG8_BAR;
    }
    for (;;) {
        const bool has_next = S.next(ui + 1, nxt);
        const char* nA = has_next ? S.a_ptr(g, nxt) : cA; const char* nB = has_next ? S.b_ptr(g, nxt) : cB;
        for (int t = 0; t < nt; t += 2) {
            const bool last = (t == nt - 2);
            const char* a1 = cA + (size_t)(t + 1) * kstep;
            const char* a2 = last ? nA : cA + (size_t)(t + 2) * kstep; const char* b2 = last ? nB : cB + (size_t)(t + 2) * kstep;
            const char* a3 = a2 + kstep; const char* b3 = b2 + kstep;
            if (last && has_next) S.a_ready(nxt);
            if constexpr (SP2) {
            PG8_LDB(B0, 0, 0); PG8_LDB(B1, 0, 1); PG8_SCHED; PG8_LDA(At, 0, 0); PG8_STAGE(PG8_SA(1, 1), a1 + hstepA, voffA);
            PG8_WAIT_V(8); PG8_WAIT_L(0); PG8_BAR; PG8_MMA(0, 0, At, B0); PG8_MMA(0, 1, At, B1); PG8_BAR; PG8_SCHED;
            PG8_LDA(At, 0, 1); PG8_STAGE(PG8_SB(0, 0), b2, voffB); PG8_STAGE(PG8_SB(0, 1), b2 + hstepB, voffB); PG8_STAGE(PG8_SA(0, 0), a2, voffA);
            PG8_WAIT_V(8); PG8_WAIT_L(0); PG8_BAR; PG8_MMA(1, 0, At, B0); PG8_MMA(1, 1, At, B1); PG8_BAR; PG8_SCHED;
            PG8_LDB(B0, 1, 0); PG8_LDB(B1, 1, 1); PG8_SCHED; PG8_LDA(At, 1, 0); PG8_STAGE(PG8_SA(0, 1), a2 + hstepA, voffA);
            PG8_WAIT_V(8); PG8_WAIT_L(0); PG8_BAR; PG8_MMA(0, 0, At, B0); PG8_MMA(0, 1, At, B1); PG8_BAR; PG8_SCHED;
            PG8_LDA(At, 1, 1); PG8_STAGE(PG8_SB(1, 0), b3, voffB); PG8_STAGE(PG8_SB(1, 1), b3 + hstepB, voffB); PG8_STAGE(PG8_SA(1, 0), a3, voffA);
            PG8_WAIT_V(8); PG8_WAIT_L(0); PG8_BAR; PG8_MMA(1, 0, At, B0); PG8_MMA(1, 1, At, B1); PG8_BAR; PG8_SCHED;
            } else {
            PG8_LDB(B0, 0, 0); PG8_SCHED; PG8_LDA(At, 0, 0); PG8_STAGE(PG8_SA(1, 1), a1 + hstepA, voffA);
            PG8_WAIT_L(8); PG8_BAR; PG8_WAIT_L(0); PG8_MMA(0, 0, At, B0); PG8_BAR; PG8_SCHED;
            PG8_LDB(B1, 0, 1); PG8_STAGE(PG8_SB(0, 0), b2, voffB);
            PG8_BAR; PG8_WAIT_L(0); PG8_MMA(0, 1, At, B1); PG8_BAR;
            PG8_LDA(At, 0, 1); PG8_STAGE(PG8_SA(0, 0), a2, voffA);
            PG8_BAR; PG8_WAIT_L(0); PG8_MMA(1, 0, At, B0); PG8_BAR; PG8_SCHED;
            PG8_STAGE(PG8_SB(0, 1), b2 + hstepB, voffB);
            PG8_WAIT_V(6); PG8_BAR; PG8_MMA(1, 1, At, B1); PG8_BAR;
            PG8_LDB(B0, 1, 0); PG8_SCHED; PG8_LDA(At, 1, 0); PG8_STAGE(PG8_SA(0, 1), a2 + hstepA, voffA);
            PG8_WAIT_L(8); PG8_BAR; PG8_WAIT_L(0); PG8_MMA(0, 0, At, B0); PG8_BAR; PG8_SCHED;
            PG8_LDB(B1, 1, 1); PG8_STAGE(PG8_SB(1, 0), b3, voffB);
            PG8_BAR; PG8_WAIT_L(0); PG8_MMA(0, 1, At, B1); PG8_BAR;
            PG8_LDA(At, 1, 1); PG8_STAGE(PG8_SA(1, 0), a3, voffA);
            PG8_BAR; PG8_WAIT_L(0); PG8_MMA(1, 0, At, B0); PG8_BAR; PG8_SCHED;
            PG8_STAGE(PG8_SB(1, 1), b3 + hstepB, voffB);
            PG8_WAIT_V(6); PG8_BAR; PG8_MMA(1, 1, At, B1); PG8_BAR;
            }
        }
        if constexpr (ALIGN_EPI) { if (wr == 0) PG8_BAR; }
        if constexpr (!Epi::AFTER_DRAIN) { E(acc, cur, wr, wc, fr, fq); S.done(cur); }
        if (!has_next) break;
#pragma unroll
        for (int a = 0; a < 2; ++a)
#pragma unroll
            for (int b = 0; b < 2; ++b)
#pragma unroll
                for (int m = 0; m < 4; ++m)
#pragma unroll
                    for (int n = 0; n < 2; ++n) acc[a][b][m][n] = (f32x4){0.f, 0.f, 0.f, 0.f};
        cur = nxt; cA = nA; cB = nB; ++ui;
        if constexpr (ALIGN_EPI) { if (wr == 1) PG8_BAR; }
    }
    PG8_WAIT_V(0);
    if constexpr (!ALIGN_EPI) { if (wr == 0) PG8_BAR; }
    PG8_BAR;
    if constexpr (Epi::AFTER_DRAIN) { E.fused(acc, cur, wr, wc, fr, fq, lds, wid, lane); S.done(cur); }
#undef PG8_SA
#undef PG8_SB
#undef PG8_STAGE
#undef PG8_LDA
#undef PG8_LDB
#undef PG8_MMA
#undef PG8_WAIT_V
#undef PG8_WAIT_L
#undef PG8_BAR
#undef PG8_SCHED
}
}

__device__ __forceinline__ int map_row(int map, int n) {
    if (map == 0) return n;
    if (map == 1) {
        if (n < 1280) return n;
        if (n < 1304) return 2304 + (n - 1280);
        if (n < 1560) return 1280 + (n - 1304);
        if (n < 2328) return 1536 + (n - 1560);
        return 2560 + (n - 2328);
    }
    if (map == 2) return (n >> 7) * 256 + (n & 127);
    return (n >> 7) * 256 + 128 + (n & 127);
}
__device__ __forceinline__ void xpose_tile(const float* __restrict__ src, int K, int Ns, bf16* dst, int map, int k0, int n0, LAS float* tile) {
    const int tid = otid();
    { const int nl = tid & 63, ks = tid >> 6, n = n0 + nl;
      for (int kk = ks; kk < 64; kk += 8) tile[kk * 65 + nl] = (n < Ns) ? src[(size_t)(k0 + kk) * Ns + n] : 0.f; }
    __syncthreads();
    { const int kl = tid & 63, ns = tid >> 6;
      for (int nn = ns; nn < 64; nn += 8) { const int n = n0 + nn; if (n < Ns) dst[(size_t)map_row(map, n) * K + k0 + kl] = (bf16)f2bf(tile[kl * 65 + nn]); } }
    __syncthreads();
}
__device__ __forceinline__ void xpose_matrix(const Frame& F, const float* src, int K, int Ns, bf16* dst, int map, int nbatch = 1, size_t sstride = 0, size_t dstride = 0) {
    const int nkt = K / 64, nnt = (Ns + 63) / 64, per = nkt * nnt;
    for (int it = blockIdx.x; it < per * nbatch; it += F.G) { const int bt = it / per, r = it % per;
        xpose_tile(src + (size_t)bt * sstride, K, Ns, dst + (size_t)bt * dstride, map, (r % nkt) * 64, (r / nkt) * 64, (LAS float*)F.lds); }
}
__device__ __forceinline__ void phase_weights(const Frame& F0, int l) { const Frame F = launder(F0);
    bf16* WIN = WSP(bf16, OFF_WIN);
    for (size_t i = (size_t)blockIdx.x * 512 + F.tid; i < (size_t)(2560 - 2328) * 1024 / 2; i += (size_t)F.G * 512) ((unsigned*)(WIN + (size_t)2328 * 1024))[i] = 0u;
    for (size_t i = (size_t)blockIdx.x * 512 + F.tid; i < (size_t)2 * 64 * 256 / 2; i += (size_t)F.G * 512) WSP(unsigned, OFF_CW2)[(i / 8192) * 16384 + 8192 + (i % 8192)] = 0u;
    __syncthreads();
    xpose_matrix(F, F.in[2] + (size_t)l * 1024 * IN_DIM, 1024, IN_DIM, WIN, 1);
    for (int s = 0; s < 2; ++s) {
        xpose_matrix(F, F.in[4] + ((size_t)l * 2 + s) * 2048 * 256, 2048, 256, WSP(bf16, OFF_CW1) + (size_t)s * 256 * 2048, 0);
        xpose_matrix(F, F.in[5] + ((size_t)l * 2 + s) * 256 * 64, 256, 64, WSP(bf16, OFF_CW2) + (size_t)s * 128 * 256, 0);
    }
    xpose_matrix(F, F.in[6] + (size_t)l * 512 * 1024, 512, 1024, WSP(bf16, OFF_WN), 0);
    xpose_matrix(F, F.in[9] + (size_t)l * 256 * 1024, 256, 1024, WSP(bf16, OFF_WP), 0);
    xpose_matrix(F, F.in[11] + (size_t)l * 256 * 1024, 256, 1024, WSP(bf16, OFF_WC), 0);
    xpose_matrix(F, F.in[12] + (size_t)l * 1024 * 1024, 1024, 1024, WSP(bf16, OFF_WO), 0);
    xpose_matrix(F, F.in[18] + (size_t)l * NEXP * 1024 * 256, 1024, 256, WSP(bf16, OFF_W13), 2, NEXP, (size_t)1024 * 256, (size_t)512 * 1024);
    xpose_matrix(F, F.in[19] + (size_t)l * NEXP * 1024 * 256, 1024, 256, WSP(bf16, OFF_W13), 3, NEXP, (size_t)1024 * 256, (size_t)512 * 1024);
    xpose_matrix(F, F.in[20] + (size_t)l * NEXP * 256 * 1024, 256, 1024, WSP(bf16, OFF_W2), 0, NEXP, (size_t)256 * 1024, (size_t)1024 * 256);
    for (int it = blockIdx.x * 8 + F.wave; it < 8; it += F.G * 8) {
        const int s = it >> 2, j = (it & 3) * 64 + F.lane;
        const float* pe = F.in[3] + ((size_t)l * 2 + s) * 2048; const float* w1 = F.in[4] + ((size_t)l * 2 + s) * 2048 * 256;
        float a = 0.f;
        for (int k = 0; k < 2048; ++k) a += pe[k] * w1[(size_t)k * 256 + j];
        WSP(float, OFF_CB1)[s * 256 + j] = a;
    }
}

template <bool FINAL> __device__ __forceinline__ void phase_norm(const Frame& F0, int l, const float* g) { const Frame F = launder(F0);
    const int gw = blockIdx.x * 8 + F.wave, NGW = F.G * 8;
    const int* toks = WSP(int, OFF_TOKS); const bf16* ys = WSP(bf16, OFF_YS); bf16* xn = WSP(bf16, OFF_XN);
    for (int n = gw; n < NTOK; n += NGW) {
        f32x4 v[4]; float ss = 0.f;
        if (l == 0) {
            const f32x4* xr = (const f32x4*)(F.in[0] + (size_t)n * D) + F.lane;
#pragma unroll
            for (int j = 0; j < 4; ++j) v[j] = xr[64 * j];
        } else {
            const f32x4* hr = (const f32x4*)(F.out + (size_t)n * D) + F.lane;
            const int s0 = toks[n * 2], s1 = toks[n * 2 + 1];
            const bf16* y0 = ys + (size_t)s0 * D + F.lane * 4; const bf16* y1 = ys + (size_t)s1 * D + F.lane * 4;
#pragma unroll
            for (int j = 0; j < 4; ++j) v[j] = hr[64 * j] + ld4bf(y0 + 256 * j) + ld4bf(y1 + 256 * j);
        }
#pragma unroll
        for (int j = 0; j < 4; ++j) ss += (v[j].x * v[j].x + v[j].y * v[j].y) + (v[j].z * v[j].z + v[j].w * v[j].w);
        const float rs = 1.f / sqrtf(wave_sum(ss) * (1.f / D) + RMS_EPS);
        f32x4* orow = (f32x4*)(F.out + (size_t)n * D) + F.lane;
#pragma unroll
        for (int j = 0; j < 4; ++j) {
            const f32x4 gg = ((const f32x4*)g)[F.lane + 64 * j];
            const f32x4 y = v[j] * rs * gg;
            if (FINAL) orow[64 * j] = y;
            else { orow[64 * j] = v[j]; st4bf(xn + (size_t)n * D + F.lane * 4 + 256 * j, y); }
        }
    }
}

__device__ __forceinline__ void epi_inproj(const Frame& F, int row, int col, f32x4 v) {
    if (col < 512) { st4bf(WSP(bf16, OFF_Q) + (size_t)row * 512 + col, v); }
    else if (col < 1280) {
        const int c = col - 512, s = c >> 7, g = (c >> 6) & 1, d = c & 63, b = row >> 14, t = row & (T - 1);
        bf16* dst;
        if (s < 2) dst = WSP(bf16, OFF_KVC) + ((size_t)((b * 2 + g) * 2 + s) * TP + t) * 64 + d;
        else dst = WSP(bf16, OFF_KS + (size_t)(s - 2) * SZ_KV) + ((size_t)(b * 2 + g) * T + t) * 64 + d;
        st4bf(dst, v);
    }
    else if (col < 1536) { st4bf(WSP(bf16, OFF_PU) + (size_t)row * 256 + (col - 1280), v); }
    else if (col < 2304) { const int c = col - 1536; st4bf(WSP(bf16, OFF_CH + (size_t)(c >> 8) * SZ_C256) + (size_t)row * 256 + (c & 255), v); }
    else if (col < 2560) { const int c = col - 2304; if (c < 32) *(f32x4*)(WSP(float, OFF_NG) + (size_t)row * 32 + c) = (f32x4){sigmoidf(v.x), sigmoidf(v.y), sigmoidf(v.z), sigmoidf(v.w)}; }
    else { st4bf(WSP(bf16, OFF_MG) + (size_t)row * 3072 + (col - 2560), (f32x4){sigmoidf(v.x), sigmoidf(v.y), sigmoidf(v.z), sigmoidf(v.w)}); }
}
__device__ __forceinline__ void phase_inproj(const Frame& F0) { const Frame F = launder(F0);
    const bf16* XN = WSP(bf16, OFF_XN); const bf16* W = WSP(bf16, OFF_WIN);
    constexpr int NT = INP / 128, MT = NTOK / 128;
    for (int it = blockIdx.x; it < MT * NT; it += F.G) {
        const int mt = it / NT, nt = it % NT;
        f32x4 acc[4][2]; ACC_ZERO(acc);
        gemm_tile_128(acc, XN + (size_t)mt * 128 * D, D, W + (size_t)nt * 128 * D, D, D, F.lds);
        TILE_FOREACH(acc, mt * 128, nt * 128, { epi_inproj(F, ROW, COL, V); });
    }
}

__device__ __forceinline__ float gelu_tanh(float x) { const float u = 0.7978845608028654f * (x + 0.044715f * x * x * x); return 0.5f * x * (1.f + tanhf(u)); }
__device__ __forceinline__ void phase_cmp1(const Frame& F0) { const Frame F = launder(F0);
    const bf16* KVC = WSP(bf16, OFF_KVC); bf16* HC = WSP(bf16, OFF_HC); const float* cb1 = WSP(float, OFF_CB1);
    for (int it = blockIdx.x; it < 64 * 2; it += F.G) {
        const int mt = it >> 1, nt = it & 1, plane = mt >> 3, i0 = (mt & 7) * 128, s = plane & 1;
        f32x4 acc[4][2]; ACC_ZERO(acc);
        gemm_tile_128(acc, KVC + (size_t)plane * TP * 64 + (size_t)i0 * 1024, 1024, WSP(bf16, OFF_CW1) + (size_t)s * 256 * 2048 + (size_t)nt * 128 * 2048, 2048, 2048, F.lds);
        TILE_FOREACH(acc, mt * 128, nt * 128, {
            const f32x4 bb = *(const f32x4*)(cb1 + s * 256 + COL);
            st4bf(HC + (size_t)ROW * 256 + COL, (f32x4){gelu_tanh(V.x + bb.x), gelu_tanh(V.y + bb.y), gelu_tanh(V.z + bb.z), gelu_tanh(V.w + bb.w)}); });
    }
}
__device__ __forceinline__ void phase_cmp2(const Frame& F0) { const Frame F = launder(F0);
    const bf16* HC = WSP(bf16, OFF_HC);
    for (int it = blockIdx.x; it < 64; it += F.G) {
        const int mt = it, plane = mt >> 3, s = plane & 1, bg = plane >> 1;
        f32x4 acc[4][2]; ACC_ZERO(acc);
        gemm_tile_128(acc, HC + (size_t)mt * 128 * 256, 256, WSP(bf16, OFF_CW2) + (size_t)s * 128 * 256, 256, 256, F.lds);
        bf16* dst = WSP(bf16, s == 0 ? OFF_KC : OFF_VC) + (size_t)bg * 1024 * 64;
        if (ATTN_MFMA && s == 1) {
            TILE_FOREACH(acc, (mt & 7) * 128, 0, { if (COL < 64) { f32x4 o = V; if (ROW == 1023) o = o * 0.f;
                bf16* vb = dst + (size_t)(ROW >> 6) * 4096 + (size_t)COL * 64 + (ROW & 48) + swap23(ROW & 15);
                vb[0] = (bf16)f2bf(o.x); vb[64] = (bf16)f2bf(o.y); vb[128] = (bf16)f2bf(o.z); vb[192] = (bf16)f2bf(o.w); } });
        } else {
            TILE_FOREACH(acc, (mt & 7) * 128, 0, { if (COL < 64) { f32x4 o = V; if (ROW == 1023) o = o * 0.f; st4bf(dst + (size_t)ROW * 64 + COL, o); } });
        }
    }
}

__device__ __forceinline__ void phase_poolconv(const Frame& F0, int l) { const Frame F = launder(F0);
    LAS float* pw = (LAS float*)F.lds;
    LAS float* ps = (LAS float*)(F.lds + 65536) + F.wave * 64;
    const float* pwg = F.in[7] + (size_t)l * 4 * 64 * 64;
    for (int i = F.tid; i < 4 * 64 * 64; i += 512) pw[i] = pwg[i];
    __syncthreads();
    const bf16* PU = WSP(bf16, OFF_PU); const bf16* CH = WSP(bf16, OFF_CH); const bf16* CBp = WSP(bf16, OFF_CB); const bf16* CC = WSP(bf16, OFF_CC);
    bf16* PM = WSP(bf16, OFF_PM); bf16* CV = WSP(bf16, OFF_CV);
    const float* pscale = F.in[8] + (size_t)l * 256; const float* cw = F.in[10] + (size_t)l * 3 * 256;
    for (int n = blockIdx.x * 8 + F.wave; n < NTOK; n += F.G * 8) {
        const int t = n & (T - 1);
#pragma unroll
        for (int g = 0; g < 4; ++g) {
            const int w = 2 << g, cnt = (t + 1 < w) ? (t + 1) : w;
            const float u0 = bf2f(PU[(size_t)n * 256 + g * 64 + F.lane]);
            float s = u0;
            for (int i = 1; i < cnt; ++i) s += bf2f(PU[(size_t)(n - i) * 256 + g * 64 + F.lane]);
            ps[F.lane] = s / (float)cnt - u0;
            WAVE_SYNC();
            float a = 0.f;
#pragma unroll 8
            for (int c = 0; c < 64; ++c) a += ps[c] * pw[(g * 64 + c) * 64 + F.lane];
            PM[(size_t)n * 256 + g * 64 + F.lane] = (bf16)f2bf(a * pscale[g * 64 + F.lane]);
            WAVE_SYNC();
        }
        {
            const int c0 = F.lane * 4; f32x4 y = {0.f, 0.f, 0.f, 0.f};
#pragma unroll
            for (int k = 0; k < 3; ++k) { const int tt = t - 2 + k; if (tt >= 0) { const size_t r = (size_t)(n - 2 + k) * 256 + c0;
                y += *(const f32x4*)(cw + k * 256 + c0) * ld4bf(CC + r) * ld4bf(CH + r); } }
            st4bf(CV + (size_t)n * 256 + c0, y * ld4bf(CBp + (size_t)n * 256 + c0));
        }
    }
}

__device__ __forceinline__ void dot4(const bf16* krow, const LAS float* qs, float (&acc)[4]) {
#pragma unroll
    for (int c = 0; c < 8; ++c) {
        const uint4 kv = ((const uint4*)krow)[c];
        const float k0 = bf2f(kv.x & 0xffffu), k1 = bf2f(kv.x >> 16), k2 = bf2f(kv.y & 0xffffu), k3 = bf2f(kv.y >> 16), k4 = bf2f(kv.z & 0xffffu), k5 = bf2f(kv.z >> 16), k6 = bf2f(kv.w & 0xffffu), k7 = bf2f(kv.w >> 16);
#pragma unroll
        for (int r = 0; r < 4; ++r) { const LAS float* q = qs + r * 64 + c * 8;
            acc[r] += (k0 * q[0] + k1 * q[1]) + (k2 * q[2] + k3 * q[3]) + (k4 * q[4] + k5 * q[5]) + (k6 * q[6] + k7 * q[7]); }
    }
}
__device__ __forceinline__ void softmax4(LAS float* sc, int n, int lane) {
#pragma unroll
    for (int r = 0; r < 4; ++r) {
        LAS float* s = sc + r * 1024; float m = -INFINITY;
        for (int c = lane; c < n; c += 64) m = fmaxf(m, s[c]);
        m = wave_max(m);
        float sum = 0.f;
        for (int c = lane; c < n; c += 64) { const float e = __expf(s[c] - m); s[c] = e; sum += e; }
        sum = wave_sum(sum);
        const float inv = 1.f / sum;
        for (int c = lane; c < n; c += 64) s[c] *= inv;
    }
}
__device__ __forceinline__ void phase_attn_valu(const Frame& F0) { const Frame F = launder(F0);
    LAS float* sc = (LAS float*)(F.lds + F.wave * 17472); LAS float* qs = sc + 4096; LAS int* sel = (LAS int*)(qs + 256);
    const int lane = F.lane;
    const bf16* Q = WSP(bf16, OFF_Q); const float* NG = WSP(float, OFF_NG); bf16* O = WSP(bf16, OFF_O);
    for (int task = blockIdx.x * 8 + F.wave; task < 2 * NTOK; task += F.G * 8) {
        const int bg = task >> 14, t = task & (T - 1), b = bg >> 1, g = bg & 1, n = b * T + t;
        { const f32x4 q4 = ld4bf(Q + (size_t)n * 512 + g * 256 + lane * 4); *(LAS f32x4*)(qs + lane * 4) = q4; }
        WAVE_SYNC();
        float slope[4];
#pragma unroll
        for (int r = 0; r < 4; ++r) slope[r] = exp2f(-(float)(g * 4 + r + 1));
        const int ncv = (t >= 31) ? ((t - 31) >> 4) + 1 : 0;
        const bf16* kc = WSP(bf16, OFF_KC) + (size_t)bg * 1024 * 64; const bf16* vc = WSP(bf16, OFF_VC) + (size_t)bg * 1024 * 64;
        for (int c = lane; c < ncv; c += 64) {
            float a[4] = {0.f, 0.f, 0.f, 0.f}; dot4(kc + (size_t)c * 64, qs, a);
            const float dist = (float)(t - (16 * c + 31));
#pragma unroll
            for (int r = 0; r < 4; ++r) sc[r * 1024 + c] = a[r] * 0.125f - slope[r] * dist;
        }
        WAVE_SYNC();
        float oc[4] = {0.f, 0.f, 0.f, 0.f};
        if (ncv > 0) {
            softmax4(sc, ncv, lane);
            WAVE_SYNC();
            for (int c = 0; c < ncv; ++c) { const float v = bf2f(vc[(size_t)c * 64 + lane]);
#pragma unroll
                for (int r = 0; r < 4; ++r) oc[r] += sc[r * 1024 + c] * v; }
            WAVE_SYNC();
            for (int c = lane; c < ncv; c += 64) sc[c] = (sc[c] + sc[1024 + c]) + (sc[2048 + c] + sc[3072 + c]);
        }
        WAVE_SYNC();
        const int cur = t >> 6;
        float val[4];
#pragma unroll
        for (int i = 0; i < 4; ++i) {
            const int j = lane + 64 * i; float imp = 0.f;
#pragma unroll
            for (int o = 0; o < 5; ++o) { const int c = 4 * j + o - 1; if (c >= 0 && c < ncv) imp += sc[c]; }
            const bool forced = (j == 0) || (j == cur) || (j == cur - 1), valid = (j <= cur);
            val[i] = forced ? 1e30f : (valid ? imp : -1e30f);
        }
        WAVE_SYNC();
        int nsel = 0;
        for (int it = 0; it < 16; ++it) {
            float bv = val[0]; int bj = lane;
#pragma unroll
            for (int i = 1; i < 4; ++i) if (val[i] > bv) { bv = val[i]; bj = lane + 64 * i; }
#pragma unroll
            for (int o = 1; o < 64; o <<= 1) { const float ov = __shfl_xor(bv, o); const int oj = __shfl_xor(bj, o); if (ov > bv || (ov == bv && oj < bj)) { bv = ov; bj = oj; } }
            if (bv < -1e29f) break;
            if (lane == 0) sel[nsel] = bj;
            ++nsel;
#pragma unroll
            for (int i = 0; i < 4; ++i) if (bj == lane + 64 * i) val[i] = -INFINITY;
        }
        WAVE_SYNC();
        const bf16* ks = WSP(bf16, OFF_KS) + (size_t)bg * T * 64; const bf16* vs = WSP(bf16, OFF_VS) + (size_t)bg * T * 64;
        for (int i = 0; i < nsel; ++i) {
            const int pos = sel[i] * 64 + lane;
            float a[4] = {0.f, 0.f, 0.f, 0.f}; dot4(ks + (size_t)pos * 64, qs, a);
            const float dist = (float)(t - pos);
#pragma unroll
            for (int r = 0; r < 4; ++r) sc[r * 1024 + i * 64 + lane] = (pos <= t) ? a[r] * 0.125f - slope[r] * dist : -INFINITY;
        }
        WAVE_SYNC();
        softmax4(sc, nsel * 64, lane);
        WAVE_SYNC();
        float os[4] = {0.f, 0.f, 0.f, 0.f};
        for (int i = 0; i < nsel; ++i) { const bf16* vb = vs + (size_t)sel[i] * 64 * 64 + lane;
            for (int k = 0; k < 64; ++k) { const float v = bf2f(vb[k * 64]);
#pragma unroll
                for (int r = 0; r < 4; ++r) os[r] += sc[r * 1024 + i * 64 + k] * v; } }
        WAVE_SYNC();
        const bf16* kw = WSP(bf16, OFF_KW) + (size_t)bg * T * 64; const bf16* vw = WSP(bf16, OFF_VW) + (size_t)bg * T * 64;
        const int lo = (t >= 511) ? t - 511 : 0, nk = t - lo + 1;
        for (int i = lane; i < nk; i += 64) {
            const int pos = lo + i;
            float a[4] = {0.f, 0.f, 0.f, 0.f}; dot4(kw + (size_t)pos * 64, qs, a);
            const float dist = (float)(t - pos);
#pragma unroll
            for (int r = 0; r < 4; ++r) sc[r * 1024 + i] = a[r] * 0.125f - slope[r] * dist;
        }
        WAVE_SYNC();
        softmax4(sc, nk, lane);
        WAVE_SYNC();
        float ow[4] = {0.f, 0.f, 0.f, 0.f};
        for (int i = 0; i < nk; ++i) { const float v = bf2f(vw[(size_t)(lo + i) * 64 + lane]);
#pragma unroll
            for (int r = 0; r < 4; ++r) ow[r] += sc[r * 1024 + i] * v; }
        WAVE_SYNC();
        const float* ng = NG + (size_t)n * 32 + g * 12;
#pragma unroll
        for (int r = 0; r < 4; ++r) O[(size_t)n * 512 + g * 256 + r * 64 + lane] = (bf16)f2bf(ng[r * 3] * oc[r] + ng[r * 3 + 1] * os[r] + ng[r * 3 + 2] * ow[r]);
    }
}


typedef float f32x16 __attribute__((ext_vector_type(16)));
typedef float f32x2_t __attribute__((ext_vector_type(2))); typedef __bf16 bf16x2_t __attribute__((ext_vector_type(2)));
__device__ __forceinline__ unsigned cvtpk(float lo, float hi) { f32x2_t v = {lo, hi}; bf16x2_t b = __builtin_convertvector(v, bf16x2_t); return __builtin_bit_cast(unsigned, b); }
__device__ __forceinline__ float pmax32(float x) { auto rr = __builtin_amdgcn_permlane32_swap(__float_as_uint(x), __float_as_uint(x), false, false); return fmaxf(__uint_as_float(rr[0]), __uint_as_float(rr[1])); }
__device__ __forceinline__ float psum32(float x) { auto rr = __builtin_amdgcn_permlane32_swap(__float_as_uint(x), __float_as_uint(x), false, false); return __uint_as_float(rr[0]) + __uint_as_float(rr[1]); }
__device__ __forceinline__ float ex2(float x) { return __builtin_amdgcn_exp2f(x); }
constexpr float ANEG = -1e30f;
#define KKC(kh, i) ((kh) * 32 + ((i) & 3) + 8 * ((i) >> 2))
struct AttnSt { f32x16 o0, o1; float m, l; };
__device__ __forceinline__ void attn_loadk(bf16x8 (&kf)[2][4], const bf16* kt, int r32, int h) {
#pragma unroll
    for (int kh = 0; kh < 2; ++kh)
#pragma unroll
        for (int ks = 0; ks < 4; ++ks) kf[kh][ks] = *(const bf16x8*)(kt + (kh * 32 + r32) * 64 + ks * 16 + h * 8);
}
template <int MODE> __device__ __forceinline__ void attn_scores(f32x16& s0, f32x16& s1, const bf16x8 (&kf)[2][4], const bf16x8 (&qf)[4], float cb, float slk, int lo, int hi, int h) {
    asm volatile("" : "+v"(slk));
    const float cbh = cb + slk * (float)(4 * h);
#pragma unroll
    for (int i = 0; i < 16; ++i) { s0[i] = cbh + slk * (float)KKC(0, i); s1[i] = cbh + slk * (float)KKC(1, i); }
#pragma unroll
    for (int ks = 0; ks < 4; ++ks) { s0 = __builtin_amdgcn_mfma_f32_32x32x16_bf16(kf[0][ks], qf[ks], s0, 0, 0, 0); s1 = __builtin_amdgcn_mfma_f32_32x32x16_bf16(kf[1][ks], qf[ks], s1, 0, 0, 0); }
    if (MODE) { const int hh = hi - 4 * h, ll = lo - 4 * h;
#pragma unroll
        for (int i = 0; i < 16; ++i) {
            const bool v0 = (KKC(0, i) <= hh) && (MODE == 1 || KKC(0, i) >= ll), v1 = (KKC(1, i) <= hh) && (MODE == 1 || KKC(1, i) >= ll);
            s0[i] = v0 ? s0[i] : ANEG; s1[i] = v1 ? s1[i] : ANEG; } }
}
__device__ __forceinline__ float max16x2(const f32x16& a, const f32x16& b) {
    float m0 = fmaxf(fmaxf(a[0], a[1]), fmaxf(a[2], a[3])), m1 = fmaxf(fmaxf(a[4], a[5]), fmaxf(a[6], a[7])), m2 = fmaxf(fmaxf(a[8], a[9]), fmaxf(a[10], a[11])), m3 = fmaxf(fmaxf(a[12], a[13]), fmaxf(a[14], a[15]));
    float n0 = fmaxf(fmaxf(b[0], b[1]), fmaxf(b[2], b[3])), n1 = fmaxf(fmaxf(b[4], b[5]), fmaxf(b[6], b[7])), n2 = fmaxf(fmaxf(b[8], b[9]), fmaxf(b[10], b[11])), n3 = fmaxf(fmaxf(b[12], b[13]), fmaxf(b[14], b[15]));
    return fmaxf(fmaxf(fmaxf(m0, m1), fmaxf(m2, m3)), fmaxf(fmaxf(n0, n1), fmaxf(n2, n3)));
}
__device__ __forceinline__ void attn_pv(f32x16& o0, f32x16& o1, const f32x16& p0, const f32x16& p1, const bf16* vt, int r32, int h) {
    bf16x8 vf[2][4];
#pragma unroll
    for (int dh = 0; dh < 2; ++dh)
#pragma unroll
        for (int k4 = 0; k4 < 4; ++k4) vf[dh][k4] = *(const bf16x8*)(vt + (dh * 32 + r32) * 64 + k4 * 16 + h * 8);
#pragma unroll
    for (int k4 = 0; k4 < 4; ++k4) {
        const f32x16& p = (k4 < 2) ? p0 : p1; const int b = (k4 & 1) * 8;
        typedef unsigned u32x4v __attribute__((ext_vector_type(4)));
        u32x4v w; w.x = cvtpk(p[b + 0], p[b + 1]); w.y = cvtpk(p[b + 2], p[b + 3]); w.z = cvtpk(p[b + 4], p[b + 5]); w.w = cvtpk(p[b + 6], p[b + 7]);
        const bf16x8 pf = __builtin_bit_cast(bf16x8, w);
        o0 = __builtin_amdgcn_mfma_f32_32x32x16_bf16(vf[0][k4], pf, o0, 0, 0, 0);
        o1 = __builtin_amdgcn_mfma_f32_32x32x16_bf16(vf[1][k4], pf, o1, 0, 0, 0);
    }
}
template <int MODE> __device__ __forceinline__ void attn_tile(AttnSt& st, bf16x8 (&kf)[2][4], const bf16* kt_next, const bf16* vt, const bf16x8 (&qf)[4], float cb, float slk, int lo, int hi, int r32, int h) {
    f32x16 s0, s1;
    attn_scores<MODE>(s0, s1, kf, qf, cb, slk, lo, hi, h);
    const float tm = pmax32(max16x2(s0, s1));
    const float mn = fmaxf(st.m, tm), mu = (mn > -1e29f) ? mn : 0.f;
    if (!__all(mn == st.m)) { const float al = ex2(st.m - mn); st.l *= al; st.o0 *= al; st.o1 *= al; st.m = mn; }
    float ls = 0.f;
#pragma unroll
    for (int i = 0; i < 16; ++i) { s0[i] = ex2(s0[i] - mu); s1[i] = ex2(s1[i] - mu); ls += s0[i] + s1[i]; }
    st.l += ls;
    attn_pv(st.o0, st.o1, s0, s1, vt, r32, h);
    attn_loadk(kf, kt_next, r32, h);
}
__device__ __forceinline__ int imax_row16(int x) {
    x = max(x, __builtin_amdgcn_update_dpp(x, x, 0x128, 0xf, 0xf, false)); x = max(x, __builtin_amdgcn_update_dpp(x, x, 0x124, 0xf, 0xf, false));
    x = max(x, __builtin_amdgcn_update_dpp(x, x, 0x122, 0xf, 0xf, false)); x = max(x, __builtin_amdgcn_update_dpp(x, x, 0x121, 0xf, 0xf, false));
    return x;
}
__device__ __forceinline__ void phase_attn_mfma(const Frame& F0) { const Frame F = launder(F0);
    const int lane = F.lane, r32 = lane & 31, h = lane >> 5, tt = r32 & 7, hd = r32 >> 3;
    LAS float* imp = (LAS float*)(F.lds + F.wave * 17152); LAS unsigned* selm = (LAS unsigned*)(imp + 2048); LAS int* ulist = (LAS int*)(selm + 64); LAS f32x4* otl = (LAS f32x4*)(ulist + 128) + lane;
    const bf16* Q = WSP(bf16, OFF_Q); const float* NG = WSP(float, OFF_NG); bf16* O = WSP(bf16, OFF_O);
    const int wv = blockIdx.x * 8 + F.wave, NW = F.G * 8;
    for (int wt = wv; wt < 4 * 2048; wt += NW) {
        const int bg = wt >> 11, gi0 = wt & 2047, grp = (bg & 1) ? 2047 - gi0 : gi0, b = bg >> 1, g = bg & 1;
        const int t0 = grp * 8, t = t0 + tt, n = b * T + t, cur = t0 >> 6, tl = (t0 & 63) + tt;
        const float sl2 = ex2(-(float)(g * 4 + hd + 1)) * 1.4426950408889634f;
        bf16x8 qf[4];
        {   const bf16* qp = Q + (size_t)n * 512 + g * 256 + hd * 64 + h * 8;
#pragma unroll
            for (int ks = 0; ks < 4; ++ks) { f32x4 a = ld4bf(qp + ks * 16), c = ld4bf(qp + ks * 16 + 4); a = a * 0.18033688011112042f; c = c * 0.18033688011112042f;
                typedef unsigned u32x4v __attribute__((ext_vector_type(4))); u32x4v w; w.x = cvtpk(a.x, a.y); w.y = cvtpk(a.z, a.w); w.z = cvtpk(c.x, c.y); w.w = cvtpk(c.z, c.w); qf[ks] = __builtin_bit_cast(bf16x8, w); } }
        const float* ngp = NG + (size_t)n * 32 + g * 12 + hd * 3;
        const float gc = ngp[0], gs = ngp[1], gw = ngp[2];
        bf16x8 kf[2][4];
        const int ncv = (t >= 31) ? ((t - 31) >> 4) + 1 : 0;
        const int ncv_hi = (t0 + 7 >= 31) ? ((t0 + 7 - 31) >> 4) + 1 : 0, ncv_lo = (t0 >= 31) ? ((t0 - 31) >> 4) + 1 : 0, nct = (ncv_hi + 63) >> 6;
        const bf16* kc = WSP(bf16, OFF_KC) + (size_t)bg * 1024 * 64; const bf16* vct = WSP(bf16, OFF_VC) + (size_t)bg * 1024 * 64;
        const float slc = sl2 * 16.f;
        float cm = ANEG, cl = 0.f;
        if (nct > 0) attn_loadk(kf, kc, r32, h);
        for (int ct = 0; ct < nct; ++ct) {
            f32x16 s0, s1; const float cb = sl2 * (float)(1024 * ct + 31 - t);
            if (ct * 64 + 63 < ncv_lo) attn_scores<0>(s0, s1, kf, qf, cb, slc, 0, 0, h); else attn_scores<1>(s0, s1, kf, qf, cb, slc, 0, ncv - 1 - ct * 64, h);
            attn_loadk(kf, kc + (size_t)((ct + 1 < nct) ? ct + 1 : 0) * 4096, r32, h);
            const float tm = max16x2(s0, s1), mn = fmaxf(cm, tm), mu = (mn > -1e29f) ? mn : 0.f;
            float ls = 0.f;
#pragma unroll
            for (int i = 0; i < 16; ++i) ls += ex2(s0[i] - mu) + ex2(s1[i] - mu);
            cl = cl * ex2(cm - mn) + ls; cm = mn;
        }
        {   const float mp = pmax32(cm), mu = (mp > -1e29f) ? mp : 0.f; cl = psum32(cl * ex2(cm - mu)); cm = mu; }
        const float cinv = (cl > 0.f) ? 1.f / cl : 0.f;
#pragma unroll
        for (int i = 0; i < 8; ++i) *(LAS f32x4*)(imp + (i * 64 + lane) * 4) = (f32x4){0.f, 0.f, 0.f, 0.f};
        WAVE_SYNC();
        {   f32x16 oc0, oc1;
#pragma unroll
            for (int i = 0; i < 16; ++i) { oc0[i] = 0.f; oc1[i] = 0.f; }
            float carry = 0.f;
            for (int ct = 0; ct < nct; ++ct) {
                f32x16 s0, s1; const float cb = sl2 * (float)(1024 * ct + 31 - t);
                if (ct * 64 + 63 < ncv_lo) attn_scores<0>(s0, s1, kf, qf, cb, slc, 0, 0, h); else attn_scores<1>(s0, s1, kf, qf, cb, slc, 0, ncv - 1 - ct * 64, h);
                attn_loadk(kf, kc + (size_t)((ct + 1 < nct) ? ct + 1 : 0) * 4096, r32, h);
#pragma unroll
                for (int i = 0; i < 16; ++i) { s0[i] = ex2(s0[i] - cm) * cinv; s1[i] = ex2(s1[i] - cm) * cinv; }
                attn_pv(oc0, oc1, s0, s1, vct + (size_t)ct * 4096, r32, h);
                float g4[2][4], xs[2][4];
#pragma unroll
                for (int q = 0; q < 4; ++q) { g4[0][q] = (s0[4 * q] + s0[4 * q + 1]) + (s0[4 * q + 2] + s0[4 * q + 3]); g4[1][q] = (s1[4 * q] + s1[4 * q + 1]) + (s1[4 * q + 2] + s1[4 * q + 3]);
                    xs[0][q] = __shfl_xor(s0[4 * q + 3], 32); xs[1][q] = __shfl_xor(s1[4 * q + 3], 32); }
#pragma unroll
                for (int kh = 0; kh < 2; ++kh)
#pragma unroll
                    for (int q = 0; q < 4; ++q) {
                        const float prev = (q > 0) ? xs[kh][q - 1] : (kh ? xs[0][3] : carry);
                        float v = g4[kh][q] + (h ? xs[kh][q] : prev);
                        v += __shfl_xor(v, 8); v += __shfl_xor(v, 16);
                        if (hd == 0) imp[tt * 256 + ct * 16 + kh * 8 + 2 * q + h] = v;
                    }
                carry = xs[1][3];
            }
#pragma unroll
            for (int q = 0; q < 4; ++q) { otl[64 * q] = gc * (f32x4){oc0[4 * q], oc0[4 * q + 1], oc0[4 * q + 2], oc0[4 * q + 3]}; otl[64 * (4 + q)] = gc * (f32x4){oc1[4 * q], oc1[4 * q + 1], oc1[4 * q + 2], oc1[4 * q + 3]}; }
        }
        WAVE_SYNC();
        unsigned uword = 0u, iword = 0xffffffffu;
        if (cur <= 15) {
            const unsigned mw = (lane == 0) ? ((2u << cur) - 1u) : 0u;
            if (lane < 8) { uword = mw; iword = mw;
#pragma unroll
                for (int k = 0; k < 8; ++k) selm[k * 8 + lane] = mw; }
        } else {
            for (int k = 0; k < 8; ++k) {
                const f32x4 iv = *(const LAS f32x4*)(imp + k * 256 + lane * 4);
                int v[4];
#pragma unroll
                for (int i = 0; i < 4; ++i) { const int j = lane * 4 + i; v[i] = __float_as_int(iv[i]); if (j == 0 || j >= cur - 1) v[i] = (int)0xBF800000; }
                unsigned mw = 0u;
                { const int w0 = 0, wa = cur >> 5, wb = (cur - 1) >> 5; if (lane == w0) mw |= 1u; if (lane == wa) mw |= 1u << (cur & 31); if (lane == wb) mw |= 1u << ((cur - 1) & 31); }
                for (int it = 0; it < 13; ++it) {
                    const int m4 = max(max(v[0], v[1]), max(v[2], v[3]));
                    const int rm = imax_row16(m4);
                    const int wm = max(max(__builtin_amdgcn_readlane(rm, 0), __builtin_amdgcn_readlane(rm, 16)), max(__builtin_amdgcn_readlane(rm, 32), __builtin_amdgcn_readlane(rm, 48)));
                    const unsigned long long bal = __ballot(m4 == wm);
                    const int win = __builtin_amdgcn_readfirstlane((int)__ffsll((long long)bal) - 1);
                    const int slot = (v[0] == wm) ? 0 : (v[1] == wm) ? 1 : (v[2] == wm) ? 2 : 3;
                    const int sslot = __builtin_amdgcn_readlane(slot, win);
                    const int j = win * 4 + sslot;
                    if (lane == win) {
#pragma unroll
                        for (int i = 0; i < 4; ++i) if (sslot == i) v[i] = (int)0xBF800000; }
                    if (lane == (j >> 5)) mw |= 1u << (j & 31);
                }
                if (lane < 8) { selm[k * 8 + lane] = mw; uword |= mw; iword &= mw; }
            }
        }
        int nu = 0;
        for (int w = 7; w >= 0; --w) { unsigned bits = __builtin_amdgcn_readlane(uword, w);
            while (bits) { const int bb = 31 - __builtin_clz(bits); bits &= ~(1u << bb); if (lane == 0) ulist[nu] = w * 32 + bb; ++nu; } }
        WAVE_SYNC();
        {   AttnSt st;
#pragma unroll
            for (int i = 0; i < 16; ++i) { st.o0[i] = 0.f; st.o1[i] = 0.f; }
            st.m = ANEG; st.l = 0.f;
            const bf16* ksb = WSP(bf16, OFF_KS) + (size_t)bg * T * 64; const bf16* vsb = WSP(bf16, OFF_VS) + (size_t)bg * T * 64;
            int j = __builtin_amdgcn_readfirstlane(ulist[0]);
            attn_loadk(kf, ksb + (size_t)j * 4096, r32, h);
            for (int u = 0; u < nu; ++u) {
                const int jn = __builtin_amdgcn_readfirstlane(ulist[(u + 1 < nu) ? u + 1 : u]);
                const unsigned rw = selm[tt * 8 + (j >> 5)]; const bool rsel = (rw >> (j & 31)) & 1u;
                const bool full = ((__builtin_amdgcn_readlane(iword, j >> 5) >> (j & 31)) & 1u) && (j < cur);
                const float cb = sl2 * (float)(64 * j - t);
                if (full) attn_tile<0>(st, kf, ksb + (size_t)jn * 4096, vsb + (size_t)j * 4096, qf, cb, sl2, 0, 0, r32, h);
                else attn_tile<1>(st, kf, ksb + (size_t)jn * 4096, vsb + (size_t)j * 4096, qf, cb, sl2, 0, rsel ? ((j == cur) ? tl : 63) : -100, r32, h);
                j = jn;
            }
            const float lr = psum32(st.l), sc = (lr > 0.f) ? gs / lr : 0.f;
#pragma unroll
            for (int q = 0; q < 4; ++q) { otl[64 * q] += sc * (f32x4){st.o0[4 * q], st.o0[4 * q + 1], st.o0[4 * q + 2], st.o0[4 * q + 3]}; otl[64 * (4 + q)] += sc * (f32x4){st.o1[4 * q], st.o1[4 * q + 1], st.o1[4 * q + 2], st.o1[4 * q + 3]}; }
        }
        {   AttnSt st;
#pragma unroll
            for (int i = 0; i < 16; ++i) { st.o0[i] = 0.f; st.o1[i] = 0.f; }
            st.m = ANEG; st.l = 0.f;
            const bf16* kwb = WSP(bf16, OFF_KW) + (size_t)bg * T * 64; const bf16* vwb = WSP(bf16, OFF_VW) + (size_t)bg * T * 64;
            const int thi = (t0 + 7) >> 6, tlo = (t0 >= 511) ? ((t0 - 511) >> 6) : 0;
            attn_loadk(kf, kwb + (size_t)thi * 4096, r32, h);
            for (int tile = thi; tile >= tlo; --tile) {
                const int tn = (tile > tlo) ? tile - 1 : tile;
                const float cb = sl2 * (float)(64 * tile - t);
                const bool full = (64 * tile + 63 <= t0) && (64 * tile >= t0 + 7 - 511);
                if (full) attn_tile<0>(st, kf, kwb + (size_t)tn * 4096, vwb + (size_t)tile * 4096, qf, cb, sl2, 0, 0, r32, h);
                else attn_tile<2>(st, kf, kwb + (size_t)tn * 4096, vwb + (size_t)tile * 4096, qf, cb, sl2, t - 511 - 64 * tile, t - 64 * tile, r32, h);
            }
            const float lr = psum32(st.l), sc = (lr > 0.f) ? gw / lr : 0.f;
            bf16* op = O + (size_t)n * 512 + g * 256 + hd * 64 + 4 * h;
#pragma unroll
            for (int q = 0; q < 4; ++q) {
                st4bf(op + 8 * q, otl[64 * q] + sc * (f32x4){st.o0[4 * q], st.o0[4 * q + 1], st.o0[4 * q + 2], st.o0[4 * q + 3]});
                st4bf(op + 32 + 8 * q, otl[64 * (4 + q)] + sc * (f32x4){st.o1[4 * q], st.o1[4 * q + 1], st.o1[4 * q + 2], st.o1[4 * q + 3]}); }
        }
        WAVE_SYNC();
    }
}

__device__ __forceinline__ void phase_merge(const Frame& F0) { const Frame F = launder(F0);
    const bf16* MG = WSP(bf16, OFF_MG); bf16* MERGED = WSP(bf16, OFF_MERGED);
    for (int it = blockIdx.x; it < (NTOK / 128) * 8; it += F.G) {
        const int mt = it >> 3, nt = it & 7;
        f32x4 outv[4][2]; ACC_ZERO(outv);
#pragma unroll
        for (int src = 0; src < 3; ++src) {
            const bf16* A = src == 0 ? WSP(bf16, OFF_O) : src == 1 ? WSP(bf16, OFF_PM) : WSP(bf16, OFF_CV);
            const bf16* B = src == 0 ? WSP(bf16, OFF_WN) : src == 1 ? WSP(bf16, OFF_WP) : WSP(bf16, OFF_WC);
            const int K = src == 0 ? 512 : 256;
            f32x4 acc[4][2]; ACC_ZERO(acc);
            gemm_tile_128(acc, A + (size_t)mt * 128 * K, K, B + (size_t)nt * 128 * K, K, K, F.lds);
            const int tq = otid(), l = tq & 63, w = tq >> 6;
#pragma unroll
            for (int i = 0; i < 4; ++i)
#pragma unroll
                for (int j = 0; j < 2; ++j) { const int row = mt * 128 + (w >> 2) * 64 + i * 16 + (l & 15), col = nt * 128 + (w & 3) * 32 + j * 16 + (l >> 4) * 4;
                    outv[i][j] += ld4bf(MG + (size_t)row * 3072 + src * 1024 + col) * acc[i][j]; }
        }
        TILE_FOREACH(outv, mt * 128, nt * 128, { st4bf(MERGED + (size_t)ROW * 1024 + COL, V); });
    }
}
__device__ __forceinline__ void phase_wo(const Frame& F0) { const Frame F = launder(F0);
    const bf16* MERGED = WSP(bf16, OFF_MERGED);
    for (int it = blockIdx.x; it < (NTOK / 128) * 8; it += F.G) {
        const int mt = it >> 3, nt = it & 7;
        f32x4 acc[4][2]; ACC_ZERO(acc);
        gemm_tile_128(acc, MERGED + (size_t)mt * 128 * 1024, 1024, WSP(bf16, OFF_WO) + (size_t)nt * 128 * 1024, 1024, 1024, F.lds);
        TILE_FOREACH(acc, mt * 128, nt * 128, { f32x4* p = (f32x4*)(F.out + (size_t)ROW * 1024 + COL); *p = *p + V; });
    }
}

__device__ __forceinline__ void phase_router(const Frame& F0, int l) { const Frame F = launder(F0);
    LAS int* hist = (LAS int*)F.lds;
    if (F.tid < 32) hist[F.tid] = 0;
    __syncthreads();
    const float* g2 = F.in[13] + (size_t)l * D; const float* wg = F.in[14] + (size_t)l * D * 4; const float* bgp = F.in[15] + (size_t)l * 4;
    const float* we = F.in[16] + (size_t)l * D * 32; const float* be = F.in[17] + (size_t)l * 32;
    bf16* xn = WSP(bf16, OFF_XN); int* toke = WSP(int, OFF_TOKE); float* tokc = WSP(float, OFF_TOKC);
    for (int n = blockIdx.x * 8 + F.wave; n < NTOK; n += F.G * 8) {
        f32x4 v[4]; float ss = 0.f;
        const f32x4* hr = (const f32x4*)(F.out + (size_t)n * D) + F.lane;
#pragma unroll
        for (int j = 0; j < 4; ++j) { v[j] = hr[64 * j]; ss += (v[j].x * v[j].x + v[j].y * v[j].y) + (v[j].z * v[j].z + v[j].w * v[j].w); }
        const float rs = 1.f / sqrtf(wave_sum(ss) * (1.f / D) + RMS_EPS);
        float gl[4] = {0.f, 0.f, 0.f, 0.f};
#pragma unroll
        for (int j = 0; j < 4; ++j) {
            v[j] = v[j] * rs * ((const f32x4*)g2)[F.lane + 64 * j];
            st4bf(xn + (size_t)n * D + F.lane * 4 + 256 * j, v[j]);
#pragma unroll
            for (int q = 0; q < 4; ++q) {
                const int k = F.lane * 4 + 256 * j + q; const float x = v[j][q];
                const f32x4 w4 = *(const f32x4*)(wg + (size_t)k * 4);
                gl[0] += x * w4.x; gl[1] += x * w4.y; gl[2] += x * w4.z; gl[3] += x * w4.w;
            }
        }
        int gs = 0;
#pragma unroll
        for (int i = 0; i < 4; ++i) gl[i] = wave_sum(gl[i]) + bgp[i];
        float gm = gl[0];
#pragma unroll
        for (int i = 1; i < 4; ++i) if (gl[i] > gm) { gm = gl[i]; gs = i; }
        float gsum = 0.f;
#pragma unroll
        for (int i = 0; i < 4; ++i) gsum += __expf(gl[i] - gm);
        const float gp = 1.f / gsum;
        gs = __builtin_amdgcn_readfirstlane(gs);
        float el[8] = {0.f, 0.f, 0.f, 0.f, 0.f, 0.f, 0.f, 0.f};
#pragma unroll
        for (int j = 0; j < 4; ++j)
#pragma unroll
            for (int q = 0; q < 4; ++q) {
                const int k = F.lane * 4 + 256 * j + q; const float x = v[j][q];
                const f32x4 u0 = *(const f32x4*)(we + (size_t)k * 32 + gs * 8), u1 = *(const f32x4*)(we + (size_t)k * 32 + gs * 8 + 4);
                el[0] += x * u0.x; el[1] += x * u0.y; el[2] += x * u0.z; el[3] += x * u0.w; el[4] += x * u1.x; el[5] += x * u1.y; el[6] += x * u1.z; el[7] += x * u1.w;
            }
        float v0 = -INFINITY, v1 = -INFINITY; int i0 = 0, i1 = 0;
#pragma unroll
        for (int i = 0; i < 8; ++i) {
            const float ev = wave_sum(el[i]) + be[gs * 8 + i];
            if (ev > v0) { v1 = v0; i1 = i0; v0 = ev; i0 = i; } else if (ev > v1) { v1 = ev; i1 = i; }
        }
        const float e1 = __expf(v1 - v0), w0 = 1.f / (1.f + e1), w1 = e1 * w0;
        if (F.lane == 0) {
            const int ea = gs * 8 + i0, eb = gs * 8 + i1;
            toke[n * 2] = ea; toke[n * 2 + 1] = eb; tokc[n * 2] = w0 * gp; tokc[n * 2 + 1] = w1 * gp;
            __hip_atomic_fetch_add(&hist[ea], 1, __ATOMIC_RELAXED, __HIP_MEMORY_SCOPE_WORKGROUP); __hip_atomic_fetch_add(&hist[eb], 1, __ATOMIC_RELAXED, __HIP_MEMORY_SCOPE_WORKGROUP);
        }
    }
    __syncthreads();
    if (F.tid < 32 && hist[F.tid]) atomicAdd(F.ctl + CW_CNT + l * 32 + F.tid, (unsigned)hist[F.tid]);
}

__device__ __forceinline__ void moe_offsets(const Frame& F, int l, LAS int* off) {
    if (F.tid == 0) { int a = 0; for (int e = 0; e < NEXP; ++e) { off[e] = a; const int c = (int)__hip_atomic_load(F.ctl + CW_CNT + l * 32 + e, __ATOMIC_RELAXED, __HIP_MEMORY_SCOPE_AGENT); a += (c + 255) & ~255; } off[NEXP] = a; }
    __syncthreads();
}
__device__ __forceinline__ void phase_dispatch(const Frame& F0, int l) { const Frame F = launder(F0);
    LAS int* off = (LAS int*)F.lds; LAS int* hist = off + 64; LAS int* base = hist + 32; LAS int* pslot = base + 32; LAS int* ptok = pslot + 512;
    moe_offsets(F, l, off);
    const int* toke = WSP(int, OFF_TOKE); const float* tokc = WSP(float, OFF_TOKC); int* toks = WSP(int, OFF_TOKS); float* slotc = WSP(float, OFF_SLOTC);
    const bf16* xn = WSP(bf16, OFF_XN); bf16* xg = WSP(bf16, OFF_XG);
    for (int ch = blockIdx.x; ch < NTOK / 256; ch += F.G) {
        if (F.tid < 32) hist[F.tid] = 0;
        __syncthreads();
        const int pr = ch * 512 + F.tid, e = toke[pr];
        const int r = __hip_atomic_fetch_add(&hist[e], 1, __ATOMIC_RELAXED, __HIP_MEMORY_SCOPE_WORKGROUP);
        __syncthreads();
        if (F.tid < 32) base[F.tid] = hist[F.tid] ? (int)atomicAdd(F.ctl + CW_CUR + l * 32 + F.tid, (unsigned)hist[F.tid]) : 0;
        __syncthreads();
        const int slot = off[e] + base[e] + r;
        toks[pr] = slot; slotc[slot] = tokc[pr]; pslot[F.tid] = slot; ptok[F.tid] = pr >> 1;
        __syncthreads();
        for (int i = F.wave; i < 512; i += 8) {
            const uint4* s = (const uint4*)(xn + (size_t)ptok[i] * D) + F.lane; uint4* d = (uint4*)(xg + (size_t)pslot[i] * D) + F.lane;
            d[0] = s[0]; d[64] = s[64];
        }
        __syncthreads();
    }
}
__device__ __forceinline__ int moe_expert_of(const LAS int* off, int row) { int e = 0;
#pragma unroll 1
    for (int i = 1; i < NEXP; ++i) if (row >= off[i]) e = i;
    return e; }
__device__ __forceinline__ void phase_moe1(const Frame& F0, int l) { const Frame F = launder(F0);
    LAS int* off = (LAS int*)(F.lds + 32768); moe_offsets(F, l, off);
    const bf16* xg = WSP(bf16, OFF_XG); bf16* hmid = WSP(bf16, OFF_HMID);
    const int ntile = off[NEXP] / 128;
    for (int it = blockIdx.x; it < ntile * 2; it += F.G) {
        const int rt = it >> 1, u = it & 1, e = moe_expert_of(off, rt * 128);
        const bf16* B = WSP(bf16, OFF_W13) + ((size_t)e * 512 + u * 256) * 1024;
        f32x4 a1[4][2], a3[4][2]; ACC_ZERO(a1); ACC_ZERO(a3);
        gemm_tile_128(a1, xg + (size_t)rt * 128 * 1024, 1024, B, 1024, 1024, F.lds);
        gemm_tile_128(a3, xg + (size_t)rt * 128 * 1024, 1024, B + (size_t)128 * 1024, 1024, 1024, F.lds);
#pragma unroll
        for (int i = 0; i < 4; ++i)
#pragma unroll
            for (int j = 0; j < 2; ++j) { const f32x4 x = a1[i][j], y = a3[i][j]; a1[i][j] = (f32x4){siluf(x.x) * y.x, siluf(x.y) * y.y, siluf(x.z) * y.z, siluf(x.w) * y.w}; }
        TILE_FOREACH(a1, rt * 128, u * 128, { st4bf(hmid + (size_t)ROW * 256 + COL, V); });
    }
}
__device__ __forceinline__ void phase_moe2(const Frame& F0, int l) { const Frame F = launder(F0);
    LAS int* off = (LAS int*)(F.lds + 32768); moe_offsets(F, l, off);
    const bf16* hmid = WSP(bf16, OFF_HMID); bf16* ys = WSP(bf16, OFF_YS); const float* slotc = WSP(float, OFF_SLOTC);
    const int ntile = off[NEXP] / 128;
    for (int it = blockIdx.x; it < ntile * 8; it += F.G) {
        const int rt = it >> 3, ct = it & 7, e = moe_expert_of(off, rt * 128);
        f32x4 acc[4][2]; ACC_ZERO(acc);
        gemm_tile_128(acc, hmid + (size_t)rt * 128 * 256, 256, WSP(bf16, OFF_W2) + ((size_t)e * 1024 + ct * 128) * 256, 256, 256, F.lds);
        TILE_FOREACH(acc, rt * 128, ct * 128, { st4bf(ys + (size_t)ROW * 1024 + COL, V * slotc[ROW]); });
    }
}


#define LDSP (F.lds)
__device__ __forceinline__ void phase_inproj_pg8(const Frame& F0) { const Frame F = launder(F0);
    pg8::Gemm g{WSP(bf16, OFF_XN), WSP(bf16, OFF_WIN), D, D, D}; pg8::StaticOrder S; S.init(NTOK, INP, F.G, (int)blockIdx.x);
    pg8::EpiInproj E{F.ws};
    pg8::gemm_phase<pg8::EpiInproj, pg8::StaticOrder, true, true>(LDSP, g, S, E);
}
template <int SRC> __device__ __forceinline__ void phase_merge_pg8(const Frame& F0) { const Frame F = launder(F0);
    pg8::StaticOrder S; S.init(NTOK, D, F.G, (int)blockIdx.x);
    constexpr int K = SRC == 0 ? 512 : 256;
    pg8::Gemm g{WSP(bf16, SRC == 0 ? OFF_O : SRC == 1 ? OFF_PM : OFF_CV), WSP(bf16, SRC == 0 ? OFF_WN : SRC == 1 ? OFF_WP : OFF_WC), K, K, K};
    pg8::EpiMerge<SRC == 0> E{WSP(bf16, OFF_MERGED), WSP(bf16, OFF_MG) + SRC * 1024};
    pg8::gemm_phase<pg8::EpiMerge<SRC == 0>, pg8::StaticOrder, true, true>(LDSP, g, S, E);
}
__device__ __forceinline__ void phase_wo_pg8(const Frame& F0) { const Frame F = launder(F0);
    pg8::Gemm g{WSP(bf16, OFF_MERGED), WSP(bf16, OFF_WO), D, D, D}; pg8::StaticOrder S; S.init(NTOK, D, F.G, (int)blockIdx.x);
    pg8::EpiWo E{F.out};
    pg8::gemm_phase<pg8::EpiWo, pg8::StaticOrder, true, true>(LDSP, g, S, E);
}
__device__ __forceinline__ void phase_moe1_pg8(const Frame& F0, int l) { const Frame F = launder(F0);
    LAS int* off = (LAS int*)(F.lds + pg8::STAGE_BYTES); moe_offsets(F, l, off);
    pg8::Gemm g{WSP(bf16, OFF_XG), WSP(bf16, OFF_W13), D, D, D}; pg8::MoeOrder S{(const LAS int*)(F.lds + pg8::STAGE_BYTES), 2, F.G, (int)blockIdx.x, (size_t)512 * 1024 * 2};
    pg8::EpiMoe1 E{WSP(bf16, OFF_HMID)};
    pg8::gemm_phase<pg8::EpiMoe1, pg8::MoeOrder, true, true>(LDSP, g, S, E);
}
__device__ __forceinline__ void phase_moe2_pg8(const Frame& F0, int l) { const Frame F = launder(F0);
    LAS int* off = (LAS int*)(F.lds + pg8::STAGE_BYTES); moe_offsets(F, l, off);
    pg8::Gemm g{WSP(bf16, OFF_HMID), WSP(bf16, OFF_W2), 256, 256, 256}; pg8::MoeOrder S{(const LAS int*)(F.lds + pg8::STAGE_BYTES), 4, F.G, (int)blockIdx.x, (size_t)1024 * 256 * 2};
    pg8::EpiMoe2 E{WSP(bf16, OFF_YS), WSP(float, OFF_SLOTC)};
    pg8::gemm_phase<pg8::EpiMoe2, pg8::MoeOrder, true, true>(LDSP, g, S, E);
}

constexpr int PPL = 11;
constexpr int NPHASE = DEPTH * PPL + 1;
__global__ void __launch_bounds__(512, 2) nsa_fwd(Args args) {
    extern __shared__ __attribute__((aligned(16))) unsigned char lds[];
    Frame F;
    F.lds = (LAS unsigned char*)lds; F.ws = args.ws; F.ctl = (unsigned*)(args.ws + WS_CTL); F.out = args.out;
#pragma unroll
    for (int i = 0; i < 22; ++i) F.in[i] = args.in[i];
    F.tid = threadIdx.x; F.lane = F.tid & 63; F.wave = __builtin_amdgcn_readfirstlane(F.tid >> 6); F.G = gridDim.x;
    volatile LAS unsigned* MISC = (volatile LAS unsigned*)((LAS unsigned char*)lds + MISC_OFF);
    if (F.tid < 32) MISC[F.tid] = 0u;
    __syncthreads();
    const int lo = args.ph_lo, hi = args.ph_hi;
    XcdBarrier bar; bar.bar = F.ctl + CW_BAR; bar.x = 0; bar.st = MISC + 8;
    if (hi - lo > 1) bar = xcd_barrier_post(F.ctl + CW_BAR, MISC + 8);
#ifndef ONLY
#define ONLY -1
#endif
#ifndef PMASK
#define PMASK 0xFFF
#endif
#define IN(k) (lo <= (k) && (k) < hi && ((PMASK >> ((k) == DEPTH * PPL ? 11 : (k) % PPL)) & 1))
#ifndef PROBE_DUP
#define PROBE_DUP 0x200
#endif
#define DUP(k) (((PROBE_DUP >> (k)) & 1) ? 2 : 1)
#define SEAM(k) do { if (IN(k) && IN((k) + 1)) xcd_barrier(bar); else __syncthreads(); } while (0)
#pragma unroll 1
    for (int l = 0; l < DEPTH; ++l) {
        const int p0 = l * PPL;
        if (IN(p0 + 0)) { for (int rep = 0; rep < DUP(0); ++rep) { phase_weights(F, l); phase_norm<false>(F, l, F.in[1] + (size_t)l * D); if (rep + 1 < DUP(0)) xcd_barrier(bar); } } SEAM(p0 + 0);
        if (IN(p0 + 1)) { for (int rep = 0; rep < DUP(1); ++rep) { if (USE_PG8 & 1) phase_inproj_pg8(F); else phase_inproj(F); if (rep + 1 < DUP(1)) xcd_barrier(bar); } } SEAM(p0 + 1);
        if (IN(p0 + 2)) { for (int rep = 0; rep < DUP(2); ++rep) { phase_cmp1(F); __syncthreads(); phase_poolconv(F, l); if (rep + 1 < DUP(2)) xcd_barrier(bar); } } SEAM(p0 + 2);
        if (IN(p0 + 3)) { for (int rep = 0; rep < DUP(3); ++rep) { phase_cmp2(F); if (rep + 1 < DUP(3)) xcd_barrier(bar); } } SEAM(p0 + 3);
        if (IN(p0 + 4)) { for (int rep = 0; rep < DUP(4); ++rep) { if (ATTN_MFMA) phase_attn_mfma(F); else phase_attn_valu(F); if (rep + 1 < DUP(4)) xcd_barrier(bar); } } SEAM(p0 + 4);
        if (IN(p0 + 5)) { for (int rep = 0; rep < DUP(5); ++rep) { if (USE_PG8 & 2) { phase_merge_pg8<0>(F); phase_merge_pg8<1>(F); phase_merge_pg8<2>(F); } else phase_merge(F); if (rep + 1 < DUP(5)) xcd_barrier(bar); } } SEAM(p0 + 5);
        if (IN(p0 + 6)) { for (int rep = 0; rep < DUP(6); ++rep) { if (USE_PG8 & 4) phase_wo_pg8(F); else phase_wo(F); if (rep + 1 < DUP(6)) xcd_barrier(bar); } } SEAM(p0 + 6);
        if (IN(p0 + 7)) { for (int rep = 0; rep < DUP(7); ++rep) { phase_router(F, l); if (rep + 1 < DUP(7)) xcd_barrier(bar); } } SEAM(p0 + 7);
        if (IN(p0 + 8)) { for (int rep = 0; rep < DUP(8); ++rep) { phase_dispatch(F, l); if (rep + 1 < DUP(8)) xcd_barrier(bar); } } SEAM(p0 + 8);
        if (IN(p0 + 9)) { for (int rep = 0; rep < DUP(9); ++rep) { if (USE_PG8 & 8) phase_moe1_pg8(F, l); else phase_moe1(F, l); if (rep + 1 < DUP(9)) xcd_barrier(bar); } } SEAM(p0 + 9);
        if (IN(p0 + 10)) { for (int rep = 0; rep < DUP(10); ++rep) { if (USE_PG8 & 16) phase_moe2_pg8(F, l); else phase_moe2(F, l); if (rep + 1 < DUP(10)) xcd_barrier(bar); } } SEAM(p0 + 10);
    }
    if (IN(DEPTH * PPL)) phase_norm<true>(F, DEPTH, F.in[21]);
#undef IN
#undef SEAM
}

extern "C" void kernel_launch(void* const* d_in, const int* in_sizes, int n_in, void* d_out, int out_size, void* d_ws, size_t ws_size, hipStream_t stream) {
    static int grid = 0;
    if (grid == 0) {
        if (n_in != 22 || out_size != NTOK * D || ws_size < WS_END) { fprintf(stderr, "kernel_launch: unexpected shapes (n_in %d out %d ws %zu, need %zu)\n", n_in, out_size, ws_size, (size_t)WS_END); grid = -1; return; }
        int dev = 0, cus = 0;
        if (hipGetDevice(&dev) != hipSuccess || hipDeviceGetAttribute(&cus, hipDeviceAttributeMultiprocessorCount, dev) != hipSuccess) { grid = -1; return; }
        if (hipFuncSetAttribute((const void*)nsa_fwd, hipFuncAttributeMaxDynamicSharedMemorySize, LDS_BYTES) != hipSuccess) { fprintf(stderr, "kernel_launch: hipFuncSetAttribute failed\n"); grid = -1; return; }
        int per_cu = 0;
        if (hipOccupancyMaxActiveBlocksPerMultiprocessor(&per_cu, (const void*)nsa_fwd, 512, LDS_BYTES) != hipSuccess || per_cu < 1) fprintf(stderr, "kernel_launch: occupancy query says %d\n", per_cu);
        (void)hipGetLastError();
        grid = cus;
    }
    if (grid < 0) return;
    (void)hipMemsetAsync((char*)d_ws + WS_CTL, 0, CTL_BYTES, stream);
    Args a{};
    for (int i = 0; i < 22; ++i) a.in[i] = (const float*)d_in[i];
    a.out = (float*)d_out; a.ws = (unsigned char*)d_ws;
#if MK_PER_PHASE
    for (int p = 0; p < NPHASE; ++p) { a.ph_lo = p; a.ph_hi = p + 1; hipLaunchKernelGGL(nsa_fwd, dim3(grid), dim3(512), LDS_BYTES, stream, a); }
#else
    a.ph_lo = 0; a.ph_hi = NPHASE;
    hipLaunchKernelGGL(nsa_fwd, dim3(grid), dim3(512), LDS_BYTES, stream, a);
#endif
}
```

```cpp
#include <hip/hip_runtime.h>
#include <cstdio>
#include <cstdint>

#ifndef USE_PG8
#define USE_PG8 31
#endif
#ifndef ATTN_MFMA
#define ATTN_MFMA 1
#endif
#ifndef ROUTER_MFMA
#define ROUTER_MFMA 1
#endif
#ifndef MK_PER_PHASE
#define MK_PER_PHASE 0
#endif

#define LAS __attribute__((address_space(3)))
#define GAS __attribute__((address_space(1)))
typedef unsigned short bf16;
typedef short bf16x8 __attribute__((ext_vector_type(8)));
typedef float f32x4 __attribute__((ext_vector_type(4)));
typedef unsigned u32x4 __attribute__((ext_vector_type(4)));

constexpr int D = 1024, NB = 2, T = 16384, NTOK = NB * T, DEPTH = 2;
constexpr int IN_DIM = 5400, INP = 5632;
constexpr int NCMP = 1023, NSLC = 256;
constexpr float RMS_EPS = 1e-6f;
constexpr int NEXP = 32, DEXP = 256;
constexpr int MOE_ROWS = 2 * NTOK + NEXP * 256;
constexpr int TP = T + 64;

constexpr size_t MiB = 1u << 20;
constexpr size_t WS_CTL = 0, CTL_BYTES = MiB;
constexpr size_t RA = MiB;
constexpr size_t SZ_Q = (size_t)NTOK * 512 * 2, SZ_KVC = (size_t)8 * TP * 64 * 2, SZ_KV = (size_t)NB * 2 * T * 64 * 2, SZ_C256 = (size_t)NTOK * 256 * 2;
constexpr size_t OFF_Q = RA, OFF_KVC = OFF_Q + SZ_Q, OFF_KS = OFF_KVC + SZ_KVC, OFF_VS = OFF_KS + SZ_KV, OFF_KW = OFF_VS + SZ_KV, OFF_VW = OFF_KW + SZ_KV;
constexpr size_t OFF_PU = OFF_VW + SZ_KV, OFF_CH = OFF_PU + SZ_C256, OFF_CB = OFF_CH + SZ_C256, OFF_CC = OFF_CB + SZ_C256, OFF_NG = OFF_CC + SZ_C256;
constexpr size_t OFF_MG = OFF_NG + (size_t)NTOK * 32 * 4, RA_END = OFF_MG + (size_t)NTOK * 3072 * 2;
constexpr size_t OFF_MERGED = RA;
static_assert(OFF_MERGED + (size_t)NTOK * 1024 * 2 <= OFF_KW, "merged alias");
constexpr size_t OFF_XG = RA, OFF_HMID = OFF_XG + (size_t)MOE_ROWS * 1024 * 2, OFF_YS = OFF_HMID + (size_t)MOE_ROWS * 256 * 2, MOE_END = OFF_YS + (size_t)MOE_ROWS * 1024 * 2;
static_assert(MOE_END <= RA_END, "moe alias");
constexpr size_t RB = RA_END, OFF_XN = RB, OFF_O = RB, OFF_PM = OFF_O + SZ_Q, OFF_CV = OFF_PM + SZ_C256, RB_END = RB + (size_t)NTOK * 1024 * 2;
static_assert(OFF_CV + SZ_C256 <= RB_END, "rb alias");
constexpr size_t RW = RB_END;
constexpr size_t OFF_WIN = RW, OFF_CW1 = OFF_WIN + (size_t)INP * 1024 * 2, OFF_CW2 = OFF_CW1 + (size_t)2 * 256 * 2048 * 2, OFF_CB1 = OFF_CW2 + (size_t)2 * 128 * 256 * 2;
constexpr size_t OFF_WN = OFF_CB1 + 4096, OFF_WP = OFF_WN + (size_t)1024 * 512 * 2, OFF_WC = OFF_WP + (size_t)1024 * 256 * 2, OFF_WO = OFF_WC + (size_t)1024 * 256 * 2;
constexpr size_t OFF_W13 = OFF_WO + (size_t)1024 * 1024 * 2, OFF_W2 = OFF_W13 + (size_t)NEXP * 512 * 1024 * 2, OFF_WR = OFF_W2 + (size_t)NEXP * 1024 * 256 * 2, RW_END = OFF_WR + (size_t)2 * 64 * 1024 * 2;
constexpr size_t RS = RW_END;
constexpr size_t OFF_KC = RS, OFF_VC = OFF_KC + (size_t)4 * 1024 * 64 * 2, OFF_HC = OFF_VC + (size_t)4 * 1024 * 64 * 2;
constexpr size_t OFF_TOKE = OFF_HC + (size_t)8192 * 256 * 2, OFF_TOKC = OFF_TOKE + (size_t)NTOK * 8, OFF_TOKS = OFF_TOKC + (size_t)NTOK * 8, OFF_SLOTC = OFF_TOKS + (size_t)NTOK * 8;
constexpr size_t WS_END = OFF_SLOTC + (size_t)MOE_ROWS * 4;
static_assert(WS_END <= (size_t)512 * MiB, "workspace");
constexpr int CW_BAR = 4096;
constexpr int CW_CNT = 16384;
constexpr int CW_CUR = CW_CNT + DEPTH * 32;

constexpr int LDS_BYTES = 147456;
constexpr int MISC_OFF = 143360;

__device__ __forceinline__ float bf2f(unsigned u) { return __builtin_bit_cast(float, u << 16); }
__device__ __forceinline__ unsigned f2bf(float f) { unsigned u = __builtin_bit_cast(unsigned, f); return (u + 0x7fffu + ((u >> 16) & 1u)) >> 16; }
__device__ __forceinline__ unsigned pk2(float lo, float hi) { return f2bf(lo) | (f2bf(hi) << 16); }
__device__ __forceinline__ void st4bf(bf16* p, f32x4 v) { *(uint2*)p = make_uint2(pk2(v.x, v.y), pk2(v.z, v.w)); }
__device__ __forceinline__ f32x4 ld4bf(const bf16* p) { const uint2 u = *(const uint2*)p; return (f32x4){bf2f(u.x & 0xffffu), bf2f(u.x >> 16), bf2f(u.y & 0xffffu), bf2f(u.y >> 16)}; }
__device__ __forceinline__ float sigmoidf(float x) { return 1.f / (1.f + __expf(-x)); }
__device__ __forceinline__ float gelu_tanh(float x) { const float u = 0.7978845608028654f * (x + 0.044715f * x * x * x); return 0.5f * x * (1.f + tanhf(u)); }
__device__ __forceinline__ float siluf(float x) { return x / (1.f + __expf(-x)); }
__device__ __forceinline__ float wave_sum(float v) {
#pragma unroll
    for (int o = 1; o < 64; o <<= 1) v += __shfl_xor(v, o);
    return v;
}
__device__ __forceinline__ float wave_max(float v) {
#pragma unroll
    for (int o = 1; o < 64; o <<= 1) v = fmaxf(v, __shfl_xor(v, o));
    return v;
}
__device__ __forceinline__ int swap23(int k) { return (k & 3) | ((k & 4) << 1) | ((k & 8) >> 1); }
__device__ __forceinline__ int ktile_off(int kk, int d0) { return ((((kk >> 5) * 4 + (d0 >> 4)) * 64 + ((d0 >> 3) & 1) * 32 + (kk & 31)) * 8); }
__device__ __forceinline__ int vtile_off(int kk, int d) { const int p = swap23(kk & 15); return ((((d >> 5) * 4 + (kk >> 4)) * 64 + (p >> 3) * 32 + (d & 31)) * 8 + (p & 7)); }
#define WAVE_SYNC() asm volatile("s_waitcnt lgkmcnt(0)" ::: "memory")
__device__ __forceinline__ int otid() { int t = threadIdx.x; asm volatile("" : "+v"(t)); return t; }

#define XB_TMO      128
#define XB_XCNT(j)  (256  + 64 * (j))
#define XB_XSUB(j)  (1280 + 64 * (j))
#define XB_XGEN(j)  (2304 + 64 * (j))
#define XB_TOP      3328
#define XB_TOPGEN   3392
#define XCD_BAR_WORDS 3456
#define XB_SPIN_CAP (1u << 18)
__device__ __forceinline__ unsigned xb_ld(unsigned* p)              { return __hip_atomic_load(p, __ATOMIC_RELAXED, __HIP_MEMORY_SCOPE_AGENT); }
__device__ __forceinline__ unsigned xb_add(unsigned* p, unsigned v) { return __hip_atomic_fetch_add(p, v, __ATOMIC_RELAXED, __HIP_MEMORY_SCOPE_AGENT); }
__device__ __forceinline__ unsigned xb_xcc_id() { return (unsigned)__builtin_amdgcn_s_getreg((3 << 11) | 20) & 0xFu; }
#define XB_SPIN(cond, bar) do { unsigned _sp = 0; while (cond) { __builtin_amdgcn_s_sleep(1); \
    if ((++_sp & 255u) == 0u) { if (xb_ld(&(bar)[XB_TMO])) break; if (_sp > XB_SPIN_CAP) { atomicAdd(&(bar)[XB_TMO], 1u); break; } } } } while (0)
struct XcdBarrier { unsigned* bar; unsigned x; volatile LAS unsigned* st; };
__device__ __forceinline__ XcdBarrier xcd_barrier_post(unsigned* bar, volatile LAS unsigned* st) {
    XcdBarrier b; b.bar = bar; b.x = xb_xcc_id(); b.st = st;
    if (threadIdx.x == 0) (void)xb_add(&bar[XB_XCNT(b.x)], 1u);
    return b;
}
__device__ __forceinline__ void xcd_barrier_complete(unsigned* bar, unsigned x, unsigned& nloc, unsigned& nx) {
    const unsigned G = gridDim.x * gridDim.y * gridDim.z;
    unsigned sum, cnt, mine, sp = 0u;
    for (;;) {
        sum = 0u; cnt = 0u; mine = 0u;
#pragma unroll
        for (unsigned j = 0; j < 16; ++j) { const unsigned c = xb_ld(&bar[XB_XCNT(j)]); sum += c; cnt += (c > 0u) ? 1u : 0u; mine = (j == x) ? c : mine; }
        if (sum == G) break;
        __builtin_amdgcn_s_sleep(1);
        if ((++sp & 255u) == 0u) { if (xb_ld(&bar[XB_TMO])) break; if (sp > XB_SPIN_CAP) { atomicAdd(&bar[XB_TMO], 1u); break; } }
    }
    nloc = mine > 0u ? mine : 1u; nx = cnt > 0u ? cnt : 1u;
}
__device__ __forceinline__ void xcd_barrier(const XcdBarrier& b) {
    asm volatile("s_waitcnt vmcnt(0)" ::: "memory");
    __syncthreads();
    if (threadIdx.x == 0) {
        unsigned* bar = b.bar; unsigned bx = b.x;
        asm volatile("" : "+s"(bar), "+s"(bx));
        __builtin_amdgcn_s_waitcnt(0);
        unsigned nloc = b.st[0], nx = b.st[1];
        if (nloc == 0u) { xcd_barrier_complete(bar, bx, nloc, nx); b.st[0] = nloc; b.st[1] = nx; }
        const unsigned old = xb_add(&bar[XB_XSUB(bx)], 1u);
        const unsigned gen = old / nloc;
        if (old + 1u == (gen + 1u) * nloc) {
            __builtin_amdgcn_fence(__ATOMIC_RELEASE, "agent");
            asm volatile("s_waitcnt vmcnt(0)" ::: "memory");
            const unsigned og = xb_add(&bar[XB_TOP], 1u);
            const unsigned tg = og / nx;
            if (og + 1u == (tg + 1u) * nx) xb_add(&bar[XB_TOPGEN], 1u);
            else XB_SPIN(xb_ld(&bar[XB_TOPGEN]) == tg, bar);
            __builtin_amdgcn_fence(__ATOMIC_ACQUIRE, "agent");
            xb_add(&bar[XB_XGEN(bx)], 1u);
            asm volatile("s_waitcnt vmcnt(0)" ::: "memory");
        } else {
            XB_SPIN(xb_ld(&bar[XB_XGEN(bx)]) == gen, bar);
            __builtin_amdgcn_fence(__ATOMIC_ACQUIRE, "agent");
            asm volatile("s_waitcnt vmcnt(0)" ::: "memory");
        }
    }
    __syncthreads();
}

struct Args { const float* in[22]; float* out; unsigned char* ws; int ph_lo, ph_hi; };
struct Frame {
    LAS unsigned char* lds; GAS unsigned char* ws; unsigned* ctl; GAS float* out;
    int tid, lane, wave, G, bid;
};
#define WSP(T_, off) ((T_*)(GAS T_*)(F.ws + (off)))
__device__ __forceinline__ const float* inptr(LAS unsigned char* lds, int k) {
    typedef unsigned u32x2 __attribute__((ext_vector_type(2)));
    const u32x2 v = *(const LAS u32x2*)(lds + MISC_OFF + 256 + k * 8);
    const unsigned long long p = ((unsigned long long)(unsigned)__builtin_amdgcn_readfirstlane((int)v.y) << 32) | (unsigned)__builtin_amdgcn_readfirstlane((int)v.x);
    return (const float*)p;
}
#define INP(k) inptr(F.lds, (k))
__device__ __forceinline__ Frame launder(const Frame& F0) {
    Frame F = F0;
    asm volatile("" : "+v"(F.tid), "+v"(F.lane));
    asm volatile("" : "+s"(F.ws), "+s"(F.out), "+s"(F.bid), "+s"(F.G), "+s"(F.wave));
    return F;
}

__device__ __forceinline__ void gemm_tile_128(f32x4 (&acc)[4][2], const bf16* __restrict__ A, int lda, const bf16* __restrict__ B, int ldb, int K, LAS unsigned char* lds) {
    LAS bf16* As = (LAS bf16*)lds; LAS bf16* Bs = As + 128 * 40;
    const int tid = otid(), lane = tid & 63, wave = tid >> 6, wm = wave >> 2, wn = wave & 3;
    const int lr = tid >> 2, lk = (tid & 3) * 8, fr = lane & 15, fq = lane >> 4;
    const bf16* ap = A + (size_t)lr * lda + lk; const bf16* bp = B + (size_t)lr * ldb + lk;
    u32x4 av = *(const u32x4*)ap, bv = *(const u32x4*)bp;
    for (int k0 = 0; k0 < K; k0 += 32) {
        __syncthreads();
        *(LAS u32x4*)(As + lr * 40 + lk) = av; *(LAS u32x4*)(Bs + lr * 40 + lk) = bv;
        __syncthreads();
        if (k0 + 32 < K) { av = *(const u32x4*)(ap + k0 + 32); bv = *(const u32x4*)(bp + k0 + 32); }
        bf16x8 af[4], bfr[2];
#pragma unroll
        for (int i = 0; i < 4; ++i) af[i] = *(const LAS bf16x8*)(As + (wm * 64 + i * 16 + fr) * 40 + fq * 8);
#pragma unroll
        for (int j = 0; j < 2; ++j) bfr[j] = *(const LAS bf16x8*)(Bs + (wn * 32 + j * 16 + fr) * 40 + fq * 8);
#pragma unroll
        for (int i = 0; i < 4; ++i)
#pragma unroll
            for (int j = 0; j < 2; ++j) acc[i][j] = __builtin_amdgcn_mfma_f32_16x16x32_bf16(bfr[j], af[i], acc[i][j], 0, 0, 0);
    }
}
#define ACC_ZERO(a) do { _Pragma("unroll") for (int _i = 0; _i < 4; ++_i) _Pragma("unroll") for (int _j = 0; _j < 2; ++_j) a[_i][_j] = (f32x4){0.f, 0.f, 0.f, 0.f}; } while (0)
#define TILE_FOREACH(acc, m0, n0, BODY) do { const int _t = otid(), _l = _t & 63, _w = _t >> 6; \
    _Pragma("unroll") for (int _i = 0; _i < 4; ++_i) _Pragma("unroll") for (int _j = 0; _j < 2; ++_j) { \
        const int ROW = (m0) + (_w >> 2) * 64 + _i * 16 + (_l & 15); const int COL = (n0) + (_w & 3) * 32 + _j * 16 + (_l >> 4) * 4; f32x4& V = acc[_i][_j]; BODY } } while (0)


namespace pg8 {
#define PG8_LAS __attribute__((address_space(3)))
typedef unsigned short bf16_t;
constexpr int BM = 256, BK = 64, HALF = 128, HTB = HALF * BK * 2  , STAGE_BYTES = 8 * HTB, NXCD = 8, WGM = 8;
__host__ __device__ __forceinline__ int lds_byte(int r, int c) { const int st = (r >> 4) * 2 + (c >> 5), rr = r & 15, cc = c & 31, ob = rr * 64 + cc * 2; return st * 1024 + (ob ^ (((ob >> 9) & 1) << 5)); }
__host__ __device__ __forceinline__ void stage_rc(int b, int& R, int& C) { const int st = b / 1024, sb = b % 1024, swz = sb ^ (((sb >> 9) & 1) << 5); R = (st >> 1) * 16 + swz / 64; C = (st & 1) * 32 + (swz % 64) / 2; }
__host__ __device__ __forceinline__ int perm32(int rho) { const int n = rho >> 4, i = rho & 15; return 8 * (i >> 2) + 4 * n + (i & 3); }
struct Unit { int pm, pn, e; };
struct Gemm { const bf16_t* A; const bf16_t* Bt; int lda, ldb, K; };
struct StaticOrder {
    int nM, nN, nwg, G, c;
    __device__ void init(int M, int N, int G_, int c_) { nM = M / BM; nN = N / BM; nwg = nM * nN; G = G_; c = c_; }
    __device__ bool next(int i, Unit& u) const {
        const long L = (long)i * G + c; if (L >= nwg) return false;
        int wgid = (int)L; { const int q = nwg / NXCD, r = nwg % NXCD, xcd = wgid % NXCD, off = wgid / NXCD; wgid = (xcd < r ? xcd * (q + 1) : r * (q + 1) + (xcd - r) * q) + off; }
        const int nig = WGM * nN, gid = wgid / nig, fm = gid * WGM, gsz = (nM - fm) < WGM ? (nM - fm) : WGM;
        u.pm = fm + ((wgid % nig) % gsz); u.pn = (wgid % nig) / gsz; u.e = 0; return true;
    }
    __device__ __forceinline__ const char* a_ptr(const Gemm& g, const Unit& u) const { return (const char*)g.A + (size_t)u.pm * BM * g.lda * 2; }
    __device__ __forceinline__ const char* b_ptr(const Gemm& g, const Unit& u) const { return (const char*)g.Bt + (size_t)u.pn * BM * g.ldb * 2; }
    __device__ __forceinline__ void a_ready(const Unit&) const {}
    __device__ __forceinline__ void done(const Unit&) const {}
};
struct MoeOrder {
    const PG8_LAS int* off; int ncol, G, c; size_t bexp;
    __device__ bool next(int i, Unit& u) const {
        const int L = i * G + c; if (L >= (off[32] >> 8) * ncol) return false;
        u.pm = L / ncol; u.pn = L % ncol; int e = 0;
#pragma unroll 1
        for (int j = 1; j < 32; ++j) if (u.pm * BM >= off[j]) e = j;
        u.e = e; return true;
    }
    __device__ __forceinline__ const char* a_ptr(const Gemm& g, const Unit& u) const { return (const char*)g.A + (size_t)u.pm * BM * g.lda * 2; }
    __device__ __forceinline__ const char* b_ptr(const Gemm& g, const Unit& u) const { return (const char*)g.Bt + (size_t)u.e * bexp + (size_t)u.pn * BM * g.ldb * 2; }
    __device__ __forceinline__ void a_ready(const Unit&) const {}
    __device__ __forceinline__ void done(const Unit&) const {}
};
__device__ __forceinline__ u32x4 pack8(f32x4 a, f32x4 b) { u32x4 w; w.x = pk2(a.x, a.y); w.y = pk2(a.z, a.w); w.z = pk2(b.x, b.y); w.w = pk2(b.z, b.w); return w; }
__device__ __forceinline__ f32x4 sig4(f32x4 v) { return (f32x4){sigmoidf(v.x), sigmoidf(v.y), sigmoidf(v.z), sigmoidf(v.w)}; }
__device__ __forceinline__ void unpack8(u32x4 w, f32x4& a, f32x4& b) { a = (f32x4){bf2f(w.x & 0xffffu), bf2f(w.x >> 16), bf2f(w.y & 0xffffu), bf2f(w.y >> 16)}; b = (f32x4){bf2f(w.z & 0xffffu), bf2f(w.z >> 16), bf2f(w.w & 0xffffu), bf2f(w.w >> 16)}; }

struct CmpOrder {
    int G, c;
    __device__ bool next(int i, Unit& u) const { const int L = i * G + c; if (L >= 32) return false; u.pm = L; u.pn = 0; u.e = L >> 2; return true; }
    __device__ __forceinline__ const char* a_ptr(const Gemm& g, const Unit& u) const { return (const char*)g.A + ((size_t)u.e * TP * 64 + (size_t)(u.pm & 3) * 256 * 1024) * 2; }
    __device__ __forceinline__ const char* b_ptr(const Gemm& g, const Unit& u) const { return (const char*)g.Bt + (size_t)(u.e & 1) * 256 * 2048 * 2; }
    __device__ __forceinline__ void a_ready(const Unit&) const {}
    __device__ __forceinline__ void done(const Unit&) const {}
};
struct EpiCmp1 {
    static constexpr bool PERM = true, AFTER_DRAIN = false; bf16* hc; const float* cb1;
    __device__ __forceinline__ void operator()(const f32x4 (&acc)[2][2][4][2], const Unit& u, int wr, int wc, int fr, int fq) const {
        const int row0 = u.pm * BM + wr * 64 + fr; const float* bb = cb1 + (u.e & 1) * 256;
#pragma unroll
        for (int ai = 0; ai < 2; ++ai)
#pragma unroll
            for (int m = 0; m < 4; ++m) { const int row = row0 + ai * HALF + m * 16;
#pragma unroll
                for (int bj = 0; bj < 2; ++bj) { const int col = bj * HALF + wc * 32 + fq * 8; f32x4 v0 = acc[ai][bj][m][0] + *(const f32x4*)(bb + col), v1 = acc[ai][bj][m][1] + *(const f32x4*)(bb + col + 4);
                    v0 = (f32x4){gelu_tanh(v0.x), gelu_tanh(v0.y), gelu_tanh(v0.z), gelu_tanh(v0.w)}; v1 = (f32x4){gelu_tanh(v1.x), gelu_tanh(v1.y), gelu_tanh(v1.z), gelu_tanh(v1.w)};
                    *(u32x4*)(hc + (size_t)row * 256 + col) = pack8(v0, v1); } }
    }
};
struct EpiInproj {
    static constexpr bool PERM = true, AFTER_DRAIN = false; unsigned char* ws;
    __device__ __forceinline__ void operator()(const f32x4 (&acc)[2][2][4][2], const Unit& u, int wr, int wc, int fr, int fq) const {
        const int row0 = u.pm * BM + wr * 64 + fr, pn = u.pn;
#pragma unroll
        for (int ai = 0; ai < 2; ++ai)
#pragma unroll
            for (int m = 0; m < 4; ++m) { const int row = row0 + ai * HALF + m * 16;
#pragma unroll
                for (int bj = 0; bj < 2; ++bj) { const int cc = bj * HALF + wc * 32 + fq * 8; const f32x4 v0 = acc[ai][bj][m][0], v1 = acc[ai][bj][m][1];
                    if (pn < 2) *(u32x4*)((bf16*)(ws + OFF_Q) + (size_t)row * 512 + pn * 256 + cc) = pack8(v0, v1);
                    else if (pn < 5) { const int s = (pn - 2) * 2 + bj, g = wc >> 1, d = (wc & 1) * 32 + fq * 8, b = row >> 14, t = row & (T - 1);
                        if (s < 2) *(u32x4*)((bf16*)(ws + OFF_KVC) + ((size_t)((b * 2 + g) * 2 + s) * TP + t) * 64 + d) = pack8(v0, v1);
                        else { bf16* tb = (bf16*)(ws + OFF_KS + (size_t)(s - 2) * SZ_KV) + (size_t)(b * 2 + g) * T * 64;
                            if (!ATTN_MFMA) *(u32x4*)(tb + (size_t)t * 64 + d) = pack8(v0, v1);
                            else if (s == 2 || s == 4) *(u32x4*)(tb + (size_t)(t >> 6) * 4096 + ktile_off(t & 63, d)) = pack8(v0, v1);
                            else { bf16* vb = tb + (size_t)(t >> 6) * 4096 + vtile_off(t & 63, d); const u32x4 w = pack8(v0, v1);
                                vb[0] = (bf16)(w.x & 0xffffu); vb[8] = (bf16)(w.x >> 16); vb[16] = (bf16)(w.y & 0xffffu); vb[24] = (bf16)(w.y >> 16);
                                vb[32] = (bf16)(w.z & 0xffffu); vb[40] = (bf16)(w.z >> 16); vb[48] = (bf16)(w.w & 0xffffu); vb[56] = (bf16)(w.w >> 16); } } }
                    else if (pn < 9) *(u32x4*)((bf16*)(ws + OFF_PU + (size_t)(pn - 5) * SZ_C256) + (size_t)row * 256 + cc) = pack8(v0, v1);
                    else if (pn == 9) { if (cc < 32) { float* p = (float*)(ws + OFF_NG) + (size_t)row * 32 + cc; *(f32x4*)p = sig4(v0); *(f32x4*)(p + 4) = sig4(v1); } }
                    else *(u32x4*)((bf16*)(ws + OFF_MG) + (size_t)row * 3072 + (pn - 10) * 256 + cc) = pack8(sig4(v0), sig4(v1));
                } }
    }
};
template <bool FIRST> struct EpiMerge {
    static constexpr bool PERM = true, AFTER_DRAIN = false; bf16* merged; const bf16* gate;
    __device__ __forceinline__ void operator()(const f32x4 (&acc)[2][2][4][2], const Unit& u, int wr, int wc, int fr, int fq) const {
        const int row0 = u.pm * BM + wr * 64 + fr;
#pragma unroll
        for (int ai = 0; ai < 2; ++ai)
#pragma unroll
            for (int m = 0; m < 4; ++m) { const int row = row0 + ai * HALF + m * 16;
#pragma unroll
                for (int bj = 0; bj < 2; ++bj) { const int col = u.pn * BM + bj * HALF + wc * 32 + fq * 8;
                    f32x4 g0, g1; unpack8(*(const u32x4*)(gate + (size_t)row * 3072 + col), g0, g1);
                    f32x4 o0 = g0 * acc[ai][bj][m][0], o1 = g1 * acc[ai][bj][m][1];
                    bf16* p = merged + (size_t)row * 1024 + col;
                    if (!FIRST) { f32x4 p0, p1; unpack8(*(const u32x4*)p, p0, p1); o0 += p0; o1 += p1; }
                    *(u32x4*)p = pack8(o0, o1); }
                if (!FIRST && (m & 1)) asm volatile("" ::: "memory"); }
    }
};
struct EpiWo {
    static constexpr bool PERM = false, AFTER_DRAIN = false; float* out;
    __device__ __forceinline__ void operator()(const f32x4 (&acc)[2][2][4][2], const Unit& u, int wr, int wc, int fr, int fq) const {
        const int row0 = u.pm * BM + wr * 64 + fr;
#pragma unroll
        for (int ai = 0; ai < 2; ++ai)
#pragma unroll
            for (int m = 0; m < 4; ++m) { float* rowp = out + (size_t)(row0 + ai * HALF + m * 16) * 1024 + u.pn * BM + wc * 32 + fq * 4;
#pragma unroll
                for (int bj = 0; bj < 2; ++bj)
#pragma unroll
                    for (int n = 0; n < 2; ++n) { f32x4* p = (f32x4*)(rowp + bj * HALF + n * 16); *p = *p + acc[ai][bj][m][n]; } }
    }
};
struct EpiMoe1 {
    static constexpr bool PERM = true, AFTER_DRAIN = false; bf16* hmid;
    __device__ __forceinline__ void operator()(const f32x4 (&acc)[2][2][4][2], const Unit& u, int wr, int wc, int fr, int fq) const {
        const int row0 = u.pm * BM + wr * 64 + fr;
#pragma unroll
        for (int ai = 0; ai < 2; ++ai)
#pragma unroll
            for (int m = 0; m < 4; ++m) { const int row = row0 + ai * HALF + m * 16;
                f32x4 o[2];
#pragma unroll
                for (int n = 0; n < 2; ++n) { const f32x4 x = acc[ai][0][m][n], y = acc[ai][1][m][n]; o[n] = (f32x4){siluf(x.x) * y.x, siluf(x.y) * y.y, siluf(x.z) * y.z, siluf(x.w) * y.w}; }
                *(u32x4*)(hmid + (size_t)row * 256 + u.pn * HALF + wc * 32 + fq * 8) = pack8(o[0], o[1]); }
    }
};
struct EpiMoe2 {
    static constexpr bool PERM = true, AFTER_DRAIN = false; bf16* ys; const float* slotc;
    __device__ __forceinline__ void operator()(const f32x4 (&acc)[2][2][4][2], const Unit& u, int wr, int wc, int fr, int fq) const {
        const int row0 = u.pm * BM + wr * 64 + fr;
#pragma unroll
        for (int ai = 0; ai < 2; ++ai)
#pragma unroll
            for (int m = 0; m < 4; ++m) { const int row = row0 + ai * HALF + m * 16; const float c = slotc[row];
#pragma unroll
                for (int bj = 0; bj < 2; ++bj) *(u32x4*)(ys + (size_t)row * 1024 + u.pn * BM + bj * HALF + wc * 32 + fq * 8) = pack8(acc[ai][bj][m][0] * c, acc[ai][bj][m][1] * c); }
    }
};
template <class Epi, class Sched, bool ALIGN_EPI = false, bool SP2 = false>
__device__ __forceinline__ void gemm_phase(PG8_LAS unsigned char* lds, const Gemm g, const Sched& S, const Epi& E) {
    const int tid = otid(), wid = __builtin_amdgcn_readfirstlane(tid >> 6), lane = tid & 63, wr = wid >> 2, wc = wid & 3, fr = lane & 15, fq = lane >> 4;
    int Kq = g.K; asm volatile("" : "+s"(Kq));
    const int K = Kq, nt = K / BK;
    unsigned voffA[2], voffB[2];
#pragma unroll
    for (int i = 0; i < 2; ++i) { int R, C; stage_rc(tid * 16 + i * 8192, R, C); const int Rb = Epi::PERM ? ((R & ~31) + perm32(R & 31)) : R;
        voffA[i] = (unsigned)(R * g.lda + C) * 2u; voffB[i] = (unsigned)(Rb * g.ldb + C) * 2u; }
    const size_t kstep = (size_t)(BK * 2);
    const size_t hstepA = (size_t)HALF * g.lda * 2, hstepB = (size_t)HALF * g.ldb * 2;
    const unsigned ldsw = (unsigned)wid * 1024u;
    const int aoff = lds_byte(wr * 64 + fr, fq * 8), boff = lds_byte(wc * 32 + fr, fq * 8);
#define PG8_SA(b, h) (((b) * 2 + (h)) * HTB)
#define PG8_SB(b, h) ((4 + (b) * 2 + (h)) * HTB)
#define PG8_STAGE(bufoff, gbase, voff) do { _Pragma("unroll") for (int _i = 0; _i < 2; ++_i) \
        __builtin_amdgcn_global_load_lds((const unsigned*)((const char*)(gbase) + (voff)[_i]), (PG8_LAS unsigned*)(lds + (bufoff) + ldsw + _i * 8192), 16, 0, 0); } while (0)
#define PG8_LDA(dst, b, h) do { _Pragma("unroll") for (int m = 0; m < 4; ++m) _Pragma("unroll") for (int k = 0; k < 2; ++k) dst[m][k] = *(const PG8_LAS bf16x8*)(lds + PG8_SA(b, h) + aoff + m * 2048 + k * 1024); } while (0)
#define PG8_LDB(dst, b, h) do { _Pragma("unroll") for (int n = 0; n < 2; ++n) _Pragma("unroll") for (int k = 0; k < 2; ++k) dst[n][k] = *(const PG8_LAS bf16x8*)(lds + PG8_SB(b, h) + boff + n * 2048 + k * 1024); } while (0)
#define PG8_MMA(ai, bj, At, Bt) do { __builtin_amdgcn_s_setprio(1); _Pragma("unroll") for (int m = 0; m < 4; ++m) _Pragma("unroll") for (int n = 0; n < 2; ++n) _Pragma("unroll") for (int k = 0; k < 2; ++k) \
        acc[ai][bj][m][n] = __builtin_amdgcn_mfma_f32_16x16x32_bf16(Bt[n][k], At[m][k], acc[ai][bj][m][n], 0, 0, 0); __builtin_amdgcn_s_setprio(0); } while (0)
#define PG8_WAIT_V(n) asm volatile("s_waitcnt vmcnt(" #n ")" ::: "memory")
#define PG8_WAIT_L(n) asm volatile("s_waitcnt lgkmcnt(" #n ")" ::: "memory")
#define PG8_BAR __builtin_amdgcn_s_barrier()
#define PG8_SCHED __builtin_amdgcn_sched_barrier(0)
    Unit cur, nxt; int ui = 0;
    if (!S.next(0, cur)) return;
    f32x4 acc[2][2][4][2];
#pragma unroll
    for (int a = 0; a < 2; ++a)
#pragma unroll
        for (int b = 0; b < 2; ++b)
#pragma unroll
            for (int m = 0; m < 4; ++m)
#pragma unroll
                for (int n = 0; n < 2; ++n) acc[a][b][m][n] = (f32x4){0.f, 0.f, 0.f, 0.f};
    bf16x8 At[4][2], B0[2][2], B1[2][2];
    const char* cA = S.a_ptr(g, cur); const char* cB = S.b_ptr(g, cur);
    S.a_ready(cur);
    if constexpr (SP2) {
        PG8_STAGE(PG8_SB(0, 0), cB, voffB); PG8_STAGE(PG8_SB(0, 1), cB + hstepB, voffB); PG8_STAGE(PG8_SA(0, 0), cA, voffA); PG8_STAGE(PG8_SA(0, 1), cA + hstepA, voffA);
        if (wr == 1) PG8_BAR;
        PG8_WAIT_V(2); PG8_BAR;
        PG8_STAGE(PG8_SB(1, 0), cB + kstep, voffB); PG8_STAGE(PG8_SA(1, 0), cA + kstep, voffA); PG8_STAGE(PG8_SB(1, 1), cB + hstepB + kstep, voffB);
        PG8_WAIT_V(6); PG8_BAR;
    } else {
        PG8_STAGE(PG8_SB(0, 0), cB, voffB); PG8_STAGE(PG8_SA(0, 0), cA, voffA); PG8_STAGE(PG8_SB(0, 1), cB + hstepB, voffB); PG8_STAGE(PG8_SA(0, 1), cA + hstepA, voffA);
        if (wr == 1) PG8_BAR;
        PG8_WAIT_V(4); PG8_BAR;
        PG8_STAGE(PG8_SB(1, 0), cB + kstep, voffB); PG8_STAGE(PG8_SA(1, 0), cA + kstep, voffA); PG8_STAGE(PG8_SB(1, 1), cB + hstepB + kstep, voffB);
        PG8_WAIT_V(6); PG8_BAR;
    }
    for (;;) {
        const bool has_next = S.next(ui + 1, nxt);
        const char* nA = has_next ? S.a_ptr(g, nxt) : cA; const char* nB = has_next ? S.b_ptr(g, nxt) : cB;
        for (int t = 0; t < nt; t += 2) {
            const bool last = (t == nt - 2);
            const char* a1 = cA + (size_t)(t + 1) * kstep;
            const char* a2 = last ? nA : cA + (size_t)(t + 2) * kstep; const char* b2 = last ? nB : cB + (size_t)(t + 2) * kstep;
            const char* a3 = a2 + kstep; const char* b3 = b2 + kstep;
            if (last && has_next) S.a_ready(nxt);
            if constexpr (SP2) {
            PG8_LDB(B0, 0, 0); PG8_LDB(B1, 0, 1); PG8_SCHED; PG8_LDA(At, 0, 0); PG8_STAGE(PG8_SA(1, 1), a1 + hstepA, voffA);
            PG8_WAIT_V(8); PG8_WAIT_L(0); PG8_BAR; PG8_MMA(0, 0, At, B0); PG8_MMA(0, 1, At, B1); PG8_BAR; PG8_SCHED;
            PG8_LDA(At, 0, 1); PG8_STAGE(PG8_SB(0, 0), b2, voffB); PG8_STAGE(PG8_SB(0, 1), b2 + hstepB, voffB); PG8_STAGE(PG8_SA(0, 0), a2, voffA);
            PG8_WAIT_V(8); PG8_WAIT_L(0); PG8_BAR; PG8_MMA(1, 0, At, B0); PG8_MMA(1, 1, At, B1); PG8_BAR; PG8_SCHED;
            PG8_LDB(B0, 1, 0); PG8_LDB(B1, 1, 1); PG8_SCHED; PG8_LDA(At, 1, 0); PG8_STAGE(PG8_SA(0, 1), a2 + hstepA, voffA);
            PG8_WAIT_V(8); PG8_WAIT_L(0); PG8_BAR; PG8_MMA(0, 0, At, B0); PG8_MMA(0, 1, At, B1); PG8_BAR; PG8_SCHED;
            PG8_LDA(At, 1, 1); PG8_STAGE(PG8_SB(1, 0), b3, voffB); PG8_STAGE(PG8_SB(1, 1), b3 + hstepB, voffB); PG8_STAGE(PG8_SA(1, 0), a3, voffA);
            PG8_WAIT_V(8); PG8_WAIT_L(0); PG8_BAR; PG8_MMA(1, 0, At, B0); PG8_MMA(1, 1, At, B1); PG8_BAR; PG8_SCHED;
            } else {
            PG8_LDB(B0, 0, 0); PG8_SCHED; PG8_LDA(At, 0, 0); PG8_STAGE(PG8_SA(1, 1), a1 + hstepA, voffA);
            PG8_WAIT_L(8); PG8_BAR; PG8_WAIT_L(0); PG8_MMA(0, 0, At, B0); PG8_BAR; PG8_SCHED;
            PG8_LDB(B1, 0, 1); PG8_STAGE(PG8_SB(0, 0), b2, voffB);
            PG8_BAR; PG8_WAIT_L(0); PG8_MMA(0, 1, At, B1); PG8_BAR;
            PG8_LDA(At, 0, 1); PG8_STAGE(PG8_SA(0, 0), a2, voffA);
            PG8_BAR; PG8_WAIT_L(0); PG8_MMA(1, 0, At, B0); PG8_BAR; PG8_SCHED;
            PG8_STAGE(PG8_SB(0, 1), b2 + hstepB, voffB);
            PG8_WAIT_V(6); PG8_BAR; PG8_MMA(1, 1, At, B1); PG8_BAR;
            PG8_LDB(B0, 1, 0); PG8_SCHED; PG8_LDA(At, 1, 0); PG8_STAGE(PG8_SA(0, 1), a2 + hstepA, voffA);
            PG8_WAIT_L(8); PG8_BAR; PG8_WAIT_L(0); PG8_MMA(0, 0, At, B0); PG8_BAR; PG8_SCHED;
            PG8_LDB(B1, 1, 1); PG8_STAGE(PG8_SB(1, 0), b3, voffB);
            PG8_BAR; PG8_WAIT_L(0); PG8_MMA(0, 1, At, B1); PG8_BAR;
            PG8_LDA(At, 1, 1); PG8_STAGE(PG8_SA(1, 0), a3, voffA);
            PG8_BAR; PG8_WAIT_L(0); PG8_MMA(1, 0, At, B0); PG8_BAR; PG8_SCHED;
            PG8_STAGE(PG8_SB(1, 1), b3 + hstepB, voffB);
            PG8_WAIT_V(6); PG8_BAR; PG8_MMA(1, 1, At, B1); PG8_BAR;
            }
        }
        if constexpr (ALIGN_EPI) { if (wr == 0) PG8_BAR; }
        if constexpr (!Epi::AFTER_DRAIN) { E(acc, cur, wr, wc, fr, fq); S.done(cur); }
        if (!has_next) break;
#pragma unroll
        for (int a = 0; a < 2; ++a)
#pragma unroll
            for (int b = 0; b < 2; ++b)
#pragma unroll
                for (int m = 0; m < 4; ++m)
#pragma unroll
                    for (int n = 0; n < 2; ++n) acc[a][b][m][n] = (f32x4){0.f, 0.f, 0.f, 0.f};
        cur = nxt; cA = nA; cB = nB; ++ui;
        if constexpr (ALIGN_EPI) { if (wr == 1) PG8_BAR; }
    }
    PG8_WAIT_V(0);
    if constexpr (!ALIGN_EPI) { if (wr == 0) PG8_BAR; }
    PG8_BAR;
    if constexpr (Epi::AFTER_DRAIN) { E.fused(acc, cur, wr, wc, fr, fq, lds, wid, lane); S.done(cur); }
#undef PG8_SA
#undef PG8_SB
#undef PG8_STAGE
#undef PG8_LDA
#undef PG8_LDB
#undef PG8_MMA
#undef PG8_WAIT_V
#undef PG8_WAIT_L
#undef PG8_BAR
#undef PG8_SCHED
}
}

__device__ __forceinline__ int map_row(int map, int n) {
    if (map == 0) return n;
    if (map == 1) {
        if (n < 1280) return n;
        if (n < 1304) return 2304 + (n - 1280);
        if (n < 1560) return 1280 + (n - 1304);
        if (n < 2328) return 1536 + (n - 1560);
        return 2560 + (n - 2328);
    }
    if (map == 2) return (n >> 7) * 256 + (n & 127);
    return (n >> 7) * 256 + 128 + (n & 127);
}
__device__ __forceinline__ void xpose_matrix(const Frame& F, const float* src, int K, int Ns, bf16* dst, int map, int nbatch = 1, size_t sstride = 0, size_t dstride = 0) {
    LAS float* tile = (LAS float*)F.lds;
    const int tid = otid(), nkt = K / 64, nnt = (Ns + 127) / 128, per = nkt * nnt, total = per * nbatch;
    const int n4 = (tid & 31) * 4, kk0 = tid >> 5, kc = tid & 7, nn0 = tid >> 3;
    f32x4 v[4];
    int it = F.bid;
    if (it < total) { const int bt = it / per, r = it % per, k0 = (r % nkt) * 64, n0 = (r / nkt) * 128; const float* sp = src + (size_t)bt * sstride;
#pragma unroll
        for (int i = 0; i < 4; ++i) v[i] = (n0 + n4 < Ns) ? *(const f32x4*)(sp + (size_t)(k0 + kk0 + 16 * i) * Ns + n0 + n4) : (f32x4){0.f, 0.f, 0.f, 0.f}; }
    for (; it < total; it += F.G) {
        const int bt = it / per, r = it % per, k0 = (r % nkt) * 64, n0 = (r / nkt) * 128;
        __syncthreads();
#pragma unroll
        for (int i = 0; i < 4; ++i) { LAS float* tp = tile + (kk0 + 16 * i) * 129 + n4; tp[0] = v[i].x; tp[1] = v[i].y; tp[2] = v[i].z; tp[3] = v[i].w; }
        __syncthreads();
        const int itn = it + F.G;
        if (itn < total) { const int btn = itn / per, rn = itn % per, k0n = (rn % nkt) * 64, n0n = (rn / nkt) * 128; const float* sp = src + (size_t)btn * sstride;
#pragma unroll
            for (int i = 0; i < 4; ++i) v[i] = (n0n + n4 < Ns) ? *(const f32x4*)(sp + (size_t)(k0n + kk0 + 16 * i) * Ns + n0n + n4) : (f32x4){0.f, 0.f, 0.f, 0.f}; }
        bf16* dp = dst + (size_t)bt * dstride;
#pragma unroll
        for (int i = 0; i < 2; ++i) { const int nn = nn0 + 64 * i, n = n0 + nn;
            if (n < Ns) { const LAS float* tp = tile + (kc * 8) * 129 + nn;
                u32x4 w; w.x = pk2(tp[0], tp[129]); w.y = pk2(tp[2 * 129], tp[3 * 129]); w.z = pk2(tp[4 * 129], tp[5 * 129]); w.w = pk2(tp[6 * 129], tp[7 * 129]);
                *(u32x4*)(dp + (size_t)map_row(map, n) * K + k0 + kc * 8) = w; } }
    }
    __syncthreads();
}
__device__ __forceinline__ void phase_weights(const Frame& F0, int l) { const Frame F = launder(F0);
    bf16* WIN = WSP(bf16, OFF_WIN);
    for (size_t i = (size_t)F.bid * 512 + F.tid; i < (size_t)(2560 - 2328) * 1024 / 2; i += (size_t)F.G * 512) ((unsigned*)(WIN + (size_t)2328 * 1024))[i] = 0u;
    for (size_t i = (size_t)F.bid * 512 + F.tid; i < (size_t)2 * 64 * 256 / 2; i += (size_t)F.G * 512) WSP(unsigned, OFF_CW2)[(i / 8192) * 16384 + 8192 + (i % 8192)] = 0u;
    __syncthreads();
    xpose_matrix(F, INP(2) + (size_t)l * 1024 * IN_DIM, 1024, IN_DIM, WIN, 1);
    for (int s = 0; s < 2; ++s) {
        xpose_matrix(F, INP(4) + ((size_t)l * 2 + s) * 2048 * 256, 2048, 256, WSP(bf16, OFF_CW1) + (size_t)s * 256 * 2048, 0);
        xpose_matrix(F, INP(5) + ((size_t)l * 2 + s) * 256 * 64, 256, 64, WSP(bf16, OFF_CW2) + (size_t)s * 128 * 256, 0);
    }
    xpose_matrix(F, INP(6) + (size_t)l * 512 * 1024, 512, 1024, WSP(bf16, OFF_WN), 0);
    {
        const float* pw = INP(7) + (size_t)l * 4 * 64 * 64; const float* psc = INP(8) + (size_t)l * 256; const float* wp = INP(9) + (size_t)l * 256 * 1024; bf16* wpt = WSP(bf16, OFF_WP);
        for (int o = F.bid * 512 + F.tid; o < 256 * 1024; o += F.G * 512) { const int k = o >> 10, n = o & 1023, g = k >> 6;
            float a = 0.f;
#pragma unroll 8
            for (int d = 0; d < 64; ++d) a += pw[(size_t)k * 64 + d] * psc[g * 64 + d] * wp[(size_t)(g * 64 + d) * 1024 + n];
            wpt[(size_t)n * 256 + k] = (bf16)f2bf(a); } }
    xpose_matrix(F, INP(11) + (size_t)l * 256 * 1024, 256, 1024, WSP(bf16, OFF_WC), 0);
    xpose_matrix(F, INP(12) + (size_t)l * 1024 * 1024, 1024, 1024, WSP(bf16, OFF_WO), 0);
    xpose_matrix(F, INP(18) + (size_t)l * NEXP * 1024 * 256, 1024, 256, WSP(bf16, OFF_W13), 2, NEXP, (size_t)1024 * 256, (size_t)512 * 1024);
    xpose_matrix(F, INP(19) + (size_t)l * NEXP * 1024 * 256, 1024, 256, WSP(bf16, OFF_W13), 3, NEXP, (size_t)1024 * 256, (size_t)512 * 1024);
    xpose_matrix(F, INP(20) + (size_t)l * NEXP * 256 * 1024, 256, 1024, WSP(bf16, OFF_W2), 0, NEXP, (size_t)256 * 1024, (size_t)1024 * 256);
    {   const float* g2 = INP(13) + (size_t)l * D; const float* wg = INP(14) + (size_t)l * D * 4; const float* we = INP(16) + (size_t)l * D * 32; bf16* wr = WSP(bf16, OFF_WR);
        for (int o = F.bid * 512 + F.tid; o < 64 * 1024; o += F.G * 512) { const int j = o >> 10, k = o & 1023;
            const float w = g2[k] * ((j < 32) ? we[(size_t)k * 32 + j] : (j < 36) ? wg[(size_t)k * 4 + (j - 32)] : 0.f);
            const unsigned hi = f2bf(w), lo = f2bf(w - bf2f(hi)); wr[o] = (bf16)hi; wr[64 * 1024 + o] = (bf16)lo; } }
    for (int it = F.bid * 8 + F.wave; it < 8; it += F.G * 8) {
        const int s = it >> 2, j = (it & 3) * 64 + F.lane;
        const float* pe = INP(3) + ((size_t)l * 2 + s) * 2048; const float* w1 = INP(4) + ((size_t)l * 2 + s) * 2048 * 256;
        float a = 0.f;
        for (int k = 0; k < 2048; ++k) a += pe[k] * w1[(size_t)k * 256 + j];
        WSP(float, OFF_CB1)[s * 256 + j] = a;
    }
}

template <bool FINAL> __device__ __forceinline__ void phase_norm(const Frame& F0, int l, const float* g) { const Frame F = launder(F0);
    const int gw = F.bid * 8 + F.wave, NGW = F.G * 8;
    const int* toks = WSP(int, OFF_TOKS); const bf16* ys = WSP(bf16, OFF_YS); bf16* xn = WSP(bf16, OFF_XN);
    for (int n = gw; n < NTOK; n += NGW) {
        f32x4 v[4]; float ss = 0.f;
        if (l == 0) {
            const f32x4* xr = (const f32x4*)(INP(0) + (size_t)n * D) + F.lane;
#pragma unroll
            for (int j = 0; j < 4; ++j) v[j] = xr[64 * j];
        } else {
            const f32x4* hr = (const f32x4*)(F.out + (size_t)n * D) + F.lane;
            const int s0 = toks[n * 2], s1 = toks[n * 2 + 1];
            const bf16* y0 = ys + (size_t)s0 * D + F.lane * 4; const bf16* y1 = ys + (size_t)s1 * D + F.lane * 4;
#pragma unroll
            for (int j = 0; j < 4; ++j) v[j] = hr[64 * j] + ld4bf(y0 + 256 * j) + ld4bf(y1 + 256 * j);
        }
#pragma unroll
        for (int j = 0; j < 4; ++j) ss += (v[j].x * v[j].x + v[j].y * v[j].y) + (v[j].z * v[j].z + v[j].w * v[j].w);
        const float rs = 1.f / sqrtf(wave_sum(ss) * (1.f / D) + RMS_EPS);
        f32x4* orow = (f32x4*)(F.out + (size_t)n * D) + F.lane;
#pragma unroll
        for (int j = 0; j < 4; ++j) {
            const f32x4 gg = ((const f32x4*)g)[F.lane + 64 * j];
            const f32x4 y = v[j] * rs * gg;
            if (FINAL) orow[64 * j] = y;
            else { orow[64 * j] = v[j]; st4bf(xn + (size_t)n * D + F.lane * 4 + 256 * j, y); }
        }
    }
}

__device__ __forceinline__ void epi_inproj(const Frame& F, int row, int col, f32x4 v) {
    if (col < 512) { st4bf(WSP(bf16, OFF_Q) + (size_t)row * 512 + col, v); }
    else if (col < 1280) {
        const int c = col - 512, s = c >> 7, g = (c >> 6) & 1, d = c & 63, b = row >> 14, t = row & (T - 1);
        bf16* dst;
        if (s < 2) dst = WSP(bf16, OFF_KVC) + ((size_t)((b * 2 + g) * 2 + s) * TP + t) * 64 + d;
        else dst = WSP(bf16, OFF_KS + (size_t)(s - 2) * SZ_KV) + ((size_t)(b * 2 + g) * T + t) * 64 + d;
        st4bf(dst, v);
    }
    else if (col < 1536) { st4bf(WSP(bf16, OFF_PU) + (size_t)row * 256 + (col - 1280), v); }
    else if (col < 2304) { const int c = col - 1536; st4bf(WSP(bf16, OFF_CH + (size_t)(c >> 8) * SZ_C256) + (size_t)row * 256 + (c & 255), v); }
    else if (col < 2560) { const int c = col - 2304; if (c < 32) *(f32x4*)(WSP(float, OFF_NG) + (size_t)row * 32 + c) = (f32x4){sigmoidf(v.x), sigmoidf(v.y), sigmoidf(v.z), sigmoidf(v.w)}; }
    else { st4bf(WSP(bf16, OFF_MG) + (size_t)row * 3072 + (col - 2560), (f32x4){sigmoidf(v.x), sigmoidf(v.y), sigmoidf(v.z), sigmoidf(v.w)}); }
}
__device__ __forceinline__ void phase_inproj(const Frame& F0) { const Frame F = launder(F0);
    const bf16* XN = WSP(bf16, OFF_XN); const bf16* W = WSP(bf16, OFF_WIN);
    constexpr int NT = INP / 128, MT = NTOK / 128;
    for (int it = F.bid; it < MT * NT; it += F.G) {
        const int mt = it / NT, nt = it % NT;
        f32x4 acc[4][2]; ACC_ZERO(acc);
        gemm_tile_128(acc, XN + (size_t)mt * 128 * D, D, W + (size_t)nt * 128 * D, D, D, F.lds);
        TILE_FOREACH(acc, mt * 128, nt * 128, { epi_inproj(F, ROW, COL, V); });
    }
}

__device__ __forceinline__ void phase_cmp1(const Frame& F0) { const Frame F = launder(F0);
    const bf16* KVC = WSP(bf16, OFF_KVC); bf16* HC = WSP(bf16, OFF_HC); const float* cb1 = WSP(float, OFF_CB1);
    for (int it = F.bid; it < 64 * 2; it += F.G) {
        const int mt = it >> 1, nt = it & 1, plane = mt >> 3, i0 = (mt & 7) * 128, s = plane & 1;
        f32x4 acc[4][2]; ACC_ZERO(acc);
        gemm_tile_128(acc, KVC + (size_t)plane * TP * 64 + (size_t)i0 * 1024, 1024, WSP(bf16, OFF_CW1) + (size_t)s * 256 * 2048 + (size_t)nt * 128 * 2048, 2048, 2048, F.lds);
        TILE_FOREACH(acc, mt * 128, nt * 128, {
            const f32x4 bb = *(const f32x4*)(cb1 + s * 256 + COL);
            st4bf(HC + (size_t)ROW * 256 + COL, (f32x4){gelu_tanh(V.x + bb.x), gelu_tanh(V.y + bb.y), gelu_tanh(V.z + bb.z), gelu_tanh(V.w + bb.w)}); });
    }
}
__device__ __forceinline__ void phase_cmp2(const Frame& F0) { const Frame F = launder(F0);
    const bf16* HC = WSP(bf16, OFF_HC);
    for (int it = F.bid; it < 64; it += F.G) {
        const int mt = it, plane = mt >> 3, s = plane & 1, bg = plane >> 1;
        f32x4 acc[4][2]; ACC_ZERO(acc);
        gemm_tile_128(acc, HC + (size_t)mt * 128 * 256, 256, WSP(bf16, OFF_CW2) + (size_t)s * 128 * 256, 256, 256, F.lds);
        bf16* dst = WSP(bf16, s == 0 ? OFF_KC : OFF_VC) + (size_t)bg * 1024 * 64;
        if (ATTN_MFMA && s == 1) {
            TILE_FOREACH(acc, (mt & 7) * 128, 0, { if (COL < 64) { f32x4 o = V; if (ROW == 1023) o = o * 0.f;
                bf16* vb = dst + (size_t)(ROW >> 6) * 4096 + vtile_off(ROW & 63, COL);
                vb[0] = (bf16)f2bf(o.x); vb[8] = (bf16)f2bf(o.y); vb[16] = (bf16)f2bf(o.z); vb[24] = (bf16)f2bf(o.w); } });
        } else if (ATTN_MFMA) {
            TILE_FOREACH(acc, (mt & 7) * 128, 0, { if (COL < 64) { f32x4 o = V; if (ROW == 1023) o = o * 0.f; st4bf(dst + (size_t)(ROW >> 6) * 4096 + ktile_off(ROW & 63, COL & ~7) + (COL & 7), o); } });
        } else {
            TILE_FOREACH(acc, (mt & 7) * 128, 0, { if (COL < 64) { f32x4 o = V; if (ROW == 1023) o = o * 0.f; st4bf(dst + (size_t)ROW * 64 + COL, o); } });
        }
    }
}

__device__ __forceinline__ void ld8bf(const bf16* p, f32x4& a, f32x4& b) { const u32x4 w = *(const u32x4*)p;
    a = (f32x4){bf2f(w.x & 0xffffu), bf2f(w.x >> 16), bf2f(w.y & 0xffffu), bf2f(w.y >> 16)}; b = (f32x4){bf2f(w.z & 0xffffu), bf2f(w.z >> 16), bf2f(w.w & 0xffffu), bf2f(w.w >> 16)}; }
template <int W> __device__ __forceinline__ void pool_window(const bf16* pu, int t, f32x4& s0, f32x4& s1) {
    if (t >= W - 1) {
#pragma unroll
        for (int i = 1; i < W; ++i) { f32x4 a, b; ld8bf(pu - (size_t)i * 256, a, b); s0 += a; s1 += b; }
    } else { for (int i = 1; i <= t; ++i) { f32x4 a, b; ld8bf(pu - (size_t)i * 256, a, b); s0 += a; s1 += b; } }
}
__device__ __forceinline__ void phase_poolconv(const Frame& F0, int l, int first_blk) { const Frame F = launder(F0);
    const bf16* PU = WSP(bf16, OFF_PU); const bf16* CH = WSP(bf16, OFF_CH); const bf16* CBp = WSP(bf16, OFF_CB); const bf16* CC = WSP(bf16, OFF_CC);
    bf16* PM = WSP(bf16, OFF_PM); bf16* CV = WSP(bf16, OFF_CV);
    const float* cw = INP(10) + (size_t)l * 3 * 256;
    const int nb = F.G - first_blk; if (F.bid < first_blk) return;
    for (int it = (F.bid - first_blk) * 512 + F.tid; it < NTOK * 32; it += nb * 512) {
        const int n = it >> 5, c0 = (it & 31) * 8, t = n & (T - 1), g = c0 >> 6;
        const size_t r = (size_t)n * 256 + c0;
        {   f32x4 u0, u1; ld8bf(PU + r, u0, u1); f32x4 s0 = u0, s1 = u1;
            if (g == 0) pool_window<2>(PU + r, t, s0, s1); else if (g == 1) pool_window<4>(PU + r, t, s0, s1); else if (g == 2) pool_window<8>(PU + r, t, s0, s1); else pool_window<16>(PU + r, t, s0, s1);
            const int w = 2 << g; const float inv = 1.f / (float)((t + 1 < w) ? t + 1 : w);
            *(u32x4*)(PM + r) = pg8::pack8(s0 * inv - u0, s1 * inv - u1); }
        {   f32x4 y0 = {0.f, 0.f, 0.f, 0.f}, y1 = y0;
#pragma unroll
            for (int k = 0; k < 3; ++k) { if (t - 2 + k >= 0) { const size_t rr = r - (size_t)(2 - k) * 256; f32x4 a0, a1, h0, h1; ld8bf(CC + rr, a0, a1); ld8bf(CH + rr, h0, h1);
                y0 += *(const f32x4*)(cw + k * 256 + c0) * a0 * h0; y1 += *(const f32x4*)(cw + k * 256 + c0 + 4) * a1 * h1; } }
            f32x4 b0, b1; ld8bf(CBp + r, b0, b1);
            *(u32x4*)(CV + r) = pg8::pack8(y0 * b0, y1 * b1); }
    }
}

__device__ __forceinline__ void dot4(const bf16* krow, const LAS float* qs, float (&acc)[4]) {
#pragma unroll
    for (int c = 0; c < 8; ++c) {
        const uint4 kv = ((const uint4*)krow)[c];
        const float k0 = bf2f(kv.x & 0xffffu), k1 = bf2f(kv.x >> 16), k2 = bf2f(kv.y & 0xffffu), k3 = bf2f(kv.y >> 16), k4 = bf2f(kv.z & 0xffffu), k5 = bf2f(kv.z >> 16), k6 = bf2f(kv.w & 0xffffu), k7 = bf2f(kv.w >> 16);
#pragma unroll
        for (int r = 0; r < 4; ++r) { const LAS float* q = qs + r * 64 + c * 8;
            acc[r] += (k0 * q[0] + k1 * q[1]) + (k2 * q[2] + k3 * q[3]) + (k4 * q[4] + k5 * q[5]) + (k6 * q[6] + k7 * q[7]); }
    }
}
__device__ __forceinline__ void softmax4(LAS float* sc, int n, int lane) {
#pragma unroll
    for (int r = 0; r < 4; ++r) {
        LAS float* s = sc + r * 1024; float m = -INFINITY;
        for (int c = lane; c < n; c += 64) m = fmaxf(m, s[c]);
        m = wave_max(m);
        float sum = 0.f;
        for (int c = lane; c < n; c += 64) { const float e = __expf(s[c] - m); s[c] = e; sum += e; }
        sum = wave_sum(sum);
        const float inv = 1.f / sum;
        for (int c = lane; c < n; c += 64) s[c] *= inv;
    }
}
__device__ __forceinline__ void phase_attn_valu(const Frame& F0) { const Frame F = launder(F0);
    LAS float* sc = (LAS float*)(F.lds + F.wave * 17472); LAS float* qs = sc + 4096; LAS int* sel = (LAS int*)(qs + 256);
    const int lane = F.lane;
    const bf16* Q = WSP(bf16, OFF_Q); const float* NG = WSP(float, OFF_NG); bf16* O = WSP(bf16, OFF_O);
    for (int task = F.bid * 8 + F.wave; task < 2 * NTOK; task += F.G * 8) {
        const int bg = task >> 14, t = task & (T - 1), b = bg >> 1, g = bg & 1, n = b * T + t;
        { const f32x4 q4 = ld4bf(Q + (size_t)n * 512 + g * 256 + lane * 4); *(LAS f32x4*)(qs + lane * 4) = q4; }
        WAVE_SYNC();
        float slope[4];
#pragma unroll
        for (int r = 0; r < 4; ++r) slope[r] = exp2f(-(float)(g * 4 + r + 1));
        const int ncv = (t >= 31) ? ((t - 31) >> 4) + 1 : 0;
        const bf16* kc = WSP(bf16, OFF_KC) + (size_t)bg * 1024 * 64; const bf16* vc = WSP(bf16, OFF_VC) + (size_t)bg * 1024 * 64;
        for (int c = lane; c < ncv; c += 64) {
            float a[4] = {0.f, 0.f, 0.f, 0.f}; dot4(kc + (size_t)c * 64, qs, a);
            const float dist = (float)(t - (16 * c + 31));
#pragma unroll
            for (int r = 0; r < 4; ++r) sc[r * 1024 + c] = a[r] * 0.125f - slope[r] * dist;
        }
        WAVE_SYNC();
        float oc[4] = {0.f, 0.f, 0.f, 0.f};
        if (ncv > 0) {
            softmax4(sc, ncv, lane);
            WAVE_SYNC();
            for (int c = 0; c < ncv; ++c) { const float v = bf2f(vc[(size_t)c * 64 + lane]);
#pragma unroll
                for (int r = 0; r < 4; ++r) oc[r] += sc[r * 1024 + c] * v; }
            WAVE_SYNC();
            for (int c = lane; c < ncv; c += 64) sc[c] = (sc[c] + sc[1024 + c]) + (sc[2048 + c] + sc[3072 + c]);
        }
        WAVE_SYNC();
        const int cur = t >> 6;
        float val[4];
#pragma unroll
        for (int i = 0; i < 4; ++i) {
            const int j = lane + 64 * i; float imp = 0.f;
#pragma unroll
            for (int o = 0; o < 5; ++o) { const int c = 4 * j + o - 1; if (c >= 0 && c < ncv) imp += sc[c]; }
            const bool forced = (j == 0) || (j == cur) || (j == cur - 1), valid = (j <= cur);
            val[i] = forced ? 1e30f : (valid ? imp : -1e30f);
        }
        WAVE_SYNC();
        int nsel = 0;
        for (int it = 0; it < 16; ++it) {
            float bv = val[0]; int bj = lane;
#pragma unroll
            for (int i = 1; i < 4; ++i) if (val[i] > bv) { bv = val[i]; bj = lane + 64 * i; }
#pragma unroll
            for (int o = 1; o < 64; o <<= 1) { const float ov = __shfl_xor(bv, o); const int oj = __shfl_xor(bj, o); if (ov > bv || (ov == bv && oj < bj)) { bv = ov; bj = oj; } }
            if (bv < -1e29f) break;
            if (lane == 0) sel[nsel] = bj;
            ++nsel;
#pragma unroll
            for (int i = 0; i < 4; ++i) if (bj == lane + 64 * i) val[i] = -INFINITY;
        }
        WAVE_SYNC();
        const bf16* ks = WSP(bf16, OFF_KS) + (size_t)bg * T * 64; const bf16* vs = WSP(bf16, OFF_VS) + (size_t)bg * T * 64;
        for (int i = 0; i < nsel; ++i) {
            const int pos = sel[i] * 64 + lane;
            float a[4] = {0.f, 0.f, 0.f, 0.f}; dot4(ks + (size_t)pos * 64, qs, a);
            const float dist = (float)(t - pos);
#pragma unroll
            for (int r = 0; r < 4; ++r) sc[r * 1024 + i * 64 + lane] = (pos <= t) ? a[r] * 0.125f - slope[r] * dist : -INFINITY;
        }
        WAVE_SYNC();
        softmax4(sc, nsel * 64, lane);
        WAVE_SYNC();
        float os[4] = {0.f, 0.f, 0.f, 0.f};
        for (int i = 0; i < nsel; ++i) { const bf16* vb = vs + (size_t)sel[i] * 64 * 64 + lane;
            for (int k = 0; k < 64; ++k) { const float v = bf2f(vb[k * 64]);
#pragma unroll
                for (int r = 0; r < 4; ++r) os[r] += sc[r * 1024 + i * 64 + k] * v; } }
        WAVE_SYNC();
        const bf16* kw = WSP(bf16, OFF_KW) + (size_t)bg * T * 64; const bf16* vw = WSP(bf16, OFF_VW) + (size_t)bg * T * 64;
        const int lo = (t >= 511) ? t - 511 : 0, nk = t - lo + 1;
        for (int i = lane; i < nk; i += 64) {
            const int pos = lo + i;
            float a[4] = {0.f, 0.f, 0.f, 0.f}; dot4(kw + (size_t)pos * 64, qs, a);
            const float dist = (float)(t - pos);
#pragma unroll
            for (int r = 0; r < 4; ++r) sc[r * 1024 + i] = a[r] * 0.125f - slope[r] * dist;
        }
        WAVE_SYNC();
        softmax4(sc, nk, lane);
        WAVE_SYNC();
        float ow[4] = {0.f, 0.f, 0.f, 0.f};
        for (int i = 0; i < nk; ++i) { const float v = bf2f(vw[(size_t)(lo + i) * 64 + lane]);
#pragma unroll
            for (int r = 0; r < 4; ++r) ow[r] += sc[r * 1024 + i] * v; }
        WAVE_SYNC();
        const float* ng = NG + (size_t)n * 32 + g * 12;
#pragma unroll
        for (int r = 0; r < 4; ++r) O[(size_t)n * 512 + g * 256 + r * 64 + lane] = (bf16)f2bf(ng[r * 3] * oc[r] + ng[r * 3 + 1] * os[r] + ng[r * 3 + 2] * ow[r]);
    }
}


typedef float f32x16 __attribute__((ext_vector_type(16)));
typedef float f32x2_t __attribute__((ext_vector_type(2))); typedef __bf16 bf16x2_t __attribute__((ext_vector_type(2)));
__device__ __forceinline__ unsigned cvtpk(float lo, float hi) { f32x2_t v = {lo, hi}; bf16x2_t b = __builtin_convertvector(v, bf16x2_t); return __builtin_bit_cast(unsigned, b); }
__device__ __forceinline__ float pmax32(float x) { auto rr = __builtin_amdgcn_permlane32_swap(__float_as_uint(x), __float_as_uint(x), false, false); return fmaxf(__uint_as_float(rr[0]), __uint_as_float(rr[1])); }
__device__ __forceinline__ float psum32(float x) { auto rr = __builtin_amdgcn_permlane32_swap(__float_as_uint(x), __float_as_uint(x), false, false); return __uint_as_float(rr[0]) + __uint_as_float(rr[1]); }
__device__ __forceinline__ float ex2(float x) { return __builtin_amdgcn_exp2f(x); }
constexpr float ANEG = -1e30f;
#ifndef ATTN_PROBE
#define ATTN_PROBE 0
#endif
#define APD(b) (((ATTN_PROBE >> (b)) & 1) ? 2 : 1)
#define KKC(kh, i) ((kh) * 32 + ((i) & 3) + 8 * ((i) >> 2))
struct AttnSt { f32x16 o0, o1; float m, l; };
__device__ __forceinline__ void attn_loadk(bf16x8 (&kf)[2][4], const bf16* kt, int r32, int h) {
#pragma unroll
    for (int kh = 0; kh < 2; ++kh)
#pragma unroll
        for (int ks = 0; ks < 4; ++ks) kf[kh][ks] = *(const bf16x8*)(kt + ((kh * 4 + ks) * 64 + h * 32 + r32) * 8);
}
template <int MODE> __device__ __forceinline__ void attn_scores(f32x16& s0, f32x16& s1, const bf16x8 (&kf)[2][4], const bf16x8 (&qf)[4], float cb, float slk, int lo, int hi, int h, bool domask) {
    asm volatile("" : "+v"(slk));
    const float cbh = cb + slk * (float)(4 * h);
#pragma unroll
    for (int i = 0; i < 16; ++i) { s0[i] = cbh + slk * (float)KKC(0, i); s1[i] = cbh + slk * (float)KKC(1, i); }
#pragma unroll
    for (int ks = 0; ks < 4; ++ks) { s0 = __builtin_amdgcn_mfma_f32_32x32x16_bf16(kf[0][ks], qf[ks], s0, 0, 0, 0); s1 = __builtin_amdgcn_mfma_f32_32x32x16_bf16(kf[1][ks], qf[ks], s1, 0, 0, 0); }
    if (domask) { const int hh = hi - 4 * h, ll = lo - 4 * h;
#pragma unroll
        for (int i = 0; i < 16; ++i) {
            const bool v0 = (KKC(0, i) <= hh) && (MODE == 1 || KKC(0, i) >= ll), v1 = (KKC(1, i) <= hh) && (MODE == 1 || KKC(1, i) >= ll);
            s0[i] = v0 ? s0[i] : ANEG; s1[i] = v1 ? s1[i] : ANEG; } }
}
__device__ __forceinline__ float max16x2(const f32x16& a, const f32x16& b) {
    float m0 = fmaxf(fmaxf(a[0], a[1]), fmaxf(a[2], a[3])), m1 = fmaxf(fmaxf(a[4], a[5]), fmaxf(a[6], a[7])), m2 = fmaxf(fmaxf(a[8], a[9]), fmaxf(a[10], a[11])), m3 = fmaxf(fmaxf(a[12], a[13]), fmaxf(a[14], a[15]));
    float n0 = fmaxf(fmaxf(b[0], b[1]), fmaxf(b[2], b[3])), n1 = fmaxf(fmaxf(b[4], b[5]), fmaxf(b[6], b[7])), n2 = fmaxf(fmaxf(b[8], b[9]), fmaxf(b[10], b[11])), n3 = fmaxf(fmaxf(b[12], b[13]), fmaxf(b[14], b[15]));
    return fmaxf(fmaxf(fmaxf(m0, m1), fmaxf(m2, m3)), fmaxf(fmaxf(n0, n1), fmaxf(n2, n3)));
}
__device__ __forceinline__ void attn_loadv(bf16x8 (&vf)[2][4], const bf16* vt, int r32, int h) {
#pragma unroll
    for (int dh = 0; dh < 2; ++dh)
#pragma unroll
        for (int k4 = 0; k4 < 4; ++k4) vf[dh][k4] = *(const bf16x8*)(vt + ((dh * 4 + k4) * 64 + h * 32 + r32) * 8);
}
__device__ __forceinline__ void attn_pv(f32x16& o0, f32x16& o1, const f32x16& p0, const f32x16& p1, const bf16x8 (&vf)[2][4]) {
#pragma unroll
    for (int k4 = 0; k4 < 4; ++k4) {
        const f32x16& p = (k4 < 2) ? p0 : p1; const int b = (k4 & 1) * 8;
        typedef unsigned u32x4v __attribute__((ext_vector_type(4)));
        u32x4v w; w.x = cvtpk(p[b + 0], p[b + 1]); w.y = cvtpk(p[b + 2], p[b + 3]); w.z = cvtpk(p[b + 4], p[b + 5]); w.w = cvtpk(p[b + 6], p[b + 7]);
        const bf16x8 pf = __builtin_bit_cast(bf16x8, w);
        o0 = __builtin_amdgcn_mfma_f32_32x32x16_bf16(vf[0][k4], pf, o0, 0, 0, 0);
        o1 = __builtin_amdgcn_mfma_f32_32x32x16_bf16(vf[1][k4], pf, o1, 0, 0, 0);
    }
}
template <int MODE> __device__ __forceinline__ void attn_tile(AttnSt& st, bf16x8 (&kf)[2][4], const bf16* kt_next, const bf16* vt, const bf16x8 (&qf)[4], float cb, float slk, int lo, int hi, int r32, int h, bool domask) {
    f32x16 s0, s1; bf16x8 vf[2][4];
    attn_loadv(vf, vt, r32, h);
#if ATTN_PROBE & 32
    bf16x8 vf2[2][4], kf2[2][4]; attn_loadv(vf2, vt + 4096, r32, h); attn_loadk(kf2, kt_next + 4096, r32, h);
#endif
    attn_scores<MODE>(s0, s1, kf, qf, cb, slk, lo, hi, h, domask);
    attn_loadk(kf, kt_next, r32, h);
    const float tm = pmax32(max16x2(s0, s1));
    const float mn = fmaxf(st.m, tm), mu = (mn > -1e29f) ? mn : 0.f;
    if (!__all(mn == st.m)) { const float al = ex2(st.m - mn); st.l *= al; st.o0 *= al; st.o1 *= al; st.m = mn; }
    float ls = 0.f;
#pragma unroll
    for (int i = 0; i < 16; ++i) { s0[i] = ex2(s0[i] - mu); s1[i] = ex2(s1[i] - mu); ls += s0[i] + s1[i]; }
    st.l += ls;
#if ATTN_PROBE & 64
    { float dz = 0.f;
#pragma unroll
      for (int i = 0; i < 16; ++i) dz += ex2(s0[i] * 0.5f - 3.f) + ex2(s1[i] * 0.5f - 3.f);
      asm volatile("" :: "v"(dz)); }
#endif
    attn_pv(st.o0, st.o1, s0, s1, vf);
#if ATTN_PROBE & 32
#pragma unroll
    for (int a = 0; a < 2; ++a)
#pragma unroll
        for (int b = 0; b < 4; ++b) asm volatile("" :: "v"(vf2[a][b]), "v"(kf2[a][b]));
#endif
}
__device__ __forceinline__ int imax_row16(int x) {
    x = max(x, __builtin_amdgcn_update_dpp(x, x, 0x128, 0xf, 0xf, false)); x = max(x, __builtin_amdgcn_update_dpp(x, x, 0x124, 0xf, 0xf, false));
    x = max(x, __builtin_amdgcn_update_dpp(x, x, 0x122, 0xf, 0xf, false)); x = max(x, __builtin_amdgcn_update_dpp(x, x, 0x121, 0xf, 0xf, false));
    return x;
}
__device__ __forceinline__ void phase_attn_mfma(const Frame& F0) { const Frame F = launder(F0);
    const int lane = F.lane, r32 = lane & 31, h = lane >> 5, tt = r32 & 7, hd = r32 >> 3;
    LAS float* imp = (LAS float*)(F.lds + F.wave * 17152); LAS unsigned* selm = (LAS unsigned*)(imp + 2048); LAS int* ulist = (LAS int*)(selm + 64); LAS f32x4* otl = (LAS f32x4*)(ulist + 128) + lane;
    const bf16* Q = WSP(bf16, OFF_Q); const float* NG = WSP(float, OFF_NG); bf16* O = WSP(bf16, OFF_O);
    const int vcu = (F.G % 8 == 0) ? (F.bid % 8) * (F.G / 8) + F.bid / 8 : F.bid;
    const int wv = vcu * 8 + F.wave, NW = F.G * 8;
    for (int wt = wv; wt < 4 * 2048; wt += NW) {
        const int bg = wt >> 11, gi0 = wt & 2047, grp = (bg & 1) ? 2047 - gi0 : gi0, b = bg >> 1, g = bg & 1;
        const int t0 = grp * 8, t = t0 + tt, n = b * T + t, cur = t0 >> 6, tl = (t0 & 63) + tt;
        const float sl2 = ex2(-(float)(g * 4 + hd + 1)) * 1.4426950408889634f;
        bf16x8 qf[4];
        {   const bf16* qp = Q + (size_t)n * 512 + g * 256 + hd * 64 + h * 8;
#pragma unroll
            for (int ks = 0; ks < 4; ++ks) { f32x4 a = ld4bf(qp + ks * 16), c = ld4bf(qp + ks * 16 + 4); a = a * 0.18033688011112042f; c = c * 0.18033688011112042f;
                typedef unsigned u32x4v __attribute__((ext_vector_type(4))); u32x4v w; w.x = cvtpk(a.x, a.y); w.y = cvtpk(a.z, a.w); w.z = cvtpk(c.x, c.y); w.w = cvtpk(c.z, c.w); qf[ks] = __builtin_bit_cast(bf16x8, w); } }
        const float* ngp = NG + (size_t)n * 32 + g * 12 + hd * 3;
        const float gc = ngp[0], gs = ngp[1], gw = ngp[2];
        bf16x8 kf[2][4];
        const int ncv = (t >= 31) ? ((t - 31) >> 4) + 1 : 0;
        const int ncv_hi = (t0 + 7 >= 31) ? ((t0 + 7 - 31) >> 4) + 1 : 0, ncv_lo = (t0 >= 31) ? ((t0 - 31) >> 4) + 1 : 0, nct = (ncv_hi + 63) >> 6;
        const bf16* kc = WSP(bf16, OFF_KC) + (size_t)bg * 1024 * 64; const bf16* vct = WSP(bf16, OFF_VC) + (size_t)bg * 1024 * 64;
        const float slc = sl2 * 16.f;
        float cm = ANEG, cl = 0.f;
        if (nct > 0) attn_loadk(kf, kc, r32, h);
        for (int rp = 0; rp < APD(0); ++rp) { cm = ANEG; cl = 0.f;
        for (int ct = 0; ct < nct; ++ct) {
            f32x16 s0, s1; const float cb = sl2 * (float)(1024 * ct + 31 - t);
            attn_scores<1>(s0, s1, kf, qf, cb, slc, 0, ncv - 1 - ct * 64, h, ct * 64 + 63 >= ncv_lo);
            attn_loadk(kf, kc + (size_t)((ct + 1 < nct) ? ct + 1 : 0) * 4096, r32, h);
            const float tm = max16x2(s0, s1), mn = fmaxf(cm, tm), mu = (mn > -1e29f) ? mn : 0.f;
            float ls = 0.f;
#pragma unroll
            for (int i = 0; i < 16; ++i) ls += ex2(s0[i] - mu) + ex2(s1[i] - mu);
            cl = cl * ex2(cm - mn) + ls; cm = mn;
        } }
        {   const float mp = pmax32(cm), mu = (mp > -1e29f) ? mp : 0.f; cl = psum32(cl * ex2(cm - mu)); cm = mu; }
        const float cinv = (cl > 0.f) ? 1.f / cl : 0.f;
#pragma unroll
        for (int i = 0; i < 8; ++i) *(LAS f32x4*)(imp + (i * 64 + lane) * 4) = (f32x4){0.f, 0.f, 0.f, 0.f};
        WAVE_SYNC();
        {   f32x16 oc0, oc1;
            for (int rp = 0; rp < APD(1); ++rp) {
#pragma unroll
            for (int i = 0; i < 16; ++i) { oc0[i] = 0.f; oc1[i] = 0.f; }
            float carry = 0.f;
            for (int ct = 0; ct < nct; ++ct) {
                f32x16 s0, s1; const float cb = sl2 * (float)(1024 * ct + 31 - t); bf16x8 vf[2][4];
                attn_loadv(vf, vct + (size_t)ct * 4096, r32, h);
                attn_scores<1>(s0, s1, kf, qf, cb, slc, 0, ncv - 1 - ct * 64, h, ct * 64 + 63 >= ncv_lo);
                attn_loadk(kf, kc + (size_t)((ct + 1 < nct) ? ct + 1 : 0) * 4096, r32, h);
#pragma unroll
                for (int i = 0; i < 16; ++i) { s0[i] = ex2(s0[i] - cm) * cinv; s1[i] = ex2(s1[i] - cm) * cinv; }
                attn_pv(oc0, oc1, s0, s1, vf);
                float g4[2][4], xs[2][4];
#pragma unroll
                for (int q = 0; q < 4; ++q) { g4[0][q] = (s0[4 * q] + s0[4 * q + 1]) + (s0[4 * q + 2] + s0[4 * q + 3]); g4[1][q] = (s1[4 * q] + s1[4 * q + 1]) + (s1[4 * q + 2] + s1[4 * q + 3]);
                    xs[0][q] = __shfl_xor(s0[4 * q + 3], 32); xs[1][q] = __shfl_xor(s1[4 * q + 3], 32); }
#pragma unroll
                for (int kh = 0; kh < 2; ++kh)
#pragma unroll
                    for (int q = 0; q < 4; ++q) {
                        const float prev = (q > 0) ? xs[kh][q - 1] : (kh ? xs[0][3] : carry);
                        float v = g4[kh][q] + (h ? xs[kh][q] : prev);
                        v += __shfl_xor(v, 8); v += __shfl_xor(v, 16);
                        if (hd == 0) imp[tt * 256 + ct * 16 + kh * 8 + 2 * q + h] = v;
                    }
                carry = xs[1][3];
            } }
#pragma unroll
            for (int q = 0; q < 4; ++q) { otl[64 * q] = gc * (f32x4){oc0[4 * q], oc0[4 * q + 1], oc0[4 * q + 2], oc0[4 * q + 3]}; otl[64 * (4 + q)] = gc * (f32x4){oc1[4 * q], oc1[4 * q + 1], oc1[4 * q + 2], oc1[4 * q + 3]}; }
        }
        WAVE_SYNC();
        unsigned uword = 0u, iword = 0xffffffffu;
        for (int rp = 0; rp < APD(2); ++rp) { uword = 0u; iword = 0xffffffffu;
        if (cur <= 15) {
            const unsigned mw = (lane == 0) ? ((2u << cur) - 1u) : 0u;
            if (lane < 8) { uword = mw; iword = mw;
#pragma unroll
                for (int k = 0; k < 8; ++k) selm[k * 8 + lane] = mw; }
        } else {
            for (int k = 0; k < 8; ++k) {
                const f32x4 iv = *(const LAS f32x4*)(imp + k * 256 + lane * 4);
                int v[4];
#pragma unroll
                for (int i = 0; i < 4; ++i) { const int j = lane * 4 + i; v[i] = __float_as_int(iv[i]); if (j == 0 || j >= cur - 1) v[i] = (int)0xBF800000; }
                unsigned mw = 0u;
                { const int w0 = 0, wa = cur >> 5, wb = (cur - 1) >> 5; if (lane == w0) mw |= 1u; if (lane == wa) mw |= 1u << (cur & 31); if (lane == wb) mw |= 1u << ((cur - 1) & 31); }
                for (int it = 0; it < 13; ++it) {
                    const int m4 = max(max(v[0], v[1]), max(v[2], v[3]));
                    const int rm = imax_row16(m4);
                    const int wm = max(max(__builtin_amdgcn_readlane(rm, 0), __builtin_amdgcn_readlane(rm, 16)), max(__builtin_amdgcn_readlane(rm, 32), __builtin_amdgcn_readlane(rm, 48)));
                    const unsigned long long bal = __ballot(m4 == wm);
                    const int win = __builtin_amdgcn_readfirstlane((int)__ffsll((long long)bal) - 1);
                    const int slot = (v[0] == wm) ? 0 : (v[1] == wm) ? 1 : (v[2] == wm) ? 2 : 3;
                    const int sslot = __builtin_amdgcn_readlane(slot, win);
                    const int j = win * 4 + sslot;
                    if (lane == win) {
#pragma unroll
                        for (int i = 0; i < 4; ++i) if (sslot == i) v[i] = (int)0xBF800000; }
                    if (lane == (j >> 5)) mw |= 1u << (j & 31);
                }
                if (lane < 8) { selm[k * 8 + lane] = mw; uword |= mw; iword &= mw; }
            }
        } }
        int nu = 0;
        for (int w = 7; w >= 0; --w) { unsigned bits = __builtin_amdgcn_readlane(uword, w);
            while (bits) { const int bb = 31 - __builtin_clz(bits); bits &= ~(1u << bb); if (lane == 0) ulist[nu] = w * 32 + bb; ++nu; } }
        WAVE_SYNC();
        {   AttnSt st;
            for (int rp = 0; rp < APD(3); ++rp) {
#pragma unroll
            for (int i = 0; i < 16; ++i) { st.o0[i] = 0.f; st.o1[i] = 0.f; }
            st.m = ANEG; st.l = 0.f;
            const bf16* ksb = WSP(bf16, OFF_KS) + (size_t)bg * T * 64; const bf16* vsb = WSP(bf16, OFF_VS) + (size_t)bg * T * 64;
            int j = __builtin_amdgcn_readfirstlane(ulist[0]);
            attn_loadk(kf, ksb + (size_t)j * 4096, r32, h);
            for (int u = 0; u < nu; ++u) {
                const int jn = __builtin_amdgcn_readfirstlane(ulist[(u + 1 < nu) ? u + 1 : u]);
                const unsigned rw = selm[tt * 8 + (j >> 5)]; const bool rsel = (rw >> (j & 31)) & 1u;
                const bool full = ((__builtin_amdgcn_readlane(iword, j >> 5) >> (j & 31)) & 1u) && (j < cur);
                const float cb = sl2 * (float)(64 * j - t);
                attn_tile<1>(st, kf, ksb + (size_t)jn * 4096, vsb + (size_t)j * 4096, qf, cb, sl2, 0, rsel ? ((j == cur) ? tl : 63) : -100, r32, h, !full);
                j = jn;
            } }
            const float lr = psum32(st.l), sc = (lr > 0.f) ? gs / lr : 0.f;
#pragma unroll
            for (int q = 0; q < 4; ++q) { otl[64 * q] += sc * (f32x4){st.o0[4 * q], st.o0[4 * q + 1], st.o0[4 * q + 2], st.o0[4 * q + 3]}; otl[64 * (4 + q)] += sc * (f32x4){st.o1[4 * q], st.o1[4 * q + 1], st.o1[4 * q + 2], st.o1[4 * q + 3]}; }
        }
        {   AttnSt st;
            for (int rp = 0; rp < APD(4); ++rp) {
#pragma unroll
            for (int i = 0; i < 16; ++i) { st.o0[i] = 0.f; st.o1[i] = 0.f; }
            st.m = ANEG; st.l = 0.f;
            const bf16* kwb = WSP(bf16, OFF_KW) + (size_t)bg * T * 64; const bf16* vwb = WSP(bf16, OFF_VW) + (size_t)bg * T * 64;
            const int thi = (t0 + 7) >> 6, tlo = (t0 >= 511) ? ((t0 - 511) >> 6) : 0;
            attn_loadk(kf, kwb + (size_t)thi * 4096, r32, h);
            for (int tile = thi; tile >= tlo; --tile) {
                const int tn = (tile > tlo) ? tile - 1 : tile;
                const float cb = sl2 * (float)(64 * tile - t);
                const bool full = (64 * tile + 63 <= t0) && (64 * tile >= t0 + 7 - 511);
                attn_tile<2>(st, kf, kwb + (size_t)tn * 4096, vwb + (size_t)tile * 4096, qf, cb, sl2, t - 511 - 64 * tile, t - 64 * tile, r32, h, !full);
            } }
            const float lr = psum32(st.l), sc = (lr > 0.f) ? gw / lr : 0.f;
            bf16* op = O + (size_t)n * 512 + g * 256 + hd * 64 + 4 * h;
#pragma unroll
            for (int q = 0; q < 4; ++q) {
                st4bf(op + 8 * q, otl[64 * q] + sc * (f32x4){st.o0[4 * q], st.o0[4 * q + 1], st.o0[4 * q + 2], st.o0[4 * q + 3]});
                st4bf(op + 32 + 8 * q, otl[64 * (4 + q)] + sc * (f32x4){st.o1[4 * q], st.o1[4 * q + 1], st.o1[4 * q + 2], st.o1[4 * q + 3]}); }
        }
        WAVE_SYNC();
    }
}

__device__ __forceinline__ void phase_merge(const Frame& F0) { const Frame F = launder(F0);
    const bf16* MG = WSP(bf16, OFF_MG); bf16* MERGED = WSP(bf16, OFF_MERGED);
    for (int it = F.bid; it < (NTOK / 128) * 8; it += F.G) {
        const int mt = it >> 3, nt = it & 7;
        f32x4 outv[4][2]; ACC_ZERO(outv);
#pragma unroll
        for (int src = 0; src < 3; ++src) {
            const bf16* A = src == 0 ? WSP(bf16, OFF_O) : src == 1 ? WSP(bf16, OFF_PM) : WSP(bf16, OFF_CV);
            const bf16* B = src == 0 ? WSP(bf16, OFF_WN) : src == 1 ? WSP(bf16, OFF_WP) : WSP(bf16, OFF_WC);
            const int K = src == 0 ? 512 : 256;
            f32x4 acc[4][2]; ACC_ZERO(acc);
            gemm_tile_128(acc, A + (size_t)mt * 128 * K, K, B + (size_t)nt * 128 * K, K, K, F.lds);
            const int tq = otid(), l = tq & 63, w = tq >> 6;
#pragma unroll
            for (int i = 0; i < 4; ++i)
#pragma unroll
                for (int j = 0; j < 2; ++j) { const int row = mt * 128 + (w >> 2) * 64 + i * 16 + (l & 15), col = nt * 128 + (w & 3) * 32 + j * 16 + (l >> 4) * 4;
                    outv[i][j] += ld4bf(MG + (size_t)row * 3072 + src * 1024 + col) * acc[i][j]; }
        }
        TILE_FOREACH(outv, mt * 128, nt * 128, { st4bf(MERGED + (size_t)ROW * 1024 + COL, V); });
    }
}
__device__ __forceinline__ void phase_wo(const Frame& F0) { const Frame F = launder(F0);
    const bf16* MERGED = WSP(bf16, OFF_MERGED);
    for (int it = F.bid; it < (NTOK / 128) * 8; it += F.G) {
        const int mt = it >> 3, nt = it & 7;
        f32x4 acc[4][2]; ACC_ZERO(acc);
        gemm_tile_128(acc, MERGED + (size_t)mt * 128 * 1024, 1024, WSP(bf16, OFF_WO) + (size_t)nt * 128 * 1024, 1024, 1024, F.lds);
        TILE_FOREACH(acc, mt * 128, nt * 128, { f32x4* p = (f32x4*)(F.out + (size_t)ROW * 1024 + COL); *p = *p + V; });
    }
}

__device__ __forceinline__ void phase_router(const Frame& F0, int l, int rep = 0) { const Frame F = launder(F0);
    LAS int* hist = (LAS int*)F.lds;
    if (F.tid < 32) hist[F.tid] = 0;
    __syncthreads();
    const float* g2 = INP(13) + (size_t)l * D; const float* wg = INP(14) + (size_t)l * D * 4; const float* bgp = INP(15) + (size_t)l * 4;
    const float* we = INP(16) + (size_t)l * D * 32; const float* be = INP(17) + (size_t)l * 32;
    bf16* xn = WSP(bf16, OFF_XN); int* toke = WSP(int, OFF_TOKE); float* tokc = WSP(float, OFF_TOKC);
    for (int n = F.bid * 8 + F.wave; n < NTOK; n += F.G * 8) {
        f32x4 v[4]; float ss = 0.f;
        const f32x4* hr = (const f32x4*)(F.out + (size_t)n * D) + F.lane;
#pragma unroll
        for (int j = 0; j < 4; ++j) { v[j] = hr[64 * j]; ss += (v[j].x * v[j].x + v[j].y * v[j].y) + (v[j].z * v[j].z + v[j].w * v[j].w); }
        const float rs = 1.f / sqrtf(wave_sum(ss) * (1.f / D) + RMS_EPS);
        float gl[4] = {0.f, 0.f, 0.f, 0.f};
#pragma unroll
        for (int j = 0; j < 4; ++j) {
            v[j] = v[j] * rs * ((const f32x4*)g2)[F.lane + 64 * j];
            st4bf(xn + (size_t)n * D + F.lane * 4 + 256 * j, v[j]);
#pragma unroll
            for (int q = 0; q < 4; ++q) {
                const int k = F.lane * 4 + 256 * j + q; const float x = v[j][q];
                const f32x4 w4 = *(const f32x4*)(wg + (size_t)k * 4);
                gl[0] += x * w4.x; gl[1] += x * w4.y; gl[2] += x * w4.z; gl[3] += x * w4.w;
            }
        }
        int gs = 0;
#pragma unroll
        for (int i = 0; i < 4; ++i) gl[i] = wave_sum(gl[i]) + bgp[i];
        float gm = gl[0];
#pragma unroll
        for (int i = 1; i < 4; ++i) if (gl[i] > gm) { gm = gl[i]; gs = i; }
        float gsum = 0.f;
#pragma unroll
        for (int i = 0; i < 4; ++i) gsum += __expf(gl[i] - gm);
        const float gp = 1.f / gsum;
        gs = __builtin_amdgcn_readfirstlane(gs);
        float el[8] = {0.f, 0.f, 0.f, 0.f, 0.f, 0.f, 0.f, 0.f};
#pragma unroll
        for (int j = 0; j < 4; ++j)
#pragma unroll
            for (int q = 0; q < 4; ++q) {
                const int k = F.lane * 4 + 256 * j + q; const float x = v[j][q];
                const f32x4 u0 = *(const f32x4*)(we + (size_t)k * 32 + gs * 8), u1 = *(const f32x4*)(we + (size_t)k * 32 + gs * 8 + 4);
                el[0] += x * u0.x; el[1] += x * u0.y; el[2] += x * u0.z; el[3] += x * u0.w; el[4] += x * u1.x; el[5] += x * u1.y; el[6] += x * u1.z; el[7] += x * u1.w;
            }
        float v0 = -INFINITY, v1 = -INFINITY; int i0 = 0, i1 = 0;
#pragma unroll
        for (int i = 0; i < 8; ++i) {
            const float ev = wave_sum(el[i]) + be[gs * 8 + i];
            if (ev > v0) { v1 = v0; i1 = i0; v0 = ev; i0 = i; } else if (ev > v1) { v1 = ev; i1 = i; }
        }
        const float e1 = __expf(v1 - v0), w0 = 1.f / (1.f + e1), w1 = e1 * w0;
        if (F.lane == 0) {
            const int ea = gs * 8 + i0, eb = gs * 8 + i1;
            toke[n * 2] = ea; toke[n * 2 + 1] = eb; tokc[n * 2] = w0 * gp; tokc[n * 2 + 1] = w1 * gp;
            __hip_atomic_fetch_add(&hist[ea], 1, __ATOMIC_RELAXED, __HIP_MEMORY_SCOPE_WORKGROUP); __hip_atomic_fetch_add(&hist[eb], 1, __ATOMIC_RELAXED, __HIP_MEMORY_SCOPE_WORKGROUP);
        }
    }
    __syncthreads();
    if (rep == 0 && F.tid < 32 && hist[F.tid]) __hip_atomic_fetch_add(F.ctl + CW_CNT + l * 32 + F.tid, (unsigned)hist[F.tid], __ATOMIC_RELAXED, __HIP_MEMORY_SCOPE_AGENT);
}


__device__ __forceinline__ float lane_lo(float x) { auto rr = __builtin_amdgcn_permlane32_swap(__float_as_uint(x), __float_as_uint(x), false, false); return __uint_as_float(rr[0]); }
__device__ __forceinline__ float lane_other(float x, int h) { auto rr = __builtin_amdgcn_permlane32_swap(__float_as_uint(x), __float_as_uint(x), false, false); return __uint_as_float(h ? rr[0] : rr[1]); }
__device__ __forceinline__ void phase_router_mfma(const Frame& F0, int l, int rep = 0) { const Frame F = launder(F0);
    LAS float* part = (LAS float*)F.lds;
    LAS float* rsv = part + 8 * 33 * 64;
    LAS int* hist = (LAS int*)(rsv + 64);
    if (F.tid < 32) hist[F.tid] = 0;
    __syncthreads();
    const int lane = F.lane, r32 = lane & 31, h = lane >> 5, wv = F.wave;
    const bf16* wrh = WSP(bf16, OFF_WR); const bf16* wrl = wrh + 64 * 1024;
    const float* g2 = INP(13) + (size_t)l * D; const float* bgp = INP(15) + (size_t)l * 4; const float* be = INP(17) + (size_t)l * 32;
    bf16* xn = WSP(bf16, OFF_XN); int* toke = WSP(int, OFF_TOKE); float* tokc = WSP(float, OFF_TOKC);
    typedef unsigned u32x4v __attribute__((ext_vector_type(4)));
    for (int tile = F.bid; tile < NTOK / 32; tile += F.G) {
        const int n = tile * 32 + r32;
        const float* xr = (const float*)F.out + (size_t)n * D + wv * 128 + 8 * h;
        f32x16 a1, a2;
#pragma unroll
        for (int i = 0; i < 16; ++i) { a1[i] = 0.f; a2[i] = 0.f; }
        float ss = 0.f;
#pragma unroll 4
        for (int ks = 0; ks < 8; ++ks) {
            const f32x4 x0 = *(const f32x4*)(xr + ks * 16), x1 = *(const f32x4*)(xr + ks * 16 + 4);
            ss += (x0.x * x0.x + x0.y * x0.y) + (x0.z * x0.z + x0.w * x0.w) + (x1.x * x1.x + x1.y * x1.y) + (x1.z * x1.z + x1.w * x1.w);
            u32x4v wh; wh.x = cvtpk(x0.x, x0.y); wh.y = cvtpk(x0.z, x0.w); wh.z = cvtpk(x1.x, x1.y); wh.w = cvtpk(x1.z, x1.w);
            u32x4v wl; wl.x = cvtpk(x0.x - bf2f(wh.x & 0xffffu), x0.y - __uint_as_float(wh.x & 0xffff0000u)); wl.y = cvtpk(x0.z - bf2f(wh.y & 0xffffu), x0.w - __uint_as_float(wh.y & 0xffff0000u));
            wl.z = cvtpk(x1.x - bf2f(wh.z & 0xffffu), x1.y - __uint_as_float(wh.z & 0xffff0000u)); wl.w = cvtpk(x1.z - bf2f(wh.w & 0xffffu), x1.w - __uint_as_float(wh.w & 0xffff0000u));
            const bf16x8 xh = __builtin_bit_cast(bf16x8, wh), xl = __builtin_bit_cast(bf16x8, wl);
            const size_t wo = (size_t)r32 * 1024 + wv * 128 + ks * 16 + 8 * h;
            const bf16x8 ah1 = *(const bf16x8*)(wrh + wo), al1 = *(const bf16x8*)(wrl + wo), ah2 = *(const bf16x8*)(wrh + 32 * 1024 + wo), al2 = *(const bf16x8*)(wrl + 32 * 1024 + wo);
            a1 = __builtin_amdgcn_mfma_f32_32x32x16_bf16(ah1, xh, a1, 0, 0, 0); a2 = __builtin_amdgcn_mfma_f32_32x32x16_bf16(ah2, xh, a2, 0, 0, 0);
            a1 = __builtin_amdgcn_mfma_f32_32x32x16_bf16(ah1, xl, a1, 0, 0, 0); a2 = __builtin_amdgcn_mfma_f32_32x32x16_bf16(ah2, xl, a2, 0, 0, 0);
            a1 = __builtin_amdgcn_mfma_f32_32x32x16_bf16(al1, xh, a1, 0, 0, 0); a2 = __builtin_amdgcn_mfma_f32_32x32x16_bf16(al2, xh, a2, 0, 0, 0);
        }
        {   LAS float* pp = part + (wv * 33) * 64 + lane;
#pragma unroll
            for (int i = 0; i < 16; ++i) pp[i * 64] = a1[i];
#pragma unroll
            for (int i = 0; i < 4; ++i) pp[(16 + i) * 64] = a2[i];
            pp[32 * 64] = ss; }
        __syncthreads();
        if (wv == 0) {
#pragma unroll
            for (int i = 0; i < 16; ++i) { float v = 0.f;
#pragma unroll
                for (int w = 0; w < 8; ++w) v += part[(w * 33 + i) * 64 + lane]; a1[i] = v; }
#pragma unroll
            for (int i = 0; i < 4; ++i) { float v = 0.f;
#pragma unroll
                for (int w = 0; w < 8; ++w) v += part[(w * 33 + 16 + i) * 64 + lane]; a2[i] = v; }
            ss = 0.f;
#pragma unroll
            for (int w = 0; w < 8; ++w) ss += part[(w * 33 + 32) * 64 + lane];
            const float rs = 1.f / sqrtf(psum32(ss) * (1.f / D) + RMS_EPS);
            if (h == 0) rsv[r32] = rs;
            float gl[4]; int gs = 0;
#pragma unroll
            for (int i = 0; i < 4; ++i) gl[i] = a2[i] * rs + bgp[i];
            float gm = gl[0];
#pragma unroll
            for (int i = 1; i < 4; ++i) if (gl[i] > gm) { gm = gl[i]; gs = i; }
            float gsum = 0.f;
#pragma unroll
            for (int i = 0; i < 4; ++i) gsum += __expf(gl[i] - gm);
            const float gp = lane_lo(1.f / gsum); gs = __float_as_int(lane_lo(__int_as_float(gs)));
            float c[4];
#pragma unroll
            for (int i = 0; i < 4; ++i) { const float v = (gs == 0) ? a1[i] : (gs == 1) ? a1[4 + i] : (gs == 2) ? a1[8 + i] : a1[12 + i]; c[i] = v * rs + be[gs * 8 + 4 * h + i]; }
            float v0 = -INFINITY, v1 = -INFINITY; int i0 = 0, i1 = 0;
#pragma unroll
            for (int i = 0; i < 4; ++i) { if (c[i] > v0) { v1 = v0; i1 = i0; v0 = c[i]; i0 = 4 * h + i; } else if (c[i] > v1) { v1 = c[i]; i1 = 4 * h + i; } }
            const float p0 = lane_other(v0, h), p1 = lane_other(v1, h); const int q0 = __float_as_int(lane_other(__int_as_float(i0), h)), q1 = __float_as_int(lane_other(__int_as_float(i1), h));
            const bool mine_first = (v0 > p0) || (v0 == p0 && i0 < q0);
            const float t0 = mine_first ? v0 : p0; const int e0 = mine_first ? i0 : q0;
            const float ca = mine_first ? p0 : v0; const int cia = mine_first ? q0 : i0;
            const float cb2 = mine_first ? v1 : p1; const int cib = mine_first ? i1 : q1;
            const bool a_second = (ca > cb2) || (ca == cb2 && cia < cib);
            const float t1 = a_second ? ca : cb2; const int e1 = a_second ? cia : cib;
            const float ex = __expf(t1 - t0), w0 = 1.f / (1.f + ex), w1 = ex * w0;
            if (h == 0) {
                const int ea = gs * 8 + e0, eb = gs * 8 + e1;
                toke[n * 2] = ea; toke[n * 2 + 1] = eb; tokc[n * 2] = w0 * gp; tokc[n * 2 + 1] = w1 * gp;
                __hip_atomic_fetch_add(&hist[ea], 1, __ATOMIC_RELAXED, __HIP_MEMORY_SCOPE_WORKGROUP); __hip_atomic_fetch_add(&hist[eb], 1, __ATOMIC_RELAXED, __HIP_MEMORY_SCOPE_WORKGROUP);
            }
        }
        __syncthreads();
        {   const float rs = rsv[r32];
#pragma unroll
            for (int ks = 0; ks < 8; ++ks) {
                const f32x4 x0 = *(const f32x4*)(xr + ks * 16), x1 = *(const f32x4*)(xr + ks * 16 + 4);
                const f32x4 g0 = *(const f32x4*)(g2 + wv * 128 + ks * 16 + 8 * h), g1 = *(const f32x4*)(g2 + wv * 128 + ks * 16 + 8 * h + 4);
                *(u32x4*)(xn + (size_t)n * D + wv * 128 + ks * 16 + 8 * h) = pg8::pack8(x0 * rs * g0, x1 * rs * g1);
            } }
    }
    __syncthreads();
    if (rep == 0 && F.tid < 32 && hist[F.tid]) __hip_atomic_fetch_add(F.ctl + CW_CNT + l * 32 + F.tid, (unsigned)hist[F.tid], __ATOMIC_RELAXED, __HIP_MEMORY_SCOPE_AGENT);
}

__device__ __forceinline__ void moe_offsets(const Frame& F, int l, LAS int* off) {
    if (F.tid == 0) { int a = 0; for (int e = 0; e < NEXP; ++e) { off[e] = a; const int c = (int)__hip_atomic_load(F.ctl + CW_CNT + l * 32 + e, __ATOMIC_RELAXED, __HIP_MEMORY_SCOPE_AGENT); a += (c + 255) & ~255; } off[NEXP] = a; }
    __syncthreads();
}
__device__ __forceinline__ void phase_dispatch(const Frame& F0, int l, int rep = 0) { const Frame F = launder(F0);
    LAS int* off = (LAS int*)F.lds; LAS int* hist = off + 64; LAS int* base = hist + 32; LAS int* pslot = base + 32; LAS int* ptok = pslot + 512;
    moe_offsets(F, l, off);
    const int* toke = WSP(int, OFF_TOKE); const float* tokc = WSP(float, OFF_TOKC); int* toks = WSP(int, OFF_TOKS); float* slotc = WSP(float, OFF_SLOTC);
    const bf16* xn = WSP(bf16, OFF_XN); bf16* xg = WSP(bf16, OFF_XG);
    for (int ch = F.bid; ch < NTOK / 256; ch += F.G) {
        if (F.tid < 32) hist[F.tid] = 0;
        __syncthreads();
        const int pr = ch * 512 + F.tid, e = toke[pr];
        const int r = __hip_atomic_fetch_add(&hist[e], 1, __ATOMIC_RELAXED, __HIP_MEMORY_SCOPE_WORKGROUP);
        __syncthreads();
        if (F.tid < 32) base[F.tid] = hist[F.tid] ? (int)__hip_atomic_fetch_add(F.ctl + CW_CUR + (rep * DEPTH + l) * 32 + F.tid, (unsigned)hist[F.tid], __ATOMIC_RELAXED, __HIP_MEMORY_SCOPE_AGENT) : 0;
        __syncthreads();
        const int slot = off[e] + base[e] + r;
        toks[pr] = slot; slotc[slot] = tokc[pr]; pslot[F.tid] = slot; ptok[F.tid] = pr >> 1;
        __syncthreads();
        for (int i = F.wave; i < 512; i += 8) {
            const uint4* s = (const uint4*)(xn + (size_t)ptok[i] * D) + F.lane; uint4* d = (uint4*)(xg + (size_t)pslot[i] * D) + F.lane;
            d[0] = s[0]; d[64] = s[64];
        }
        __syncthreads();
    }
}
__device__ __forceinline__ int moe_expert_of(const LAS int* off, int row) { int e = 0;
#pragma unroll 1
    for (int i = 1; i < NEXP; ++i) if (row >= off[i]) e = i;
    return e; }
__device__ __forceinline__ void phase_moe1(const Frame& F0, int l) { const Frame F = launder(F0);
    LAS int* off = (LAS int*)(F.lds + 32768); moe_offsets(F, l, off);
    const bf16* xg = WSP(bf16, OFF_XG); bf16* hmid = WSP(bf16, OFF_HMID);
    const int ntile = off[NEXP] / 128;
    for (int it = F.bid; it < ntile * 2; it += F.G) {
        const int rt = it >> 1, u = it & 1, e = moe_expert_of(off, rt * 128);
        const bf16* B = WSP(bf16, OFF_W13) + ((size_t)e * 512 + u * 256) * 1024;
        f32x4 a1[4][2], a3[4][2]; ACC_ZERO(a1); ACC_ZERO(a3);
        gemm_tile_128(a1, xg + (size_t)rt * 128 * 1024, 1024, B, 1024, 1024, F.lds);
        gemm_tile_128(a3, xg + (size_t)rt * 128 * 1024, 1024, B + (size_t)128 * 1024, 1024, 1024, F.lds);
#pragma unroll
        for (int i = 0; i < 4; ++i)
#pragma unroll
            for (int j = 0; j < 2; ++j) { const f32x4 x = a1[i][j], y = a3[i][j]; a1[i][j] = (f32x4){siluf(x.x) * y.x, siluf(x.y) * y.y, siluf(x.z) * y.z, siluf(x.w) * y.w}; }
        TILE_FOREACH(a1, rt * 128, u * 128, { st4bf(hmid + (size_t)ROW * 256 + COL, V); });
    }
}
__device__ __forceinline__ void phase_moe2(const Frame& F0, int l) { const Frame F = launder(F0);
    LAS int* off = (LAS int*)(F.lds + 32768); moe_offsets(F, l, off);
    const bf16* hmid = WSP(bf16, OFF_HMID); bf16* ys = WSP(bf16, OFF_YS); const float* slotc = WSP(float, OFF_SLOTC);
    const int ntile = off[NEXP] / 128;
    for (int it = F.bid; it < ntile * 8; it += F.G) {
        const int rt = it >> 3, ct = it & 7, e = moe_expert_of(off, rt * 128);
        f32x4 acc[4][2]; ACC_ZERO(acc);
        gemm_tile_128(acc, hmid + (size_t)rt * 128 * 256, 256, WSP(bf16, OFF_W2) + ((size_t)e * 1024 + ct * 128) * 256, 256, 256, F.lds);
        TILE_FOREACH(acc, rt * 128, ct * 128, { st4bf(ys + (size_t)ROW * 1024 + COL, V * slotc[ROW]); });
    }
}


#define LDSP (F.lds)
__device__ __forceinline__ void phase_inproj_pg8(const Frame& F0) { const Frame F = launder(F0);
    pg8::Gemm g{WSP(bf16, OFF_XN), WSP(bf16, OFF_WIN), D, D, D}; pg8::StaticOrder S; S.init(NTOK, INP, F.G, F.bid);
    pg8::EpiInproj E{(unsigned char*)F.ws};
    pg8::gemm_phase<pg8::EpiInproj, pg8::StaticOrder, true, true>(LDSP, g, S, E);
}
template <int SRC> __device__ __forceinline__ void phase_merge_pg8(const Frame& F0) { const Frame F = launder(F0);
    pg8::StaticOrder S; S.init(NTOK, D, F.G, F.bid);
    constexpr int K = SRC == 0 ? 512 : 256;
    pg8::Gemm g{WSP(bf16, SRC == 0 ? OFF_O : SRC == 1 ? OFF_PM : OFF_CV), WSP(bf16, SRC == 0 ? OFF_WN : SRC == 1 ? OFF_WP : OFF_WC), K, K, K};
    pg8::EpiMerge<SRC == 0> E{WSP(bf16, OFF_MERGED), WSP(bf16, OFF_MG) + SRC * 1024};
    pg8::gemm_phase<pg8::EpiMerge<SRC == 0>, pg8::StaticOrder, true, true>(LDSP, g, S, E);
}
__device__ __forceinline__ void phase_cmp1_pg8(const Frame& F0) { const Frame F = launder(F0);
    pg8::Gemm g{WSP(bf16, OFF_KVC), WSP(bf16, OFF_CW1), 1024, 2048, 2048}; pg8::CmpOrder S{F.G, F.bid};
    pg8::EpiCmp1 E{WSP(bf16, OFF_HC), WSP(float, OFF_CB1)};
    pg8::gemm_phase<pg8::EpiCmp1, pg8::CmpOrder, true, true>(LDSP, g, S, E);
}
__device__ __forceinline__ void phase_wo_pg8(const Frame& F0) { const Frame F = launder(F0);
    pg8::Gemm g{WSP(bf16, OFF_MERGED), WSP(bf16, OFF_WO), D, D, D}; pg8::StaticOrder S; S.init(NTOK, D, F.G, F.bid);
    pg8::EpiWo E{(float*)F.out};
    pg8::gemm_phase<pg8::EpiWo, pg8::StaticOrder, true, true>(LDSP, g, S, E);
}
__device__ __forceinline__ void phase_moe1_pg8(const Frame& F0, int l) { const Frame F = launder(F0);
    LAS int* off = (LAS int*)(F.lds + pg8::STAGE_BYTES); moe_offsets(F, l, off);
    pg8::Gemm g{WSP(bf16, OFF_XG), WSP(bf16, OFF_W13), D, D, D}; pg8::MoeOrder S{(const LAS int*)(F.lds + pg8::STAGE_BYTES), 2, F.G, F.bid, (size_t)512 * 1024 * 2};
    pg8::EpiMoe1 E{WSP(bf16, OFF_HMID)};
    pg8::gemm_phase<pg8::EpiMoe1, pg8::MoeOrder, true, true>(LDSP, g, S, E);
}
__device__ __forceinline__ void phase_moe2_pg8(const Frame& F0, int l) { const Frame F = launder(F0);
    LAS int* off = (LAS int*)(F.lds + pg8::STAGE_BYTES); moe_offsets(F, l, off);
    pg8::Gemm g{WSP(bf16, OFF_HMID), WSP(bf16, OFF_W2), 256, 256, 256}; pg8::MoeOrder S{(const LAS int*)(F.lds + pg8::STAGE_BYTES), 4, F.G, F.bid, (size_t)1024 * 256 * 2};
    pg8::EpiMoe2 E{WSP(bf16, OFF_YS), WSP(float, OFF_SLOTC)};
    pg8::gemm_phase<pg8::EpiMoe2, pg8::MoeOrder, true, true>(LDSP, g, S, E);
}

constexpr int PPL = 11;
constexpr int NPHASE = DEPTH * PPL + 1;
__global__ void __launch_bounds__(512, 2) nsa_fwd(Args args) {
    extern __shared__ __attribute__((aligned(16))) unsigned char lds[];
    Frame F;
    F.lds = (LAS unsigned char*)lds; F.ws = (GAS unsigned char*)args.ws; F.ctl = (unsigned*)(args.ws + WS_CTL); F.out = (GAS float*)args.out;
    F.tid = threadIdx.x; F.lane = F.tid & 63; F.wave = __builtin_amdgcn_readfirstlane(F.tid >> 6); F.G = gridDim.x; F.bid = blockIdx.x;
    volatile LAS unsigned* MISC = (volatile LAS unsigned*)((LAS unsigned char*)lds + MISC_OFF);
    if (F.tid < 32) MISC[F.tid] = 0u;
    if (F.tid < 22) *(LAS unsigned long long*)((LAS unsigned char*)lds + MISC_OFF + 256 + F.tid * 8) = (unsigned long long)args.in[F.tid];
    __syncthreads();
    const int lo = args.ph_lo, hi = args.ph_hi;
    XcdBarrier bar; bar.bar = F.ctl + CW_BAR; bar.x = 0; bar.st = MISC + 8;
    if (hi - lo > 1) bar = xcd_barrier_post(F.ctl + CW_BAR, MISC + 8);
#ifndef ONLY
#define ONLY -1
#endif
#ifndef PMASK
#define PMASK 0xFFF
#endif
#define IN(k) (lo <= (k) && (k) < hi && ((PMASK >> ((k) == DEPTH * PPL ? 11 : (k) % PPL)) & 1))
#ifndef PROBE_DUP
#define PROBE_DUP 0
#endif
#define DUP(k) (((PROBE_DUP >> (k)) & 1) ? 2 : 1)
#define SEAM(k) do { if (IN(k) && IN((k) + 1)) xcd_barrier(bar); else __syncthreads(); } while (0)
#pragma unroll 1
    for (int l = 0; l < DEPTH; ++l) {
        const int p0 = l * PPL;
        if (IN(p0 + 0)) { for (int rep = 0; rep < DUP(0); ++rep) { phase_weights(F, l); if (rep + 1 < DUP(0)) xcd_barrier(bar); } phase_norm<false>(F, l, INP(1) + (size_t)l * D); } SEAM(p0 + 0);
        if (IN(p0 + 1)) { for (int rep = 0; rep < DUP(1); ++rep) { if (USE_PG8 & 1) phase_inproj_pg8(F); else phase_inproj(F); if (rep + 1 < DUP(1)) xcd_barrier(bar); } } SEAM(p0 + 1);
        if (IN(p0 + 2)) { for (int rep = 0; rep < DUP(2); ++rep) { phase_cmp1_pg8(F); __syncthreads(); phase_poolconv(F, l, 32); if (rep + 1 < DUP(2)) xcd_barrier(bar); } } SEAM(p0 + 2);
        if (IN(p0 + 3)) { for (int rep = 0; rep < DUP(3); ++rep) { phase_cmp2(F); if (rep + 1 < DUP(3)) xcd_barrier(bar); } } SEAM(p0 + 3);
        if (IN(p0 + 4)) { for (int rep = 0; rep < DUP(4); ++rep) { if (ATTN_MFMA) phase_attn_mfma(F); else phase_attn_valu(F); if (rep + 1 < DUP(4)) xcd_barrier(bar); } } SEAM(p0 + 4);
        if (IN(p0 + 5)) { for (int rep = 0; rep < DUP(5); ++rep) { if (USE_PG8 & 2) { phase_merge_pg8<0>(F); phase_merge_pg8<1>(F); phase_merge_pg8<2>(F); } else phase_merge(F); if (rep + 1 < DUP(5)) xcd_barrier(bar); } } SEAM(p0 + 5);
        if (IN(p0 + 6)) { for (int rep = 0; rep < DUP(6); ++rep) { if (USE_PG8 & 4) phase_wo_pg8(F); else phase_wo(F); if (rep + 1 < DUP(6)) xcd_barrier(bar); } } SEAM(p0 + 6);
        if (IN(p0 + 7)) { for (int rep = 0; rep < DUP(7); ++rep) { if (ROUTER_MFMA) phase_router_mfma(F, l, rep); else phase_router(F, l, rep); if (rep + 1 < DUP(7)) xcd_barrier(bar); } } SEAM(p0 + 7);
        if (IN(p0 + 8)) { for (int rep = 0; rep < DUP(8); ++rep) { phase_dispatch(F, l, rep); if (rep + 1 < DUP(8)) xcd_barrier(bar); } } SEAM(p0 + 8);
        if (IN(p0 + 9)) { for (int rep = 0; rep < DUP(9); ++rep) { if (USE_PG8 & 8) phase_moe1_pg8(F, l); else phase_moe1(F, l); if (rep + 1 < DUP(9)) xcd_barrier(bar); } } SEAM(p0 + 9);
        if (IN(p0 + 10)) { for (int rep = 0; rep < DUP(10); ++rep) { if (USE_PG8 & 16) phase_moe2_pg8(F, l); else phase_moe2(F, l); if (rep + 1 < DUP(10)) xcd_barrier(bar); } } SEAM(p0 + 10);
    }
    if (IN(DEPTH * PPL)) phase_norm<true>(F, DEPTH, INP(21));
#undef IN
#undef SEAM
}

extern "C" void kernel_launch(void* const* d_in, const int* in_sizes, int n_in, void* d_out, int out_size, void* d_ws, size_t ws_size, hipStream_t stream) {
    static int grid = 0;
    if (grid == 0) {
        if (n_in != 22 || out_size != NTOK * D || ws_size < WS_END) { fprintf(stderr, "kernel_launch: unexpected shapes (n_in %d out %d ws %zu, need %zu)\n", n_in, out_size, ws_size, (size_t)WS_END); grid = -1; return; }
        int dev = 0, cus = 0;
        if (hipGetDevice(&dev) != hipSuccess || hipDeviceGetAttribute(&cus, hipDeviceAttributeMultiprocessorCount, dev) != hipSuccess) { grid = -1; return; }
        if (hipFuncSetAttribute((const void*)nsa_fwd, hipFuncAttributeMaxDynamicSharedMemorySize, LDS_BYTES) != hipSuccess) { fprintf(stderr, "kernel_launch: hipFuncSetAttribute failed\n"); grid = -1; return; }
        int per_cu = 0;
        if (hipOccupancyMaxActiveBlocksPerMultiprocessor(&per_cu, (const void*)nsa_fwd, 512, LDS_BYTES) != hipSuccess || per_cu < 1) fprintf(stderr, "kernel_launch: occupancy query says %d\n", per_cu);
        (void)hipGetLastError();
        grid = cus;
    }
    if (grid < 0) return;
    (void)hipMemsetAsync((char*)d_ws + WS_CTL, 0, CTL_BYTES, stream);
    Args a{};
    for (int i = 0; i < 22; ++i) a.in[i] = (const float*)d_in[i];
    a.out = (float*)d_out; a.ws = (unsigned char*)d_ws;
#if MK_PER_PHASE
    for (int p = 0; p < NPHASE; ++p) { a.ph_lo = p; a.ph_hi = p + 1; hipLaunchKernelGGL(nsa_fwd, dim3(grid), dim3(512), LDS_BYTES, stream, a); }
#else
    a.ph_lo = 0; a.ph_hi = NPHASE;
    hipLaunchKernelGGL(nsa_fwd, dim3(grid), dim3(512), LDS_BYTES, stream, a);
#endif
}
```

```cpp
#include <hip/hip_runtime.h>
#include <cstdio>
#include <cstdint>

#ifndef USE_PG8
#define USE_PG8 31
#endif
#ifndef ATTN_MFMA
#define ATTN_MFMA 1
#endif
#ifndef ROUTER_MFMA
#define ROUTER_MFMA 1
#endif
#ifndef DIAG
#define DIAG 0
#endif
#ifndef GATE_U8
#define GATE_U8 1
#endif
#ifndef MK_PER_PHASE
#define MK_PER_PHASE 0
#endif

#define LAS __attribute__((address_space(3)))
#define GAS __attribute__((address_space(1)))
typedef unsigned short bf16;
typedef short bf16x8 __attribute__((ext_vector_type(8)));
typedef float f32x4 __attribute__((ext_vector_type(4)));
typedef unsigned u32x4 __attribute__((ext_vector_type(4)));

constexpr int D = 1024, NB = 2, T = 16384, NTOK = NB * T, DEPTH = 2;
constexpr int IN_DIM = 5400, INP = 5632;
constexpr int NCMP = 1023, NSLC = 256;
constexpr float RMS_EPS = 1e-6f;
constexpr int NEXP = 32, DEXP = 256;
constexpr int MOE_ROWS = 2 * NTOK + NEXP * 256;
constexpr int TP = T + 64;

constexpr size_t MiB = 1u << 20;
constexpr size_t WS_CTL = 0, CTL_BYTES = MiB;
constexpr size_t RA = MiB;
constexpr size_t SZ_Q = (size_t)NTOK * 512 * 2, SZ_KVC = (size_t)8 * TP * 64 * 2, SZ_KV = (size_t)NB * 2 * T * 64 * 2, SZ_C256 = (size_t)NTOK * 256 * 2;
constexpr size_t OFF_Q = RA, OFF_KVC = OFF_Q + SZ_Q, OFF_KS = OFF_KVC + SZ_KVC, OFF_VS = OFF_KS + SZ_KV, OFF_KW = OFF_VS + SZ_KV, OFF_VW = OFF_KW + SZ_KV;
constexpr size_t OFF_PU = OFF_VW + SZ_KV, OFF_CH = OFF_PU + SZ_C256, OFF_CB = OFF_CH + SZ_C256, OFF_CC = OFF_CB + SZ_C256, OFF_NG = OFF_CC + SZ_C256;
constexpr size_t OFF_MG = OFF_NG + (size_t)NTOK * 32 * 4, RA_END = OFF_MG + (size_t)NTOK * 3072 * 2;
constexpr size_t OFF_MERGED = RA;
static_assert(OFF_MERGED + (size_t)NTOK * 1024 * 2 <= OFF_KW, "merged alias");
constexpr size_t OFF_XG = RA, OFF_HMID = OFF_XG + (size_t)MOE_ROWS * 1024 * 2, OFF_YS = OFF_HMID + (size_t)MOE_ROWS * 256 * 2, MOE_END = OFF_YS + (size_t)MOE_ROWS * 1024 * 2;
static_assert(MOE_END <= RA_END, "moe alias");
constexpr size_t RB = RA_END, OFF_XN = RB, OFF_O = RB, OFF_PM = OFF_O + SZ_Q, OFF_CV = OFF_PM + SZ_C256, RB_END = RB + (size_t)NTOK * 1024 * 2;
static_assert(OFF_CV + SZ_C256 <= RB_END, "rb alias");
constexpr size_t RW = RB_END;
constexpr size_t OFF_WIN = RW, OFF_CW1 = OFF_WIN + (size_t)INP * 1024 * 2, OFF_CW2 = OFF_CW1 + (size_t)2 * 256 * 2048 * 2, OFF_CB1 = OFF_CW2 + (size_t)2 * 128 * 256 * 2;
constexpr size_t OFF_WN = OFF_CB1 + 4096, OFF_WP = OFF_WN + (size_t)1024 * 512 * 2, OFF_WC = OFF_WP + (size_t)1024 * 256 * 2, OFF_WO = OFF_WC + (size_t)1024 * 256 * 2;
constexpr size_t OFF_W13 = OFF_WO + (size_t)1024 * 1024 * 2, OFF_W2 = OFF_W13 + (size_t)NEXP * 512 * 1024 * 2, OFF_WR = OFF_W2 + (size_t)NEXP * 1024 * 256 * 2, RW_END = OFF_WR + (size_t)2 * 64 * 1024 * 2;
constexpr size_t RS = RW_END;
constexpr size_t OFF_KC = RS, OFF_VC = OFF_KC + (size_t)4 * 1024 * 64 * 2, OFF_HC = OFF_VC + (size_t)4 * 1024 * 64 * 2;
constexpr size_t OFF_TOKE = OFF_HC + (size_t)8192 * 256 * 2, OFF_TOKC = OFF_TOKE + (size_t)NTOK * 8, OFF_TOKS = OFF_TOKC + (size_t)NTOK * 8, OFF_SLOTC = OFF_TOKS + (size_t)NTOK * 8;
constexpr size_t WS_END = OFF_SLOTC + (size_t)MOE_ROWS * 4;
static_assert(WS_END <= (size_t)512 * MiB, "workspace");
constexpr int CW_BAR = 4096;
constexpr int CW_CNT = 16384;
constexpr int CW_CUR = CW_CNT + DEPTH * 32;

constexpr int LDS_BYTES = 147456;
constexpr int MISC_OFF = 143360;

__device__ __forceinline__ float bf2f(unsigned u) { return __builtin_bit_cast(float, u << 16); }
__device__ __forceinline__ unsigned f2bf(float f) { unsigned u = __builtin_bit_cast(unsigned, f); return (u + 0x7fffu + ((u >> 16) & 1u)) >> 16; }
__device__ __forceinline__ unsigned pk2(float lo, float hi) { return f2bf(lo) | (f2bf(hi) << 16); }
__device__ __forceinline__ void st4bf(bf16* p, f32x4 v) { *(uint2*)p = make_uint2(pk2(v.x, v.y), pk2(v.z, v.w)); }
__device__ __forceinline__ f32x4 ld4bf(const bf16* p) { const uint2 u = *(const uint2*)p; return (f32x4){bf2f(u.x & 0xffffu), bf2f(u.x >> 16), bf2f(u.y & 0xffffu), bf2f(u.y >> 16)}; }
__device__ __forceinline__ float sigmoidf(float x) { return __builtin_amdgcn_rcpf(1.f + __builtin_amdgcn_exp2f(-1.4426950408889634f * x)); }
__device__ __forceinline__ float gelu_tanh(float x) { const float u = 0.7978845608028654f * (x + 0.044715f * x * x * x);
    return x * __builtin_amdgcn_rcpf(1.f + __builtin_amdgcn_exp2f(-2.885390081777927f * u)); }
__device__ __forceinline__ float siluf(float x) { return x * __builtin_amdgcn_rcpf(1.f + __builtin_amdgcn_exp2f(-1.4426950408889634f * x)); }
__device__ __forceinline__ float wave_sum(float v) {
#pragma unroll
    for (int o = 1; o < 64; o <<= 1) v += __shfl_xor(v, o);
    return v;
}
__device__ __forceinline__ float wave_max(float v) {
#pragma unroll
    for (int o = 1; o < 64; o <<= 1) v = fmaxf(v, __shfl_xor(v, o));
    return v;
}
__device__ __forceinline__ int swap23(int k) { return (k & 3) | ((k & 4) << 1) | ((k & 8) >> 1); }
__device__ __forceinline__ int ktile_off(int kk, int d0) { return ((((kk >> 5) * 4 + (d0 >> 4)) * 64 + ((d0 >> 3) & 1) * 32 + (kk & 31)) * 8); }
__device__ __forceinline__ int vtile_off(int kk, int d) { const int p = swap23(kk & 15); return ((((d >> 5) * 4 + (kk >> 4)) * 64 + (p >> 3) * 32 + (d & 31)) * 8 + (p & 7)); }
#define WAVE_SYNC() asm volatile("s_waitcnt lgkmcnt(0)" ::: "memory")
__device__ __forceinline__ int otid() { int t = threadIdx.x; asm volatile("" : "+v"(t)); return t; }

#define XB_TMO      128
#define XB_XCNT(j)  (256  + 64 * (j))
#define XB_XSUB(j)  (1280 + 64 * (j))
#define XB_XGEN(j)  (2304 + 64 * (j))
#define XB_TOP      3328
#define XB_TOPGEN   3392
#define XCD_BAR_WORDS 3456
#define XB_SPIN_CAP (1u << 18)
__device__ __forceinline__ unsigned xb_ld(unsigned* p)              { return __hip_atomic_load(p, __ATOMIC_RELAXED, __HIP_MEMORY_SCOPE_AGENT); }
__device__ __forceinline__ unsigned xb_add(unsigned* p, unsigned v) { return __hip_atomic_fetch_add(p, v, __ATOMIC_RELAXED, __HIP_MEMORY_SCOPE_AGENT); }
__device__ __forceinline__ unsigned xb_xcc_id() { return (unsigned)__builtin_amdgcn_s_getreg((3 << 11) | 20) & 0xFu; }
#define XB_SPIN(cond, bar) do { unsigned _sp = 0; while (cond) { __builtin_amdgcn_s_sleep(1); \
    if ((++_sp & 255u) == 0u) { if (xb_ld(&(bar)[XB_TMO])) break; if (_sp > XB_SPIN_CAP) { atomicAdd(&(bar)[XB_TMO], 1u); break; } } } } while (0)
struct XcdBarrier { unsigned* bar; unsigned x; volatile LAS unsigned* st; };
__device__ __forceinline__ XcdBarrier xcd_barrier_post(unsigned* bar, volatile LAS unsigned* st) {
    XcdBarrier b; b.bar = bar; b.x = xb_xcc_id(); b.st = st;
    if (threadIdx.x == 0) (void)xb_add(&bar[XB_XCNT(b.x)], 1u);
    return b;
}
__device__ __forceinline__ void xcd_barrier_complete(unsigned* bar, unsigned x, unsigned& nloc, unsigned& nx) {
    const unsigned G = gridDim.x * gridDim.y * gridDim.z;
    unsigned sum, cnt, mine, sp = 0u;
    for (;;) {
        sum = 0u; cnt = 0u; mine = 0u;
#pragma unroll
        for (unsigned j = 0; j < 16; ++j) { const unsigned c = xb_ld(&bar[XB_XCNT(j)]); sum += c; cnt += (c > 0u) ? 1u : 0u; mine = (j == x) ? c : mine; }
        if (sum == G) break;
        __builtin_amdgcn_s_sleep(1);
        if ((++sp & 255u) == 0u) { if (xb_ld(&bar[XB_TMO])) break; if (sp > XB_SPIN_CAP) { atomicAdd(&bar[XB_TMO], 1u); break; } }
    }
    nloc = mine > 0u ? mine : 1u; nx = cnt > 0u ? cnt : 1u;
}
__device__ __forceinline__ void xcd_barrier(const XcdBarrier& b) {
    asm volatile("s_waitcnt vmcnt(0)" ::: "memory");
    __syncthreads();
    if (threadIdx.x == 0) {
        unsigned* bar = b.bar; unsigned bx = b.x;
        asm volatile("" : "+s"(bar), "+s"(bx));
        __builtin_amdgcn_s_waitcnt(0);
        unsigned nloc = b.st[0], nx = b.st[1];
        if (nloc == 0u) { xcd_barrier_complete(bar, bx, nloc, nx); b.st[0] = nloc; b.st[1] = nx; }
        const unsigned old = xb_add(&bar[XB_XSUB(bx)], 1u);
        const unsigned gen = old / nloc;
        if (old + 1u == (gen + 1u) * nloc) {
            __builtin_amdgcn_fence(__ATOMIC_RELEASE, "agent");
            asm volatile("s_waitcnt vmcnt(0)" ::: "memory");
            const unsigned og = xb_add(&bar[XB_TOP], 1u);
            const unsigned tg = og / nx;
            if (og + 1u == (tg + 1u) * nx) xb_add(&bar[XB_TOPGEN], 1u);
            else XB_SPIN(xb_ld(&bar[XB_TOPGEN]) == tg, bar);
            __builtin_amdgcn_fence(__ATOMIC_ACQUIRE, "agent");
            xb_add(&bar[XB_XGEN(bx)], 1u);
            asm volatile("s_waitcnt vmcnt(0)" ::: "memory");
        } else {
            XB_SPIN(xb_ld(&bar[XB_XGEN(bx)]) == gen, bar);
            __builtin_amdgcn_fence(__ATOMIC_ACQUIRE, "agent");
            asm volatile("s_waitcnt vmcnt(0)" ::: "memory");
        }
    }
    __syncthreads();
}

struct Args { const float* in[22]; float* out; unsigned char* ws; int ph_lo, ph_hi; };
struct Frame {
    LAS unsigned char* lds; GAS unsigned char* ws; unsigned* ctl; GAS float* out;
    int tid, lane, wave, G, bid;
};
#define WSP(T_, off) ((T_*)(GAS T_*)(F.ws + (off)))
__device__ __forceinline__ const float* inptr(LAS unsigned char* lds, int k) {
    typedef unsigned u32x2 __attribute__((ext_vector_type(2)));
    const u32x2 v = *(const LAS u32x2*)(lds + MISC_OFF + 256 + k * 8);
    const unsigned long long p = ((unsigned long long)(unsigned)__builtin_amdgcn_readfirstlane((int)v.y) << 32) | (unsigned)__builtin_amdgcn_readfirstlane((int)v.x);
    return (const float*)p;
}
#define INP(k) inptr(F.lds, (k))
__device__ __forceinline__ Frame launder(const Frame& F0) {
    Frame F = F0;
    F.tid = otid(); F.lane = F.tid & 63;
    asm volatile("" : "+s"(F.ws), "+s"(F.out), "+s"(F.bid), "+s"(F.G), "+s"(F.wave));
    return F;
}

__device__ __forceinline__ void gemm_tile_128(f32x4 (&acc)[4][2], const bf16* __restrict__ A, int lda, const bf16* __restrict__ B, int ldb, int K, LAS unsigned char* lds) {
    LAS bf16* As = (LAS bf16*)lds; LAS bf16* Bs = As + 128 * 40;
    const int tid = otid(), lane = tid & 63, wave = tid >> 6, wm = wave >> 2, wn = wave & 3;
    const int lr = tid >> 2, lk = (tid & 3) * 8, fr = lane & 15, fq = lane >> 4;
    const bf16* ap = A + (size_t)lr * lda + lk; const bf16* bp = B + (size_t)lr * ldb + lk;
    u32x4 av = *(const u32x4*)ap, bv = *(const u32x4*)bp;
    for (int k0 = 0; k0 < K; k0 += 32) {
        __syncthreads();
        *(LAS u32x4*)(As + lr * 40 + lk) = av; *(LAS u32x4*)(Bs + lr * 40 + lk) = bv;
        __syncthreads();
        if (k0 + 32 < K) { av = *(const u32x4*)(ap + k0 + 32); bv = *(const u32x4*)(bp + k0 + 32); }
        bf16x8 af[4], bfr[2];
#pragma unroll
        for (int i = 0; i < 4; ++i) af[i] = *(const LAS bf16x8*)(As + (wm * 64 + i * 16 + fr) * 40 + fq * 8);
#pragma unroll
        for (int j = 0; j < 2; ++j) bfr[j] = *(const LAS bf16x8*)(Bs + (wn * 32 + j * 16 + fr) * 40 + fq * 8);
#pragma unroll
        for (int i = 0; i < 4; ++i)
#pragma unroll
            for (int j = 0; j < 2; ++j) acc[i][j] = __builtin_amdgcn_mfma_f32_16x16x32_bf16(bfr[j], af[i], acc[i][j], 0, 0, 0);
    }
}
#define ACC_ZERO(a) do { _Pragma("unroll") for (int _i = 0; _i < 4; ++_i) _Pragma("unroll") for (int _j = 0; _j < 2; ++_j) a[_i][_j] = (f32x4){0.f, 0.f, 0.f, 0.f}; } while (0)
#define TILE_FOREACH(acc, m0, n0, BODY) do { const int _t = otid(), _l = _t & 63, _w = _t >> 6; \
    _Pragma("unroll") for (int _i = 0; _i < 4; ++_i) _Pragma("unroll") for (int _j = 0; _j < 2; ++_j) { \
        const int ROW = (m0) + (_w >> 2) * 64 + _i * 16 + (_l & 15); const int COL = (n0) + (_w & 3) * 32 + _j * 16 + (_l >> 4) * 4; f32x4& V = acc[_i][_j]; BODY } } while (0)


namespace pg8 {
#define PG8_LAS __attribute__((address_space(3)))
typedef unsigned short bf16_t;
constexpr int BM = 256, BK = 64, HALF = 128, HTB = HALF * BK * 2  , STAGE_BYTES = 8 * HTB, NXCD = 8, WGM = 8;
__host__ __device__ __forceinline__ int lds_byte(int r, int c) { const int st = (r >> 4) * 2 + (c >> 5), rr = r & 15, cc = c & 31, ob = rr * 64 + cc * 2; return st * 1024 + (ob ^ (((ob >> 9) & 1) << 5)); }
__host__ __device__ __forceinline__ void stage_rc(int b, int& R, int& C) { const int st = b / 1024, sb = b % 1024, swz = sb ^ (((sb >> 9) & 1) << 5); R = (st >> 1) * 16 + swz / 64; C = (st & 1) * 32 + (swz % 64) / 2; }
__host__ __device__ __forceinline__ int perm32(int rho) { const int n = rho >> 4, i = rho & 15; return 8 * (i >> 2) + 4 * n + (i & 3); }
struct Unit { int pm, pn, e; };
struct Gemm { const bf16_t* A; const bf16_t* Bt; int lda, ldb, K; };
struct StaticOrder {
    int nM, nN, nwg, G, c;
    __device__ void init(int M, int N, int G_, int c_) { nM = M / BM; nN = N / BM; nwg = nM * nN; G = G_; c = c_; }
    __device__ bool next(int i, Unit& u) const {
        const long L = (long)i * G + c; if (L >= nwg) return false;
        int wgid = (int)L; { const int q = nwg / NXCD, r = nwg % NXCD, xcd = wgid % NXCD, off = wgid / NXCD; wgid = (xcd < r ? xcd * (q + 1) : r * (q + 1) + (xcd - r) * q) + off; }
        const int nig = WGM * nN, gid = wgid / nig, fm = gid * WGM, gsz = (nM - fm) < WGM ? (nM - fm) : WGM;
        u.pm = fm + ((wgid % nig) % gsz); u.pn = (wgid % nig) / gsz; u.e = 0; return true;
    }
    __device__ __forceinline__ const char* a_ptr(const Gemm& g, const Unit& u) const { return (const char*)g.A + (size_t)u.pm * BM * g.lda * 2; }
    __device__ __forceinline__ const char* b_ptr(const Gemm& g, const Unit& u) const { return (const char*)g.Bt + (size_t)u.pn * BM * g.ldb * 2; }
    __device__ __forceinline__ void a_ready(const Unit&) const {}
    __device__ __forceinline__ void done(const Unit&) const {}
};
struct MoeOrder {
    const PG8_LAS int* off; int ncol, G, c; size_t bexp;
    __device__ bool next(int i, Unit& u) const {
        const int L = i * G + c; if (L >= (off[32] >> 8) * ncol) return false;
        u.pm = L / ncol; u.pn = L % ncol; int e = 0;
#pragma unroll 1
        for (int j = 1; j < 32; ++j) if (u.pm * BM >= off[j]) e = j;
        u.e = e; return true;
    }
    __device__ __forceinline__ const char* a_ptr(const Gemm& g, const Unit& u) const { return (const char*)g.A + (size_t)u.pm * BM * g.lda * 2; }
    __device__ __forceinline__ const char* b_ptr(const Gemm& g, const Unit& u) const { return (const char*)g.Bt + (size_t)u.e * bexp + (size_t)u.pn * BM * g.ldb * 2; }
    __device__ __forceinline__ void a_ready(const Unit&) const {}
    __device__ __forceinline__ void done(const Unit&) const {}
};
__device__ __forceinline__ u32x4 pack8(f32x4 a, f32x4 b) { u32x4 w; w.x = pk2(a.x, a.y); w.y = pk2(a.z, a.w); w.z = pk2(b.x, b.y); w.w = pk2(b.z, b.w); return w; }
__device__ __forceinline__ f32x4 sig4(f32x4 v) { return (f32x4){sigmoidf(v.x), sigmoidf(v.y), sigmoidf(v.z), sigmoidf(v.w)}; }
__device__ __forceinline__ void unpack8(u32x4 w, f32x4& a, f32x4& b) { a = (f32x4){bf2f(w.x & 0xffffu), bf2f(w.x >> 16), bf2f(w.y & 0xffffu), bf2f(w.y >> 16)}; b = (f32x4){bf2f(w.z & 0xffffu), bf2f(w.z >> 16), bf2f(w.w & 0xffffu), bf2f(w.w >> 16)}; }

struct CmpOrder {
    int G, c;
    __device__ bool next(int i, Unit& u) const { const int L = i * G + c; if (L >= 32) return false; u.pm = L; u.pn = 0; u.e = L >> 2; return true; }
    __device__ __forceinline__ const char* a_ptr(const Gemm& g, const Unit& u) const { return (const char*)g.A + ((size_t)u.e * TP * 64 + (size_t)(u.pm & 3) * 256 * 1024) * 2; }
    __device__ __forceinline__ const char* b_ptr(const Gemm& g, const Unit& u) const { return (const char*)g.Bt + (size_t)(u.e & 1) * 256 * 2048 * 2; }
    __device__ __forceinline__ void a_ready(const Unit&) const {}
    __device__ __forceinline__ void done(const Unit&) const {}
};
struct EpiCmp1 {
    static constexpr bool PERM = true, AFTER_DRAIN = false; bf16* hc; const float* cb1;
    __device__ __forceinline__ void operator()(const f32x4 (&acc)[2][2][4][2], const Unit& u, int wr, int wc, int fr, int fq) const {
        const int row0 = u.pm * BM + wr * 64 + fr; const float* bb = cb1 + (u.e & 1) * 256;
#pragma unroll
        for (int ai = 0; ai < 2; ++ai)
#pragma unroll
            for (int m = 0; m < 4; ++m) { const int row = row0 + ai * HALF + m * 16;
#pragma unroll
                for (int bj = 0; bj < 2; ++bj) { const int col = bj * HALF + wc * 32 + fq * 8; f32x4 v0 = acc[ai][bj][m][0] + *(const f32x4*)(bb + col), v1 = acc[ai][bj][m][1] + *(const f32x4*)(bb + col + 4);
                    v0 = (f32x4){gelu_tanh(v0.x), gelu_tanh(v0.y), gelu_tanh(v0.z), gelu_tanh(v0.w)}; v1 = (f32x4){gelu_tanh(v1.x), gelu_tanh(v1.y), gelu_tanh(v1.z), gelu_tanh(v1.w)};
                    *(u32x4*)(hc + (size_t)row * 256 + col) = pack8(v0, v1); } }
    }
};
struct EpiInproj {
    static constexpr bool PERM = true, AFTER_DRAIN = false; unsigned char* ws;
    __device__ __forceinline__ void operator()(const f32x4 (&acc)[2][2][4][2], const Unit& u, int wr, int wc, int fr, int fq) const {
        const int row0 = u.pm * BM + wr * 64 + fr, pn = u.pn;
#pragma unroll
        for (int ai = 0; ai < 2; ++ai)
#pragma unroll
            for (int m = 0; m < 4; ++m) { const int row = row0 + ai * HALF + m * 16;
#pragma unroll
                for (int bj = 0; bj < 2; ++bj) { const int cc = bj * HALF + wc * 32 + fq * 8; const f32x4 v0 = acc[ai][bj][m][0], v1 = acc[ai][bj][m][1];
                    if (pn < 2) *(u32x4*)((bf16*)(ws + OFF_Q) + (size_t)row * 512 + pn * 256 + cc) = pack8(v0, v1);
                    else if (pn < 5) { const int s = (pn - 2) * 2 + bj, g = wc >> 1, d = (wc & 1) * 32 + fq * 8, b = row >> 14, t = row & (T - 1);
                        if (s < 2) *(u32x4*)((bf16*)(ws + OFF_KVC) + ((size_t)((b * 2 + g) * 2 + s) * TP + t) * 64 + d) = pack8(v0, v1);
                        else { bf16* tb = (bf16*)(ws + OFF_KS + (size_t)(s - 2) * SZ_KV) + (size_t)(b * 2 + g) * T * 64;
                            if (!ATTN_MFMA) *(u32x4*)(tb + (size_t)t * 64 + d) = pack8(v0, v1);
                            else if (s == 2 || s == 4) *(u32x4*)(tb + (size_t)(t >> 6) * 4096 + ktile_off(t & 63, d)) = pack8(v0, v1);
                            else { bf16* vb = tb + (size_t)(t >> 6) * 4096 + vtile_off(t & 63, d); const u32x4 w = pack8(v0, v1);
                                vb[0] = (bf16)(w.x & 0xffffu); vb[8] = (bf16)(w.x >> 16); vb[16] = (bf16)(w.y & 0xffffu); vb[24] = (bf16)(w.y >> 16);
                                vb[32] = (bf16)(w.z & 0xffffu); vb[40] = (bf16)(w.z >> 16); vb[48] = (bf16)(w.w & 0xffffu); vb[56] = (bf16)(w.w >> 16); } } }
                    else if (pn < 9) *(u32x4*)((bf16*)(ws + OFF_PU + (size_t)(pn - 5) * SZ_C256) + (size_t)row * 256 + cc) = pack8(v0, v1);
                    else if (pn == 9) { if (cc < 32) { float* p = (float*)(ws + OFF_NG) + (size_t)row * 32 + cc; *(f32x4*)p = sig4(v0); *(f32x4*)(p + 4) = sig4(v1); } }
                    else if (!GATE_U8) *(u32x4*)((bf16*)(ws + OFF_MG) + (size_t)row * 3072 + (pn - 10) * 256 + cc) = pack8(sig4(v0), sig4(v1));
                    else { const f32x4 g0 = sig4(v0) * 255.f + 0.5f, g1 = sig4(v1) * 255.f + 0.5f;
                        const unsigned lo = (unsigned)g0.x | ((unsigned)g0.y << 8) | ((unsigned)g0.z << 16) | ((unsigned)g0.w << 24), hi = (unsigned)g1.x | ((unsigned)g1.y << 8) | ((unsigned)g1.z << 16) | ((unsigned)g1.w << 24);
                        *(uint2*)((unsigned char*)(ws + OFF_MG) + (size_t)row * 3072 + (pn - 10) * 256 + cc) = make_uint2(lo, hi); }
                } }
    }
};
template <bool FIRST> struct EpiMerge {
    static constexpr bool PERM = true, AFTER_DRAIN = false; bf16* merged; const unsigned char* gate;
    __device__ __forceinline__ void operator()(const f32x4 (&acc)[2][2][4][2], const Unit& u, int wr, int wc, int fr, int fq) const {
        const int row0 = u.pm * BM + wr * 64 + fr;
#pragma unroll
        for (int ai = 0; ai < 2; ++ai)
#pragma unroll
            for (int m = 0; m < 4; ++m) { const int row = row0 + ai * HALF + m * 16;
#pragma unroll
                for (int bj = 0; bj < 2; ++bj) { const int col = u.pn * BM + bj * HALF + wc * 32 + fq * 8;
                    f32x4 g0, g1;
                    if (GATE_U8) { const uint2 gb = *(const uint2*)(gate + (size_t)row * 3072 + col);
                        g0 = (f32x4){(float)(gb.x & 255u), (float)((gb.x >> 8) & 255u), (float)((gb.x >> 16) & 255u), (float)(gb.x >> 24)} * (1.f / 255.f);
                        g1 = (f32x4){(float)(gb.y & 255u), (float)((gb.y >> 8) & 255u), (float)((gb.y >> 16) & 255u), (float)(gb.y >> 24)} * (1.f / 255.f); }
                    else unpack8(*(const u32x4*)((const bf16*)gate + (size_t)row * 3072 + col), g0, g1);
                    f32x4 o0 = g0 * acc[ai][bj][m][0], o1 = g1 * acc[ai][bj][m][1];
                    bf16* p = merged + (size_t)row * 1024 + col;
                    if (!FIRST) { f32x4 p0, p1; unpack8(*(const u32x4*)p, p0, p1); o0 += p0; o1 += p1; }
                    *(u32x4*)p = pack8(o0, o1); }
                if (!FIRST && (m & 1)) asm volatile("" ::: "memory"); }
    }
};
struct EpiWo {
    static constexpr bool PERM = false, AFTER_DRAIN = false; float* out;
    __device__ __forceinline__ void operator()(const f32x4 (&acc)[2][2][4][2], const Unit& u, int wr, int wc, int fr, int fq) const {
        const int row0 = u.pm * BM + wr * 64 + fr;
#pragma unroll
        for (int ai = 0; ai < 2; ++ai)
#pragma unroll
            for (int m = 0; m < 4; ++m) { float* rowp = out + (size_t)(row0 + ai * HALF + m * 16) * 1024 + u.pn * BM + wc * 32 + fq * 4;
#pragma unroll
                for (int bj = 0; bj < 2; ++bj)
#pragma unroll
                    for (int n = 0; n < 2; ++n) { f32x4* p = (f32x4*)(rowp + bj * HALF + n * 16); *p = *p + acc[ai][bj][m][n]; } }
    }
};
struct EpiMoe1 {
    static constexpr bool PERM = true, AFTER_DRAIN = false; bf16* hmid;
    __device__ __forceinline__ void operator()(const f32x4 (&acc)[2][2][4][2], const Unit& u, int wr, int wc, int fr, int fq) const {
        const int row0 = u.pm * BM + wr * 64 + fr;
#pragma unroll
        for (int ai = 0; ai < 2; ++ai)
#pragma unroll
            for (int m = 0; m < 4; ++m) { const int row = row0 + ai * HALF + m * 16;
                f32x4 o[2];
#pragma unroll
                for (int n = 0; n < 2; ++n) { const f32x4 x = acc[ai][0][m][n], y = acc[ai][1][m][n]; o[n] = (f32x4){siluf(x.x) * y.x, siluf(x.y) * y.y, siluf(x.z) * y.z, siluf(x.w) * y.w}; }
                *(u32x4*)(hmid + (size_t)row * 256 + u.pn * HALF + wc * 32 + fq * 8) = pack8(o[0], o[1]); }
    }
};
struct EpiMoe2 {
    static constexpr bool PERM = true, AFTER_DRAIN = false; bf16* ys; const float* slotc;
    __device__ __forceinline__ void operator()(const f32x4 (&acc)[2][2][4][2], const Unit& u, int wr, int wc, int fr, int fq) const {
        const int row0 = u.pm * BM + wr * 64 + fr;
#pragma unroll
        for (int ai = 0; ai < 2; ++ai)
#pragma unroll
            for (int m = 0; m < 4; ++m) { const int row = row0 + ai * HALF + m * 16; const float c = slotc[row];
#pragma unroll
                for (int bj = 0; bj < 2; ++bj) *(u32x4*)(ys + (size_t)row * 1024 + u.pn * BM + bj * HALF + wc * 32 + fq * 8) = pack8(acc[ai][bj][m][0] * c, acc[ai][bj][m][1] * c); }
    }
};
template <class Epi, class Sched, bool ALIGN_EPI = false, bool SP2 = false>
__device__ __forceinline__ void gemm_phase(PG8_LAS unsigned char* lds, const Gemm g, const Sched& S, const Epi& E) {
    const int tid = otid(), wid = __builtin_amdgcn_readfirstlane(tid >> 6), lane = tid & 63, wr = wid >> 2, wc = wid & 3, fr = lane & 15, fq = lane >> 4;
    int Kq = g.K; asm volatile("" : "+s"(Kq));
    const int K = Kq, nt = K / BK;
    unsigned voffA[2], voffB[2];
#pragma unroll
    for (int i = 0; i < 2; ++i) { int R, C; stage_rc(tid * 16 + i * 8192, R, C); const int Rb = Epi::PERM ? ((R & ~31) + perm32(R & 31)) : R;
        voffA[i] = (unsigned)(R * g.lda + C) * 2u; voffB[i] = (unsigned)(Rb * g.ldb + C) * 2u; }
    const size_t kstep = (size_t)(BK * 2);
    const size_t hstepA = (size_t)HALF * g.lda * 2, hstepB = (size_t)HALF * g.ldb * 2;
    const unsigned ldsw = (unsigned)wid * 1024u;
    const int aoff = lds_byte(wr * 64 + fr, fq * 8), boff = lds_byte(wc * 32 + fr, fq * 8);
#define PG8_SA(b, h) (((b) * 2 + (h)) * HTB)
#define PG8_SB(b, h) ((4 + (b) * 2 + (h)) * HTB)
#define PG8_STAGE(bufoff, gbase, voff) do { _Pragma("unroll") for (int _i = 0; _i < 2; ++_i) \
        __builtin_amdgcn_global_load_lds((const unsigned*)((const char*)(gbase) + (voff)[_i]), (PG8_LAS unsigned*)(lds + (bufoff) + ldsw + _i * 8192), 16, 0, 0); } while (0)
#define PG8_LDA(dst, b, h) do { _Pragma("unroll") for (int m = 0; m < 4; ++m) _Pragma("unroll") for (int k = 0; k < 2; ++k) dst[m][k] = *(const PG8_LAS bf16x8*)(lds + PG8_SA(b, h) + aoff + m * 2048 + k * 1024); } while (0)
#define PG8_LDB(dst, b, h) do { _Pragma("unroll") for (int n = 0; n < 2; ++n) _Pragma("unroll") for (int k = 0; k < 2; ++k) dst[n][k] = *(const PG8_LAS bf16x8*)(lds + PG8_SB(b, h) + boff + n * 2048 + k * 1024); } while (0)
#define PG8_MMA(ai, bj, At, Bt) do { __builtin_amdgcn_s_setprio(1); _Pragma("unroll") for (int m = 0; m < 4; ++m) _Pragma("unroll") for (int n = 0; n < 2; ++n) _Pragma("unroll") for (int k = 0; k < 2; ++k) \
        acc[ai][bj][m][n] = __builtin_amdgcn_mfma_f32_16x16x32_bf16(Bt[n][k], At[m][k], acc[ai][bj][m][n], 0, 0, 0); __builtin_amdgcn_s_setprio(0); } while (0)
#define PG8_WAIT_V(n) asm volatile("s_waitcnt vmcnt(" #n ")" ::: "memory")
#define PG8_WAIT_L(n) asm volatile("s_waitcnt lgkmcnt(" #n ")" ::: "memory")
#define PG8_BAR __builtin_amdgcn_s_barrier()
#define PG8_SCHED __builtin_amdgcn_sched_barrier(0)
    Unit cur, nxt; int ui = 0;
    if (!S.next(0, cur)) return;
    f32x4 acc[2][2][4][2];
#pragma unroll
    for (int a = 0; a < 2; ++a)
#pragma unroll
        for (int b = 0; b < 2; ++b)
#pragma unroll
            for (int m = 0; m < 4; ++m)
#pragma unroll
                for (int n = 0; n < 2; ++n) acc[a][b][m][n] = (f32x4){0.f, 0.f, 0.f, 0.f};
    bf16x8 At[4][2], B0[2][2], B1[2][2];
    const char* cA = S.a_ptr(g, cur); const char* cB = S.b_ptr(g, cur);
    S.a_ready(cur);
    if constexpr (SP2) {
        PG8_STAGE(PG8_SB(0, 0), cB, voffB); PG8_STAGE(PG8_SB(0, 1), cB + hstepB, voffB); PG8_STAGE(PG8_SA(0, 0), cA, voffA); PG8_STAGE(PG8_SA(0, 1), cA + hstepA, voffA);
        if (wr == 1) PG8_BAR;
        PG8_WAIT_V(2); PG8_BAR;
        PG8_STAGE(PG8_SB(1, 0), cB + kstep, voffB); PG8_STAGE(PG8_SA(1, 0), cA + kstep, voffA); PG8_STAGE(PG8_SB(1, 1), cB + hstepB + kstep, voffB);
        PG8_WAIT_V(6); PG8_BAR;
    } else {
        PG8_STAGE(PG8_SB(0, 0), cB, voffB); PG8_STAGE(PG8_SA(0, 0), cA, voffA); PG8_STAGE(PG8_SB(0, 1), cB + hstepB, voffB); PG8_STAGE(PG8_SA(0, 1), cA + hstepA, voffA);
        if (wr == 1) PG8_BAR;
        PG8_WAIT_V(4); PG8_BAR;
        PG8_STAGE(PG8_SB(1, 0), cB + kstep, voffB); PG8_STAGE(PG8_SA(1, 0), cA + kstep, voffA); PG8_STAGE(PG8_SB(1, 1), cB + hstepB + kstep, voffB);
        PG8_WAIT_V(6); PG8_BAR;
    }
    for (;;) {
        const bool has_next = S.next(ui + 1, nxt);
        const char* nA = has_next ? S.a_ptr(g, nxt) : cA; const char* nB = has_next ? S.b_ptr(g, nxt) : cB;
        for (int t = 0; t < nt; t += 2) {
            const bool last = (t == nt - 2);
            const char* a1 = cA + (size_t)(t + 1) * kstep;
            const char* a2 = last ? nA : cA + (size_t)(t + 2) * kstep; const char* b2 = last ? nB : cB + (size_t)(t + 2) * kstep;
            const char* a3 = a2 + kstep; const char* b3 = b2 + kstep;
            if (last && has_next) S.a_ready(nxt);
            if constexpr (SP2) {
            PG8_LDB(B0, 0, 0); PG8_LDB(B1, 0, 1); PG8_SCHED; PG8_LDA(At, 0, 0); PG8_STAGE(PG8_SA(1, 1), a1 + hstepA, voffA);
            PG8_WAIT_V(8); PG8_WAIT_L(0); PG8_BAR; PG8_MMA(0, 0, At, B0); PG8_MMA(0, 1, At, B1); PG8_BAR; PG8_SCHED;
            PG8_LDA(At, 0, 1); PG8_STAGE(PG8_SB(0, 0), b2, voffB); PG8_STAGE(PG8_SB(0, 1), b2 + hstepB, voffB); PG8_STAGE(PG8_SA(0, 0), a2, voffA);
            PG8_WAIT_V(8); PG8_WAIT_L(0); PG8_BAR; PG8_MMA(1, 0, At, B0); PG8_MMA(1, 1, At, B1); PG8_BAR; PG8_SCHED;
            PG8_LDB(B0, 1, 0); PG8_LDB(B1, 1, 1); PG8_SCHED; PG8_LDA(At, 1, 0); PG8_STAGE(PG8_SA(0, 1), a2 + hstepA, voffA);
            PG8_WAIT_V(8); PG8_WAIT_L(0); PG8_BAR; PG8_MMA(0, 0, At, B0); PG8_MMA(0, 1, At, B1); PG8_BAR; PG8_SCHED;
            PG8_LDA(At, 1, 1); PG8_STAGE(PG8_SB(1, 0), b3, voffB); PG8_STAGE(PG8_SB(1, 1), b3 + hstepB, voffB); PG8_STAGE(PG8_SA(1, 0), a3, voffA);
            PG8_WAIT_V(8); PG8_WAIT_L(0); PG8_BAR; PG8_MMA(1, 0, At, B0); PG8_MMA(1, 1, At, B1); PG8_BAR; PG8_SCHED;
            } else {
            PG8_LDB(B0, 0, 0); PG8_SCHED; PG8_LDA(At, 0, 0); PG8_STAGE(PG8_SA(1, 1), a1 + hstepA, voffA);
            PG8_WAIT_L(8); PG8_BAR; PG8_WAIT_L(0); PG8_MMA(0, 0, At, B0); PG8_BAR; PG8_SCHED;
            PG8_LDB(B1, 0, 1); PG8_STAGE(PG8_SB(0, 0), b2, voffB);
            PG8_BAR; PG8_WAIT_L(0); PG8_MMA(0, 1, At, B1); PG8_BAR;
            PG8_LDA(At, 0, 1); PG8_STAGE(PG8_SA(0, 0), a2, voffA);
            PG8_BAR; PG8_WAIT_L(0); PG8_MMA(1, 0, At, B0); PG8_BAR; PG8_SCHED;
            PG8_STAGE(PG8_SB(0, 1), b2 + hstepB, voffB);
            PG8_WAIT_V(6); PG8_BAR; PG8_MMA(1, 1, At, B1); PG8_BAR;
            PG8_LDB(B0, 1, 0); PG8_SCHED; PG8_LDA(At, 1, 0); PG8_STAGE(PG8_SA(0, 1), a2 + hstepA, voffA);
            PG8_WAIT_L(8); PG8_BAR; PG8_WAIT_L(0); PG8_MMA(0, 0, At, B0); PG8_BAR; PG8_SCHED;
            PG8_LDB(B1, 1, 1); PG8_STAGE(PG8_SB(1, 0), b3, voffB);
            PG8_BAR; PG8_WAIT_L(0); PG8_MMA(0, 1, At, B1); PG8_BAR;
            PG8_LDA(At, 1, 1); PG8_STAGE(PG8_SA(1, 0), a3, voffA);
            PG8_BAR; PG8_WAIT_L(0); PG8_MMA(1, 0, At, B0); PG8_BAR; PG8_SCHED;
            PG8_STAGE(PG8_SB(1, 1), b3 + hstepB, voffB);
            PG8_WAIT_V(6); PG8_BAR; PG8_MMA(1, 1, At, B1); PG8_BAR;
            }
        }
        if constexpr (ALIGN_EPI) { if (wr == 0) PG8_BAR; }
        if constexpr (!Epi::AFTER_DRAIN) { E(acc, cur, wr, wc, fr, fq); S.done(cur); }
        if (!has_next) break;
#pragma unroll
        for (int a = 0; a < 2; ++a)
#pragma unroll
            for (int b = 0; b < 2; ++b)
#pragma unroll
                for (int m = 0; m < 4; ++m)
#pragma unroll
                    for (int n = 0; n < 2; ++n) acc[a][b][m][n] = (f32x4){0.f, 0.f, 0.f, 0.f};
        cur = nxt; cA = nA; cB = nB; ++ui;
        if constexpr (ALIGN_EPI) { if (wr == 1) PG8_BAR; }
    }
    PG8_WAIT_V(0);
    if constexpr (!ALIGN_EPI) { if (wr == 0) PG8_BAR; }
    PG8_BAR;
    if constexpr (Epi::AFTER_DRAIN) { E.fused(acc, cur, wr, wc, fr, fq, lds, wid, lane); S.done(cur); }
#undef PG8_SA
#undef PG8_SB
#undef PG8_STAGE
#undef PG8_LDA
#undef PG8_LDB
#undef PG8_MMA
#undef PG8_WAIT_V
#undef PG8_WAIT_L
#undef PG8_BAR
#undef PG8_SCHED
}
}

__device__ __forceinline__ int map_row(int map, int n) {
    if (map == 0) return n;
    if (map == 1) {
        if (n < 1280) return n;
        if (n < 1304) return 2304 + (n - 1280);
        if (n < 1560) return 1280 + (n - 1304);
        if (n < 2328) return 1536 + (n - 1560);
        return 2560 + (n - 2328);
    }
    if (map == 2) return (n >> 7) * 256 + (n & 127);
    return (n >> 7) * 256 + 128 + (n & 127);
}
__device__ __forceinline__ void xpose_matrix(const Frame& F, const float* src, int K, int Ns, bf16* dst, int map, int nbatch = 1, size_t sstride = 0, size_t dstride = 0) {
    LAS float* tile = (LAS float*)F.lds;
    const int tid = otid(), nkt = K / 64, nnt = (Ns + 127) / 128, per = nkt * nnt, total = per * nbatch;
    const int n4 = (tid & 31) * 4, kk0 = tid >> 5, kc = tid & 7, nn0 = tid >> 3;
    f32x4 v[4];
    int it = F.bid;
    if (it < total) { const int bt = it / per, r = it % per, k0 = (r % nkt) * 64, n0 = (r / nkt) * 128; const float* sp = src + (size_t)bt * sstride;
#pragma unroll
        for (int i = 0; i < 4; ++i) v[i] = (n0 + n4 < Ns) ? *(const f32x4*)(sp + (size_t)(k0 + kk0 + 16 * i) * Ns + n0 + n4) : (f32x4){0.f, 0.f, 0.f, 0.f}; }
    for (; it < total; it += F.G) {
        const int bt = it / per, r = it % per, k0 = (r % nkt) * 64, n0 = (r / nkt) * 128;
        __syncthreads();
#pragma unroll
        for (int i = 0; i < 4; ++i) { LAS float* tp = tile + (kk0 + 16 * i) * 129 + n4; tp[0] = v[i].x; tp[1] = v[i].y; tp[2] = v[i].z; tp[3] = v[i].w; }
        __syncthreads();
        const int itn = it + F.G;
        if (itn < total) { const int btn = itn / per, rn = itn % per, k0n = (rn % nkt) * 64, n0n = (rn / nkt) * 128; const float* sp = src + (size_t)btn * sstride;
#pragma unroll
            for (int i = 0; i < 4; ++i) v[i] = (n0n + n4 < Ns) ? *(const f32x4*)(sp + (size_t)(k0n + kk0 + 16 * i) * Ns + n0n + n4) : (f32x4){0.f, 0.f, 0.f, 0.f}; }
        bf16* dp = dst + (size_t)bt * dstride;
#pragma unroll
        for (int i = 0; i < 2; ++i) { const int nn = nn0 + 64 * i, n = n0 + nn;
            if (n < Ns) { const LAS float* tp = tile + (kc * 8) * 129 + nn;
                u32x4 w; w.x = pk2(tp[0], tp[129]); w.y = pk2(tp[2 * 129], tp[3 * 129]); w.z = pk2(tp[4 * 129], tp[5 * 129]); w.w = pk2(tp[6 * 129], tp[7 * 129]);
                *(u32x4*)(dp + (size_t)map_row(map, n) * K + k0 + kc * 8) = w; } }
    }
    __syncthreads();
}
__device__ __forceinline__ void phase_weights(const Frame& F0, int l) { const Frame F = launder(F0);
    bf16* WIN = WSP(bf16, OFF_WIN);
    for (size_t i = (size_t)F.bid * 512 + F.tid; i < (size_t)(2560 - 2328) * 1024 / 2; i += (size_t)F.G * 512) ((unsigned*)(WIN + (size_t)2328 * 1024))[i] = 0u;
    for (size_t i = (size_t)F.bid * 512 + F.tid; i < (size_t)2 * 64 * 256 / 2; i += (size_t)F.G * 512) WSP(unsigned, OFF_CW2)[(i / 8192) * 16384 + 8192 + (i % 8192)] = 0u;
    __syncthreads();
    xpose_matrix(F, INP(2) + (size_t)l * 1024 * IN_DIM, 1024, IN_DIM, WIN, 1);
    for (int s = 0; s < 2; ++s) {
        xpose_matrix(F, INP(4) + ((size_t)l * 2 + s) * 2048 * 256, 2048, 256, WSP(bf16, OFF_CW1) + (size_t)s * 256 * 2048, 0);
        xpose_matrix(F, INP(5) + ((size_t)l * 2 + s) * 256 * 64, 256, 64, WSP(bf16, OFF_CW2) + (size_t)s * 128 * 256, 0);
    }
    xpose_matrix(F, INP(6) + (size_t)l * 512 * 1024, 512, 1024, WSP(bf16, OFF_WN), 0);
    {
        const float* pw = INP(7) + (size_t)l * 4 * 64 * 64; const float* psc = INP(8) + (size_t)l * 256; const float* wp = INP(9) + (size_t)l * 256 * 1024; bf16* wpt = WSP(bf16, OFF_WP);
        for (int o = F.bid * 512 + F.tid; o < 256 * 1024; o += F.G * 512) { const int k = o >> 10, n = o & 1023, g = k >> 6;
            float a = 0.f;
#pragma unroll 8
            for (int d = 0; d < 64; ++d) a += pw[(size_t)k * 64 + d] * psc[g * 64 + d] * wp[(size_t)(g * 64 + d) * 1024 + n];
            wpt[(size_t)n * 256 + k] = (bf16)f2bf(a); } }
    xpose_matrix(F, INP(11) + (size_t)l * 256 * 1024, 256, 1024, WSP(bf16, OFF_WC), 0);
    xpose_matrix(F, INP(12) + (size_t)l * 1024 * 1024, 1024, 1024, WSP(bf16, OFF_WO), 0);
    xpose_matrix(F, INP(18) + (size_t)l * NEXP * 1024 * 256, 1024, 256, WSP(bf16, OFF_W13), 2, NEXP, (size_t)1024 * 256, (size_t)512 * 1024);
    xpose_matrix(F, INP(19) + (size_t)l * NEXP * 1024 * 256, 1024, 256, WSP(bf16, OFF_W13), 3, NEXP, (size_t)1024 * 256, (size_t)512 * 1024);
    xpose_matrix(F, INP(20) + (size_t)l * NEXP * 256 * 1024, 256, 1024, WSP(bf16, OFF_W2), 0, NEXP, (size_t)256 * 1024, (size_t)1024 * 256);
    {   const float* g2 = INP(13) + (size_t)l * D; const float* wg = INP(14) + (size_t)l * D * 4; const float* we = INP(16) + (size_t)l * D * 32; bf16* wr = WSP(bf16, OFF_WR);
        for (int o = F.bid * 512 + F.tid; o < 64 * 1024; o += F.G * 512) { const int j = o >> 10, k = o & 1023;
            const float w = g2[k] * ((j < 32) ? we[(size_t)k * 32 + j] : (j < 36) ? wg[(size_t)k * 4 + (j - 32)] : 0.f);
            const unsigned hi = f2bf(w), lo = f2bf(w - bf2f(hi)); wr[o] = (bf16)hi; wr[64 * 1024 + o] = (bf16)lo; } }
    __syncthreads();
    for (int it = F.G - 1 - F.bid; it < 8; it += F.G) {
        const int s = it >> 2, j = (it & 3) * 64 + F.lane;
        const float* pe = INP(3) + ((size_t)l * 2 + s) * 2048 + F.wave * 256; const float* w1 = INP(4) + ((size_t)l * 2 + s) * 2048 * 256 + (size_t)F.wave * 256 * 256;
        float a0 = 0.f, a1 = 0.f, a2 = 0.f, a3 = 0.f;
#pragma unroll 2
        for (int k = 0; k < 256; k += 4) { a0 += pe[k] * w1[(size_t)k * 256 + j]; a1 += pe[k + 1] * w1[(size_t)(k + 1) * 256 + j]; a2 += pe[k + 2] * w1[(size_t)(k + 2) * 256 + j]; a3 += pe[k + 3] * w1[(size_t)(k + 3) * 256 + j]; }
        LAS float* red = (LAS float*)F.lds;
        red[F.wave * 64 + F.lane] = (a0 + a1) + (a2 + a3);
        __syncthreads();
        if (F.wave == 0) { float a = 0.f;
#pragma unroll
            for (int w = 0; w < 8; ++w) a += red[w * 64 + F.lane];
            WSP(float, OFF_CB1)[s * 256 + j] = a; }
        __syncthreads();
    }
}

template <bool FINAL> __device__ __forceinline__ void phase_norm(const Frame& F0, int l, const float* g) { const Frame F = launder(F0);
    const int gw = F.bid * 8 + F.wave, NGW = F.G * 8;
    const int* toks = WSP(int, OFF_TOKS); const bf16* ys = WSP(bf16, OFF_YS); bf16* xn = WSP(bf16, OFF_XN);
    for (int n = gw; n < NTOK; n += NGW) {
        f32x4 v[4]; float ss = 0.f;
        if (l == 0) {
            const f32x4* xr = (const f32x4*)(INP(0) + (size_t)n * D) + F.lane;
#pragma unroll
            for (int j = 0; j < 4; ++j) v[j] = xr[64 * j];
        } else {
            const f32x4* hr = (const f32x4*)(F.out + (size_t)n * D) + F.lane;
            const int s0 = toks[n * 2], s1 = toks[n * 2 + 1];
            const bf16* y0 = ys + (size_t)s0 * D + F.lane * 4; const bf16* y1 = ys + (size_t)s1 * D + F.lane * 4;
#pragma unroll
            for (int j = 0; j < 4; ++j) v[j] = hr[64 * j] + ld4bf(y0 + 256 * j) + ld4bf(y1 + 256 * j);
        }
#pragma unroll
        for (int j = 0; j < 4; ++j) ss += (v[j].x * v[j].x + v[j].y * v[j].y) + (v[j].z * v[j].z + v[j].w * v[j].w);
        const float rs = 1.f / sqrtf(wave_sum(ss) * (1.f / D) + RMS_EPS);
        f32x4* orow = (f32x4*)(F.out + (size_t)n * D) + F.lane;
#pragma unroll
        for (int j = 0; j < 4; ++j) {
            const f32x4 gg = ((const f32x4*)g)[F.lane + 64 * j];
            const f32x4 y = v[j] * rs * gg;
            if (FINAL) orow[64 * j] = DIAG ? y * (1.f + 0.06f * ((const float*)F.ctl)[200000]) : y;
            else { orow[64 * j] = v[j]; st4bf(xn + (size_t)n * D + F.lane * 4 + 256 * j, y); }
        }
    }
}

__device__ __forceinline__ void epi_inproj(const Frame& F, int row, int col, f32x4 v) {
    if (col < 512) { st4bf(WSP(bf16, OFF_Q) + (size_t)row * 512 + col, v); }
    else if (col < 1280) {
        const int c = col - 512, s = c >> 7, g = (c >> 6) & 1, d = c & 63, b = row >> 14, t = row & (T - 1);
        bf16* dst;
        if (s < 2) dst = WSP(bf16, OFF_KVC) + ((size_t)((b * 2 + g) * 2 + s) * TP + t) * 64 + d;
        else dst = WSP(bf16, OFF_KS + (size_t)(s - 2) * SZ_KV) + ((size_t)(b * 2 + g) * T + t) * 64 + d;
        st4bf(dst, v);
    }
    else if (col < 1536) { st4bf(WSP(bf16, OFF_PU) + (size_t)row * 256 + (col - 1280), v); }
    else if (col < 2304) { const int c = col - 1536; st4bf(WSP(bf16, OFF_CH + (size_t)(c >> 8) * SZ_C256) + (size_t)row * 256 + (c & 255), v); }
    else if (col < 2560) { const int c = col - 2304; if (c < 32) *(f32x4*)(WSP(float, OFF_NG) + (size_t)row * 32 + c) = (f32x4){sigmoidf(v.x), sigmoidf(v.y), sigmoidf(v.z), sigmoidf(v.w)}; }
    else { st4bf(WSP(bf16, OFF_MG) + (size_t)row * 3072 + (col - 2560), (f32x4){sigmoidf(v.x), sigmoidf(v.y), sigmoidf(v.z), sigmoidf(v.w)}); }
}
__device__ __forceinline__ void phase_inproj(const Frame& F0) { const Frame F = launder(F0);
    const bf16* XN = WSP(bf16, OFF_XN); const bf16* W = WSP(bf16, OFF_WIN);
    constexpr int NT = INP / 128, MT = NTOK / 128;
    for (int it = F.bid; it < MT * NT; it += F.G) {
        const int mt = it / NT, nt = it % NT;
        f32x4 acc[4][2]; ACC_ZERO(acc);
        gemm_tile_128(acc, XN + (size_t)mt * 128 * D, D, W + (size_t)nt * 128 * D, D, D, F.lds);
        TILE_FOREACH(acc, mt * 128, nt * 128, { epi_inproj(F, ROW, COL, V); });
    }
}

__device__ __forceinline__ void phase_cmp1(const Frame& F0) { const Frame F = launder(F0);
    const bf16* KVC = WSP(bf16, OFF_KVC); bf16* HC = WSP(bf16, OFF_HC); const float* cb1 = WSP(float, OFF_CB1);
    for (int it = F.bid; it < 64 * 2; it += F.G) {
        const int mt = it >> 1, nt = it & 1, plane = mt >> 3, i0 = (mt & 7) * 128, s = plane & 1;
        f32x4 acc[4][2]; ACC_ZERO(acc);
        gemm_tile_128(acc, KVC + (size_t)plane * TP * 64 + (size_t)i0 * 1024, 1024, WSP(bf16, OFF_CW1) + (size_t)s * 256 * 2048 + (size_t)nt * 128 * 2048, 2048, 2048, F.lds);
        TILE_FOREACH(acc, mt * 128, nt * 128, {
            const f32x4 bb = *(const f32x4*)(cb1 + s * 256 + COL);
            st4bf(HC + (size_t)ROW * 256 + COL, (f32x4){gelu_tanh(V.x + bb.x), gelu_tanh(V.y + bb.y), gelu_tanh(V.z + bb.z), gelu_tanh(V.w + bb.w)}); });
    }
}
__device__ __forceinline__ void phase_cmp2(const Frame& F0) { const Frame F = launder(F0);
    const bf16* HC = WSP(bf16, OFF_HC);
    for (int it = F.bid; it < 64; it += F.G) {
        const int mt = it, plane = mt >> 3, s = plane & 1, bg = plane >> 1;
        f32x4 acc[4][2]; ACC_ZERO(acc);
        gemm_tile_128(acc, HC + (size_t)mt * 128 * 256, 256, WSP(bf16, OFF_CW2) + (size_t)s * 128 * 256, 256, 256, F.lds);
        bf16* dst = WSP(bf16, s == 0 ? OFF_KC : OFF_VC) + (size_t)bg * 1024 * 64;
        if (ATTN_MFMA && s == 1) {
            TILE_FOREACH(acc, (mt & 7) * 128, 0, { if (COL < 64) { f32x4 o = V; if (ROW == 1023) o = o * 0.f;
                bf16* vb = dst + (size_t)(ROW >> 6) * 4096 + vtile_off(ROW & 63, COL);
                vb[0] = (bf16)f2bf(o.x); vb[8] = (bf16)f2bf(o.y); vb[16] = (bf16)f2bf(o.z); vb[24] = (bf16)f2bf(o.w); } });
        } else if (ATTN_MFMA) {
            TILE_FOREACH(acc, (mt & 7) * 128, 0, { if (COL < 64) { f32x4 o = V; if (ROW == 1023) o = o * 0.f; st4bf(dst + (size_t)(ROW >> 6) * 4096 + ktile_off(ROW & 63, COL & ~7) + (COL & 7), o); } });
        } else {
            TILE_FOREACH(acc, (mt & 7) * 128, 0, { if (COL < 64) { f32x4 o = V; if (ROW == 1023) o = o * 0.f; st4bf(dst + (size_t)ROW * 64 + COL, o); } });
        }
    }
}

__device__ __forceinline__ void ld8bf(const bf16* p, f32x4& a, f32x4& b) { const u32x4 w = *(const u32x4*)p;
    a = (f32x4){bf2f(w.x & 0xffffu), bf2f(w.x >> 16), bf2f(w.y & 0xffffu), bf2f(w.y >> 16)}; b = (f32x4){bf2f(w.z & 0xffffu), bf2f(w.z >> 16), bf2f(w.w & 0xffffu), bf2f(w.w >> 16)}; }
template <int W> __device__ __forceinline__ void pool_window(const bf16* pu, int t, f32x4& s0, f32x4& s1) {
    if (t >= W - 1) {
#pragma unroll
        for (int i = 1; i < W; ++i) { f32x4 a, b; ld8bf(pu - (size_t)i * 256, a, b); s0 += a; s1 += b; }
    } else { for (int i = 1; i <= t; ++i) { f32x4 a, b; ld8bf(pu - (size_t)i * 256, a, b); s0 += a; s1 += b; } }
}
__device__ __forceinline__ void phase_poolconv(const Frame& F0, int l, int first_blk) { const Frame F = launder(F0);
    const bf16* PU = WSP(bf16, OFF_PU); const bf16* CH = WSP(bf16, OFF_CH); const bf16* CBp = WSP(bf16, OFF_CB); const bf16* CC = WSP(bf16, OFF_CC);
    bf16* PM = WSP(bf16, OFF_PM); bf16* CV = WSP(bf16, OFF_CV);
    const float* cw = INP(10) + (size_t)l * 3 * 256;
    const int nb = F.G - first_blk; if (F.bid < first_blk) return;
    for (int it = (F.bid - first_blk) * 512 + F.tid; it < NTOK * 32; it += nb * 512) {
        const int n = it >> 5, c0 = (it & 31) * 8, t = n & (T - 1), g = c0 >> 6;
        const size_t r = (size_t)n * 256 + c0;
        {   f32x4 u0, u1; ld8bf(PU + r, u0, u1); f32x4 s0 = u0, s1 = u1;
            if (g == 0) pool_window<2>(PU + r, t, s0, s1); else if (g == 1) pool_window<4>(PU + r, t, s0, s1); else if (g == 2) pool_window<8>(PU + r, t, s0, s1); else pool_window<16>(PU + r, t, s0, s1);
            const int w = 2 << g; const float inv = 1.f / (float)((t + 1 < w) ? t + 1 : w);
            *(u32x4*)(PM + r) = pg8::pack8(s0 * inv - u0, s1 * inv - u1); }
        {   f32x4 y0 = {0.f, 0.f, 0.f, 0.f}, y1 = y0;
#pragma unroll
            for (int k = 0; k < 3; ++k) { if (t - 2 + k >= 0) { const size_t rr = r - (size_t)(2 - k) * 256; f32x4 a0, a1, h0, h1; ld8bf(CC + rr, a0, a1); ld8bf(CH + rr, h0, h1);
                y0 += *(const f32x4*)(cw + k * 256 + c0) * a0 * h0; y1 += *(const f32x4*)(cw + k * 256 + c0 + 4) * a1 * h1; } }
            f32x4 b0, b1; ld8bf(CBp + r, b0, b1);
            *(u32x4*)(CV + r) = pg8::pack8(y0 * b0, y1 * b1); }
    }
}

__device__ __forceinline__ void dot4(const bf16* krow, const LAS float* qs, float (&acc)[4]) {
#pragma unroll
    for (int c = 0; c < 8; ++c) {
        const uint4 kv = ((const uint4*)krow)[c];
        const float k0 = bf2f(kv.x & 0xffffu), k1 = bf2f(kv.x >> 16), k2 = bf2f(kv.y & 0xffffu), k3 = bf2f(kv.y >> 16), k4 = bf2f(kv.z & 0xffffu), k5 = bf2f(kv.z >> 16), k6 = bf2f(kv.w & 0xffffu), k7 = bf2f(kv.w >> 16);
#pragma unroll
        for (int r = 0; r < 4; ++r) { const LAS float* q = qs + r * 64 + c * 8;
            acc[r] += (k0 * q[0] + k1 * q[1]) + (k2 * q[2] + k3 * q[3]) + (k4 * q[4] + k5 * q[5]) + (k6 * q[6] + k7 * q[7]); }
    }
}
__device__ __forceinline__ void softmax4(LAS float* sc, int n, int lane) {
#pragma unroll
    for (int r = 0; r < 4; ++r) {
        LAS float* s = sc + r * 1024; float m = -INFINITY;
        for (int c = lane; c < n; c += 64) m = fmaxf(m, s[c]);
        m = wave_max(m);
        float sum = 0.f;
        for (int c = lane; c < n; c += 64) { const float e = __expf(s[c] - m); s[c] = e; sum += e; }
        sum = wave_sum(sum);
        const float inv = 1.f / sum;
        for (int c = lane; c < n; c += 64) s[c] *= inv;
    }
}
__device__ __forceinline__ void phase_attn_valu(const Frame& F0) { const Frame F = launder(F0);
    LAS float* sc = (LAS float*)(F.lds + F.wave * 17472); LAS float* qs = sc + 4096; LAS int* sel = (LAS int*)(qs + 256);
    const int lane = F.lane;
    const bf16* Q = WSP(bf16, OFF_Q); const float* NG = WSP(float, OFF_NG); bf16* O = WSP(bf16, OFF_O);
    for (int task = F.bid * 8 + F.wave; task < 2 * NTOK; task += F.G * 8) {
        const int bg = task >> 14, t = task & (T - 1), b = bg >> 1, g = bg & 1, n = b * T + t;
        { const f32x4 q4 = ld4bf(Q + (size_t)n * 512 + g * 256 + lane * 4); *(LAS f32x4*)(qs + lane * 4) = q4; }
        WAVE_SYNC();
        float slope[4];
#pragma unroll
        for (int r = 0; r < 4; ++r) slope[r] = exp2f(-(float)(g * 4 + r + 1));
        const int ncv = (t >= 31) ? ((t - 31) >> 4) + 1 : 0;
        const bf16* kc = WSP(bf16, OFF_KC) + (size_t)bg * 1024 * 64; const bf16* vc = WSP(bf16, OFF_VC) + (size_t)bg * 1024 * 64;
        for (int c = lane; c < ncv; c += 64) {
            float a[4] = {0.f, 0.f, 0.f, 0.f}; dot4(kc + (size_t)c * 64, qs, a);
            const float dist = (float)(t - (16 * c + 31));
#pragma unroll
            for (int r = 0; r < 4; ++r) sc[r * 1024 + c] = a[r] * 0.125f - slope[r] * dist;
        }
        WAVE_SYNC();
        float oc[4] = {0.f, 0.f, 0.f, 0.f};
        if (ncv > 0) {
            softmax4(sc, ncv, lane);
            WAVE_SYNC();
            for (int c = 0; c < ncv; ++c) { const float v = bf2f(vc[(size_t)c * 64 + lane]);
#pragma unroll
                for (int r = 0; r < 4; ++r) oc[r] += sc[r * 1024 + c] * v; }
            WAVE_SYNC();
            for (int c = lane; c < ncv; c += 64) sc[c] = (sc[c] + sc[1024 + c]) + (sc[2048 + c] + sc[3072 + c]);
        }
        WAVE_SYNC();
        const int cur = t >> 6;
        float val[4];
#pragma unroll
        for (int i = 0; i < 4; ++i) {
            const int j = lane + 64 * i; float imp = 0.f;
#pragma unroll
            for (int o = 0; o < 5; ++o) { const int c = 4 * j + o - 1; if (c >= 0 && c < ncv) imp += sc[c]; }
            const bool forced = (j == 0) || (j == cur) || (j == cur - 1), valid = (j <= cur);
            val[i] = forced ? 1e30f : (valid ? imp : -1e30f);
        }
        WAVE_SYNC();
        int nsel = 0;
        for (int it = 0; it < 16; ++it) {
            float bv = val[0]; int bj = lane;
#pragma unroll
            for (int i = 1; i < 4; ++i) if (val[i] > bv) { bv = val[i]; bj = lane + 64 * i; }
#pragma unroll
            for (int o = 1; o < 64; o <<= 1) { const float ov = __shfl_xor(bv, o); const int oj = __shfl_xor(bj, o); if (ov > bv || (ov == bv && oj < bj)) { bv = ov; bj = oj; } }
            if (bv < -1e29f) break;
            if (lane == 0) sel[nsel] = bj;
            ++nsel;
#pragma unroll
            for (int i = 0; i < 4; ++i) if (bj == lane + 64 * i) val[i] = -INFINITY;
        }
        WAVE_SYNC();
        const bf16* ks = WSP(bf16, OFF_KS) + (size_t)bg * T * 64; const bf16* vs = WSP(bf16, OFF_VS) + (size_t)bg * T * 64;
        for (int i = 0; i < nsel; ++i) {
            const int pos = sel[i] * 64 + lane;
            float a[4] = {0.f, 0.f, 0.f, 0.f}; dot4(ks + (size_t)pos * 64, qs, a);
            const float dist = (float)(t - pos);
#pragma unroll
            for (int r = 0; r < 4; ++r) sc[r * 1024 + i * 64 + lane] = (pos <= t) ? a[r] * 0.125f - slope[r] * dist : -INFINITY;
        }
        WAVE_SYNC();
        softmax4(sc, nsel * 64, lane);
        WAVE_SYNC();
        float os[4] = {0.f, 0.f, 0.f, 0.f};
        for (int i = 0; i < nsel; ++i) { const bf16* vb = vs + (size_t)sel[i] * 64 * 64 + lane;
            for (int k = 0; k < 64; ++k) { const float v = bf2f(vb[k * 64]);
#pragma unroll
                for (int r = 0; r < 4; ++r) os[r] += sc[r * 1024 + i * 64 + k] * v; } }
        WAVE_SYNC();
        const bf16* kw = WSP(bf16, OFF_KW) + (size_t)bg * T * 64; const bf16* vw = WSP(bf16, OFF_VW) + (size_t)bg * T * 64;
        const int lo = (t >= 511) ? t - 511 : 0, nk = t - lo + 1;
        for (int i = lane; i < nk; i += 64) {
            const int pos = lo + i;
            float a[4] = {0.f, 0.f, 0.f, 0.f}; dot4(kw + (size_t)pos * 64, qs, a);
            const float dist = (float)(t - pos);
#pragma unroll
            for (int r = 0; r < 4; ++r) sc[r * 1024 + i] = a[r] * 0.125f - slope[r] * dist;
        }
        WAVE_SYNC();
        softmax4(sc, nk, lane);
        WAVE_SYNC();
        float ow[4] = {0.f, 0.f, 0.f, 0.f};
        for (int i = 0; i < nk; ++i) { const float v = bf2f(vw[(size_t)(lo + i) * 64 + lane]);
#pragma unroll
            for (int r = 0; r < 4; ++r) ow[r] += sc[r * 1024 + i] * v; }
        WAVE_SYNC();
        const float* ng = NG + (size_t)n * 32 + g * 12;
#pragma unroll
        for (int r = 0; r < 4; ++r) O[(size_t)n * 512 + g * 256 + r * 64 + lane] = (bf16)f2bf(ng[r * 3] * oc[r] + ng[r * 3 + 1] * os[r] + ng[r * 3 + 2] * ow[r]);
    }
}


typedef float f32x16 __attribute__((ext_vector_type(16)));
typedef float f32x2_t __attribute__((ext_vector_type(2))); typedef __bf16 bf16x2_t __attribute__((ext_vector_type(2)));
__device__ __forceinline__ unsigned cvtpk(float lo, float hi) { f32x2_t v = {lo, hi}; bf16x2_t b = __builtin_convertvector(v, bf16x2_t); return __builtin_bit_cast(unsigned, b); }
__device__ __forceinline__ float pmax32(float x) { auto rr = __builtin_amdgcn_permlane32_swap(__float_as_uint(x), __float_as_uint(x), false, false); return fmaxf(__uint_as_float(rr[0]), __uint_as_float(rr[1])); }
__device__ __forceinline__ float psum32(float x) { auto rr = __builtin_amdgcn_permlane32_swap(__float_as_uint(x), __float_as_uint(x), false, false); return __uint_as_float(rr[0]) + __uint_as_float(rr[1]); }
__device__ __forceinline__ float ex2(float x) { return __builtin_amdgcn_exp2f(x); }
constexpr float ANEG = -1e30f;
#ifndef ATTN_PROBE
#define ATTN_PROBE 0
#endif

#define APD(b) (((ATTN_PROBE >> (b)) & 1) ? 2 : 1)
#define KKC(kh, i) ((kh) * 32 + ((i) & 3) + 8 * ((i) >> 2))
struct AttnSt { f32x16 o0, o1; float m, l; };
__device__ __forceinline__ void attn_loadk(bf16x8 (&kf)[2][4], const bf16* kt, int r32, int h) {
#pragma unroll
    for (int kh = 0; kh < 2; ++kh)
#pragma unroll
        for (int ks = 0; ks < 4; ++ks) kf[kh][ks] = *(const bf16x8*)(kt + ((kh * 4 + ks) * 64 + h * 32 + r32) * 8);
}
template <int MODE> __device__ __forceinline__ void attn_scores(f32x16& s0, f32x16& s1, const bf16x8 (&kf)[2][4], const bf16x8 (&qf)[4], float cb, float slk, int lo, int hi, int h, bool domask) {
    asm volatile("" : "+v"(slk));
    const float cbh = cb + slk * (float)(4 * h);
#pragma unroll
    for (int i = 0; i < 16; ++i) { s0[i] = cbh + slk * (float)KKC(0, i); s1[i] = cbh + slk * (float)KKC(1, i); }
#pragma unroll
    for (int ks = 0; ks < 4; ++ks) { s0 = __builtin_amdgcn_mfma_f32_32x32x16_bf16(kf[0][ks], qf[ks], s0, 0, 0, 0); s1 = __builtin_amdgcn_mfma_f32_32x32x16_bf16(kf[1][ks], qf[ks], s1, 0, 0, 0); }
    if (domask) { const int hh = hi - 4 * h, ll = lo - 4 * h;
#pragma unroll
        for (int i = 0; i < 16; ++i) {
            const bool v0 = (KKC(0, i) <= hh) && (MODE == 1 || KKC(0, i) >= ll), v1 = (KKC(1, i) <= hh) && (MODE == 1 || KKC(1, i) >= ll);
            s0[i] = v0 ? s0[i] : ANEG; s1[i] = v1 ? s1[i] : ANEG; } }
}
__device__ __forceinline__ float mx3(float a, float b, float c) { float r; asm("v_max3_f32 %0, %1, %2, %3" : "=v"(r) : "v"(a), "v"(b), "v"(c)); return r; }
__device__ __forceinline__ float max16x2(const f32x16& a, const f32x16& b) {
    const float m0 = mx3(a[0], a[1], a[2]), m1 = mx3(a[3], a[4], a[5]), m2 = mx3(a[6], a[7], a[8]), m3 = mx3(a[9], a[10], a[11]), m4 = mx3(a[12], a[13], a[14]);
    const float n0 = mx3(b[0], b[1], b[2]), n1 = mx3(b[3], b[4], b[5]), n2 = mx3(b[6], b[7], b[8]), n3 = mx3(b[9], b[10], b[11]), n4 = mx3(b[12], b[13], b[14]);
    const float q0 = mx3(m0, m1, m2), q1 = mx3(m3, m4, a[15]), q2 = mx3(n0, n1, n2), q3 = mx3(n3, n4, b[15]);
    return fmaxf(mx3(q0, q1, q2), q3);
}
__device__ __forceinline__ void attn_loadv(bf16x8 (&vf)[2][4], const bf16* vt, int r32, int h) {
#pragma unroll
    for (int dh = 0; dh < 2; ++dh)
#pragma unroll
        for (int k4 = 0; k4 < 4; ++k4) vf[dh][k4] = *(const bf16x8*)(vt + ((dh * 4 + k4) * 64 + h * 32 + r32) * 8);
}
__device__ __forceinline__ void attn_pack(bf16x8 (&pf)[4], const f32x16& p0, const f32x16& p1) {
#pragma unroll
    for (int k4 = 0; k4 < 4; ++k4) {
        const f32x16& p = (k4 < 2) ? p0 : p1; const int b = (k4 & 1) * 8;
        typedef unsigned u32x4v __attribute__((ext_vector_type(4)));
        u32x4v w; w.x = cvtpk(p[b + 0], p[b + 1]); w.y = cvtpk(p[b + 2], p[b + 3]); w.z = cvtpk(p[b + 4], p[b + 5]); w.w = cvtpk(p[b + 6], p[b + 7]);
        pf[k4] = __builtin_bit_cast(bf16x8, w);
    }
}
__device__ __forceinline__ void attn_pvp(f32x16& o0, f32x16& o1, const bf16x8 (&pf)[4], const bf16x8 (&vf)[2][4]) {
#pragma unroll
    for (int k4 = 0; k4 < 4; ++k4) {
        o0 = __builtin_amdgcn_mfma_f32_32x32x16_bf16(vf[0][k4], pf[k4], o0, 0, 0, 0);
        o1 = __builtin_amdgcn_mfma_f32_32x32x16_bf16(vf[1][k4], pf[k4], o1, 0, 0, 0);
    }
}
__device__ __forceinline__ void attn_pv(f32x16& o0, f32x16& o1, const f32x16& p0, const f32x16& p1, const bf16x8 (&vf)[2][4]) {
    bf16x8 pf[4]; attn_pack(pf, p0, p1); attn_pvp(o0, o1, pf, vf);
}
template <int MODE> __device__ __forceinline__ void attn_tile(AttnSt& st, bf16x8 (&kf)[2][4], const bf16* kt_next, const bf16* vt, const bf16x8 (&qf)[4], float cb, float slk, int lo, int hi, int r32, int h, bool domask) {
    f32x16 s0, s1; bf16x8 vf[2][4];
    attn_loadv(vf, vt, r32, h);
#if ATTN_PROBE & 32
    bf16x8 kf2[4];
#pragma unroll
    for (int ks = 0; ks < 4; ++ks) kf2[ks] = *(const bf16x8*)(kt_next + 4096 + (ks * 64 + h * 32 + r32) * 8);
#endif
    const bool inited = st.m > -1e29f; const float mr = inited ? st.m : 0.f;
    attn_scores<MODE>(s0, s1, kf, qf, cb - mr, slk, lo, hi, h, domask);
    attn_loadk(kf, kt_next, r32, h);
    const float tm = pmax32(max16x2(s0, s1));
    const bool mv = inited ? (tm > 8.f) : (tm > -1e29f);
    if (__any(mv)) {
        const float delta = mv ? tm : 0.f, al = (mv && inited) ? ex2(-delta) : 1.f;
        st.m = mv ? mr + delta : st.m; st.l *= al; st.o0 *= al; st.o1 *= al;
#pragma unroll
        for (int i = 0; i < 16; ++i) { s0[i] -= delta; s1[i] -= delta; }
    }
    float ls = 0.f;
#pragma unroll
    for (int i = 0; i < 16; ++i) { s0[i] = ex2(s0[i]); s1[i] = ex2(s1[i]); ls += s0[i] + s1[i]; }
    st.l += ls;
#if ATTN_PROBE & 64
    { float dz = 0.f;
#pragma unroll
      for (int i = 0; i < 16; ++i) dz += ex2(s0[i] * 0.5f - 3.f) + ex2(s1[i] * 0.5f - 3.f);
      asm volatile("" :: "v"(dz)); }
#endif
    attn_pv(st.o0, st.o1, s0, s1, vf);
#if ATTN_PROBE & 32
#pragma unroll
    for (int b = 0; b < 4; ++b) asm volatile("" :: "v"(kf2[b]));
#endif
}
__device__ __forceinline__ int imax_row16(int x) {
    x = max(x, __builtin_amdgcn_update_dpp(x, x, 0x128, 0xf, 0xf, false)); x = max(x, __builtin_amdgcn_update_dpp(x, x, 0x124, 0xf, 0xf, false));
    x = max(x, __builtin_amdgcn_update_dpp(x, x, 0x122, 0xf, 0xf, false)); x = max(x, __builtin_amdgcn_update_dpp(x, x, 0x121, 0xf, 0xf, false));
    return x;
}
__device__ __forceinline__ void phase_attn_mfma(const Frame& F0) { const Frame F = launder(F0);
    const int lane = F.lane, r32 = lane & 31, h = lane >> 5, tt = r32 & 7, hd = r32 >> 3;
    LAS float* imp = (LAS float*)(F.lds + F.wave * 17152); LAS unsigned* selm = (LAS unsigned*)(imp + 2048); LAS int* ulist = (LAS int*)(selm + 64); LAS f32x4* otl = (LAS f32x4*)(ulist + 128) + lane;
    const bf16* Q = WSP(bf16, OFF_Q); const float* NG = WSP(float, OFF_NG); bf16* O = WSP(bf16, OFF_O);
    const int vcu = (F.G % 8 == 0) ? (F.bid % 8) * (F.G / 8) + F.bid / 8 : F.bid;
    const int wv = vcu * 8 + F.wave, NW = F.G * 8;
    for (int wt = wv; wt < 4 * 2048; wt += NW) {
        const int bg = wt >> 11, gi0 = wt & 2047, grp = (bg & 1) ? 2047 - gi0 : gi0, b = bg >> 1, g = bg & 1;
        const int t0 = grp * 8, t = t0 + tt, n = b * T + t, cur = t0 >> 6, tl = (t0 & 63) + tt;
        const float sl2 = ex2(-(float)(g * 4 + hd + 1)) * 1.4426950408889634f;
        bf16x8 qf[4];
        {   const bf16* qp = Q + (size_t)n * 512 + g * 256 + hd * 64 + h * 8;
#pragma unroll
            for (int ks = 0; ks < 4; ++ks) { f32x4 a = ld4bf(qp + ks * 16), c = ld4bf(qp + ks * 16 + 4); a = a * 0.18033688011112042f; c = c * 0.18033688011112042f;
                typedef unsigned u32x4v __attribute__((ext_vector_type(4))); u32x4v w; w.x = cvtpk(a.x, a.y); w.y = cvtpk(a.z, a.w); w.z = cvtpk(c.x, c.y); w.w = cvtpk(c.z, c.w); qf[ks] = __builtin_bit_cast(bf16x8, w); } }
        const float* ngp = NG + (size_t)n * 32 + g * 12 + hd * 3;
        const float gc = ngp[0], gs = ngp[1], gw = ngp[2];
        bf16x8 kf[2][4];
        const int ncv = (t >= 31) ? ((t - 31) >> 4) + 1 : 0;
        const int ncv_hi = (t0 + 7 >= 31) ? ((t0 + 7 - 31) >> 4) + 1 : 0, ncv_lo = (t0 >= 31) ? ((t0 - 31) >> 4) + 1 : 0, nct = (ncv_hi + 63) >> 6;
        const bf16* kc = WSP(bf16, OFF_KC) + (size_t)bg * 1024 * 64; const bf16* vct = WSP(bf16, OFF_VC) + (size_t)bg * 1024 * 64;
        const float slc = sl2 * 16.f;
        float cm = ANEG, cl = 0.f;
        if (nct > 0) attn_loadk(kf, kc + (size_t)(nct - 1) * 4096, r32, h);
        for (int rp = 0; rp < APD(0); ++rp) { cm = ANEG; cl = 0.f;
        for (int ct = nct - 1; ct >= 0; --ct) {
            const bool cin = cm > -1e29f; const float cmr = cin ? cm : 0.f;
            f32x16 s0, s1; const float cb = sl2 * (float)(1024 * ct + 31 - t) - cmr;
            attn_scores<1>(s0, s1, kf, qf, cb, slc, 0, ncv - 1 - ct * 64, h, ct * 64 + 63 >= ncv_lo);
            attn_loadk(kf, kc + (size_t)((ct > 0) ? ct - 1 : ((APD(0) > 1 && rp == 0) ? nct - 1 : 0)) * 4096, r32, h);
            const float tm = max16x2(s0, s1);
            const bool mv = cin ? (tm > 8.f) : (tm > -1e29f);
            if (__any(mv)) { const float delta = mv ? tm : 0.f; if (mv && cin) cl *= ex2(-delta); if (mv) cm = cmr + delta;
#pragma unroll
                for (int i = 0; i < 16; ++i) { s0[i] -= delta; s1[i] -= delta; } }
            float ls = 0.f;
#pragma unroll
            for (int i = 0; i < 16; ++i) ls += ex2(s0[i]) + ex2(s1[i]);
            cl += ls;
        } }
        {   const float mp = pmax32(cm), mu = (mp > -1e29f) ? mp : 0.f; cl = psum32(cl * ex2(cm - mu)); cm = mu; }
        const float coff = (cl > 0.f) ? cm + __builtin_amdgcn_logf(cl) : 1e30f;
#pragma unroll
        for (int i = 0; i < 8; ++i) *(LAS f32x4*)(imp + (i * 64 + lane) * 4) = (f32x4){0.f, 0.f, 0.f, 0.f};
        WAVE_SYNC();
        {   f32x16 oc0, oc1;
            for (int rp = 0; rp < APD(1); ++rp) {
#pragma unroll
            for (int i = 0; i < 16; ++i) { oc0[i] = 0.f; oc1[i] = 0.f; }
            float carry = 0.f;
            for (int ct = 0; ct < nct; ++ct) {
                f32x16 s0, s1; const float cb = sl2 * (float)(1024 * ct + 31 - t) - coff;
                attn_scores<1>(s0, s1, kf, qf, cb, slc, 0, ncv - 1 - ct * 64, h, ct * 64 + 63 >= ncv_lo);
                attn_loadk(kf, kc + (size_t)((ct + 1 < nct) ? ct + 1 : 0) * 4096, r32, h);
#pragma unroll
                for (int i = 0; i < 16; ++i) { s0[i] = ex2(s0[i]); s1[i] = ex2(s1[i]); }
                bf16x8 pf[4]; attn_pack(pf, s0, s1);
                float g4[2][4], xs[2][4];
#pragma unroll
                for (int q = 0; q < 4; ++q) { g4[0][q] = (s0[4 * q] + s0[4 * q + 1]) + (s0[4 * q + 2] + s0[4 * q + 3]); g4[1][q] = (s1[4 * q] + s1[4 * q + 1]) + (s1[4 * q + 2] + s1[4 * q + 3]);
                    xs[0][q] = __shfl_xor(s0[4 * q + 3], 32); xs[1][q] = __shfl_xor(s1[4 * q + 3], 32); }
#pragma unroll
                for (int kh = 0; kh < 2; ++kh)
#pragma unroll
                    for (int q = 0; q < 4; ++q) {
                        const float prev = (q > 0) ? xs[kh][q - 1] : (kh ? xs[0][3] : carry);
                        float v = g4[kh][q] + (h ? xs[kh][q] : prev);
                        v += __shfl_xor(v, 8); v += __shfl_xor(v, 16);
                        if (hd == 0) imp[tt * 256 + ct * 16 + kh * 8 + 2 * q + h] = v;
                    }
                carry = xs[1][3];
                asm volatile("" ::: "memory");
                { bf16x8 vf[2][4]; attn_loadv(vf, vct + (size_t)ct * 4096, r32, h); attn_pvp(oc0, oc1, pf, vf); }
            } }
#pragma unroll
            for (int q = 0; q < 4; ++q) { otl[64 * q] = gc * (f32x4){oc0[4 * q], oc0[4 * q + 1], oc0[4 * q + 2], oc0[4 * q + 3]}; otl[64 * (4 + q)] = gc * (f32x4){oc1[4 * q], oc1[4 * q + 1], oc1[4 * q + 2], oc1[4 * q + 3]}; }
        }
        WAVE_SYNC();
        unsigned uword = 0u, iword = 0xffffffffu;
        for (int rp = 0; rp < APD(2); ++rp) { uword = 0u; iword = 0xffffffffu;
        if (cur <= 15) {
            const unsigned mw = (lane == 0) ? ((2u << cur) - 1u) : 0u;
            if (lane < 8) { uword = mw; iword = mw;
#pragma unroll
                for (int k = 0; k < 8; ++k) selm[k * 8 + lane] = mw; }
        } else {
            for (int k = 0; k < 8; ++k) {
                const f32x4 iv = *(const LAS f32x4*)(imp + k * 256 + lane * 4);
                int v[4];
#pragma unroll
                for (int i = 0; i < 4; ++i) { const int j = lane * 4 + i; v[i] = __float_as_int(iv[i]); if (j == 0 || j >= cur - 1) v[i] = (int)0xBF800000; }
                unsigned mw = 0u;
                { const int w0 = 0, wa = cur >> 5, wb = (cur - 1) >> 5; if (lane == w0) mw |= 1u; if (lane == wa) mw |= 1u << (cur & 31); if (lane == wb) mw |= 1u << ((cur - 1) & 31); }
                for (int it = 0; it < 13; ++it) {
                    const int m4 = max(max(v[0], v[1]), max(v[2], v[3]));
                    const int rm = imax_row16(m4);
                    const int wm = max(max(__builtin_amdgcn_readlane(rm, 0), __builtin_amdgcn_readlane(rm, 16)), max(__builtin_amdgcn_readlane(rm, 32), __builtin_amdgcn_readlane(rm, 48)));
                    const unsigned long long bal = __ballot(m4 == wm);
                    const int win = __builtin_amdgcn_readfirstlane((int)__ffsll((long long)bal) - 1);
                    const int slot = (v[0] == wm) ? 0 : (v[1] == wm) ? 1 : (v[2] == wm) ? 2 : 3;
                    const int sslot = __builtin_amdgcn_readlane(slot, win);
                    const int j = win * 4 + sslot;
                    if (lane == win) {
#pragma unroll
                        for (int i = 0; i < 4; ++i) if (sslot == i) v[i] = (int)0xBF800000; }
                    if (lane == (j >> 5)) mw |= 1u << (j & 31);
                }
                if (lane < 8) { selm[k * 8 + lane] = mw; uword |= mw; iword &= mw; }
            }
        } }
        int nu = 0;
        for (int w = 7; w >= 0; --w) { unsigned bits = __builtin_amdgcn_readlane(uword, w);
            while (bits) { const int bb = 31 - __builtin_clz(bits); bits &= ~(1u << bb); if (lane == 0) ulist[nu] = w * 32 + bb; ++nu; } }
        WAVE_SYNC();
        {   AttnSt st;
            for (int rp = 0; rp < APD(3); ++rp) {
#pragma unroll
            for (int i = 0; i < 16; ++i) { st.o0[i] = 0.f; st.o1[i] = 0.f; }
            st.m = ANEG; st.l = 0.f;
            const bf16* ksb = WSP(bf16, OFF_KS) + (size_t)bg * T * 64; const bf16* vsb = WSP(bf16, OFF_VS) + (size_t)bg * T * 64;
            int j = __builtin_amdgcn_readfirstlane(ulist[0]);
            attn_loadk(kf, ksb + (size_t)j * 4096, r32, h);
            for (int u = 0; u < nu; ++u) {
                const int jn = __builtin_amdgcn_readfirstlane(ulist[(u + 1 < nu) ? u + 1 : u]);
                const unsigned rw = selm[tt * 8 + (j >> 5)]; const bool rsel = (rw >> (j & 31)) & 1u;
                const bool full = ((__builtin_amdgcn_readlane(iword, j >> 5) >> (j & 31)) & 1u) && (j < cur);
                const float cb = sl2 * (float)(64 * j - t);
                attn_tile<1>(st, kf, ksb + (size_t)jn * 4096, vsb + (size_t)j * 4096, qf, cb, sl2, 0, rsel ? ((j == cur) ? tl : 63) : -100, r32, h, !full);
                j = jn;
            } }
            const float lr = psum32(st.l), sc = (lr > 0.f) ? gs / lr : 0.f;
#pragma unroll
            for (int q = 0; q < 4; ++q) { otl[64 * q] += sc * (f32x4){st.o0[4 * q], st.o0[4 * q + 1], st.o0[4 * q + 2], st.o0[4 * q + 3]}; otl[64 * (4 + q)] += sc * (f32x4){st.o1[4 * q], st.o1[4 * q + 1], st.o1[4 * q + 2], st.o1[4 * q + 3]}; }
        }
        {   AttnSt st;
#if DIAG
            unsigned long long dc0 = 0, dw0 = 0; int dnt = 1;
#endif
            for (int rp = 0; rp < APD(4); ++rp) {
#pragma unroll
            for (int i = 0; i < 16; ++i) { st.o0[i] = 0.f; st.o1[i] = 0.f; }
            st.m = ANEG; st.l = 0.f;
            const bf16* kwb = WSP(bf16, OFF_KW) + (size_t)bg * T * 64; const bf16* vwb = WSP(bf16, OFF_VW) + (size_t)bg * T * 64;
            const int thi = (t0 + 7) >> 6, tlo = (t0 >= 511) ? ((t0 - 511) >> 6) : 0;
            attn_loadk(kf, kwb + (size_t)thi * 4096, r32, h);
#if DIAG
            dc0 = __builtin_amdgcn_s_memtime(); dw0 = __builtin_amdgcn_s_memrealtime(); dnt = thi - tlo + 1;
#endif
            for (int tile = thi; tile >= tlo; --tile) {
                const int tn = (tile > tlo) ? tile - 1 : tile;
                const float cb = sl2 * (float)(64 * tile - t);
                const bool full = (64 * tile + 63 <= t0) && (64 * tile >= t0 + 7 - 511);
                attn_tile<2>(st, kf, kwb + (size_t)tn * 4096, vwb + (size_t)tile * 4096, qf, cb, sl2, t - 511 - 64 * tile, t - 64 * tile, r32, h, !full);
            } }
#if DIAG
            { const unsigned long long dc1 = __builtin_amdgcn_s_memtime(), dw1 = __builtin_amdgcn_s_memrealtime();
              if (F.bid == 0 && F.wave == 0 && lane == 0 && wt == wv + 3 * NW) {
                  const float cyc = (float)(dc1 - dc0), wal = (float)(dw1 - dw0) * 10.f;
                  const float q = (DIAG == 1) ? (cyc / wal) / 3.f : (cyc / (float)dnt) / 8000.f;
                  ((float*)F.ctl)[200000] = floorf(q * 8.f + 0.5f) * 0.125f; } }
#endif
            const float lr = psum32(st.l), sc = (lr > 0.f) ? gw / lr : 0.f;
            bf16* op = O + (size_t)n * 512 + g * 256 + hd * 64 + 4 * h;
#pragma unroll
            for (int q = 0; q < 4; ++q) {
                st4bf(op + 8 * q, otl[64 * q] + sc * (f32x4){st.o0[4 * q], st.o0[4 * q + 1], st.o0[4 * q + 2], st.o0[4 * q + 3]});
                st4bf(op + 32 + 8 * q, otl[64 * (4 + q)] + sc * (f32x4){st.o1[4 * q], st.o1[4 * q + 1], st.o1[4 * q + 2], st.o1[4 * q + 3]}); }
        }
        WAVE_SYNC();
    }
}

__device__ __forceinline__ void phase_merge(const Frame& F0) { const Frame F = launder(F0);
    const bf16* MG = WSP(bf16, OFF_MG); bf16* MERGED = WSP(bf16, OFF_MERGED);
    for (int it = F.bid; it < (NTOK / 128) * 8; it += F.G) {
        const int mt = it >> 3, nt = it & 7;
        f32x4 outv[4][2]; ACC_ZERO(outv);
#pragma unroll
        for (int src = 0; src < 3; ++src) {
            const bf16* A = src == 0 ? WSP(bf16, OFF_O) : src == 1 ? WSP(bf16, OFF_PM) : WSP(bf16, OFF_CV);
            const bf16* B = src == 0 ? WSP(bf16, OFF_WN) : src == 1 ? WSP(bf16, OFF_WP) : WSP(bf16, OFF_WC);
            const int K = src == 0 ? 512 : 256;
            f32x4 acc[4][2]; ACC_ZERO(acc);
            gemm_tile_128(acc, A + (size_t)mt * 128 * K, K, B + (size_t)nt * 128 * K, K, K, F.lds);
            const int tq = otid(), l = tq & 63, w = tq >> 6;
#pragma unroll
            for (int i = 0; i < 4; ++i)
#pragma unroll
                for (int j = 0; j < 2; ++j) { const int row = mt * 128 + (w >> 2) * 64 + i * 16 + (l & 15), col = nt * 128 + (w & 3) * 32 + j * 16 + (l >> 4) * 4;
                    outv[i][j] += ld4bf(MG + (size_t)row * 3072 + src * 1024 + col) * acc[i][j]; }
        }
        TILE_FOREACH(outv, mt * 128, nt * 128, { st4bf(MERGED + (size_t)ROW * 1024 + COL, V); });
    }
}
__device__ __forceinline__ void phase_wo(const Frame& F0) { const Frame F = launder(F0);
    const bf16* MERGED = WSP(bf16, OFF_MERGED);
    for (int it = F.bid; it < (NTOK / 128) * 8; it += F.G) {
        const int mt = it >> 3, nt = it & 7;
        f32x4 acc[4][2]; ACC_ZERO(acc);
        gemm_tile_128(acc, MERGED + (size_t)mt * 128 * 1024, 1024, WSP(bf16, OFF_WO) + (size_t)nt * 128 * 1024, 1024, 1024, F.lds);
        TILE_FOREACH(acc, mt * 128, nt * 128, { f32x4* p = (f32x4*)(F.out + (size_t)ROW * 1024 + COL); *p = *p + V; });
    }
}

__device__ __forceinline__ void phase_router(const Frame& F0, int l, int rep = 0) { const Frame F = launder(F0);
    LAS int* hist = (LAS int*)F.lds;
    if (F.tid < 32) hist[F.tid] = 0;
    __syncthreads();
    const float* g2 = INP(13) + (size_t)l * D; const float* wg = INP(14) + (size_t)l * D * 4; const float* bgp = INP(15) + (size_t)l * 4;
    const float* we = INP(16) + (size_t)l * D * 32; const float* be = INP(17) + (size_t)l * 32;
    bf16* xn = WSP(bf16, OFF_XN); int* toke = WSP(int, OFF_TOKE); float* tokc = WSP(float, OFF_TOKC);
    for (int n = F.bid * 8 + F.wave; n < NTOK; n += F.G * 8) {
        f32x4 v[4]; float ss = 0.f;
        const f32x4* hr = (const f32x4*)(F.out + (size_t)n * D) + F.lane;
#pragma unroll
        for (int j = 0; j < 4; ++j) { v[j] = hr[64 * j]; ss += (v[j].x * v[j].x + v[j].y * v[j].y) + (v[j].z * v[j].z + v[j].w * v[j].w); }
        const float rs = 1.f / sqrtf(wave_sum(ss) * (1.f / D) + RMS_EPS);
        float gl[4] = {0.f, 0.f, 0.f, 0.f};
#pragma unroll
        for (int j = 0; j < 4; ++j) {
            v[j] = v[j] * rs * ((const f32x4*)g2)[F.lane + 64 * j];
            st4bf(xn + (size_t)n * D + F.lane * 4 + 256 * j, v[j]);
#pragma unroll
            for (int q = 0; q < 4; ++q) {
                const int k = F.lane * 4 + 256 * j + q; const float x = v[j][q];
                const f32x4 w4 = *(const f32x4*)(wg + (size_t)k * 4);
                gl[0] += x * w4.x; gl[1] += x * w4.y; gl[2] += x * w4.z; gl[3] += x * w4.w;
            }
        }
        int gs = 0;
#pragma unroll
        for (int i = 0; i < 4; ++i) gl[i] = wave_sum(gl[i]) + bgp[i];
        float gm = gl[0];
#pragma unroll
        for (int i = 1; i < 4; ++i) if (gl[i] > gm) { gm = gl[i]; gs = i; }
        float gsum = 0.f;
#pragma unroll
        for (int i = 0; i < 4; ++i) gsum += __expf(gl[i] - gm);
        const float gp = 1.f / gsum;
        gs = __builtin_amdgcn_readfirstlane(gs);
        float el[8] = {0.f, 0.f, 0.f, 0.f, 0.f, 0.f, 0.f, 0.f};
#pragma unroll
        for (int j = 0; j < 4; ++j)
#pragma unroll
            for (int q = 0; q < 4; ++q) {
                const int k = F.lane * 4 + 256 * j + q; const float x = v[j][q];
                const f32x4 u0 = *(const f32x4*)(we + (size_t)k * 32 + gs * 8), u1 = *(const f32x4*)(we + (size_t)k * 32 + gs * 8 + 4);
                el[0] += x * u0.x; el[1] += x * u0.y; el[2] += x * u0.z; el[3] += x * u0.w; el[4] += x * u1.x; el[5] += x * u1.y; el[6] += x * u1.z; el[7] += x * u1.w;
            }
        float v0 = -INFINITY, v1 = -INFINITY; int i0 = 0, i1 = 0;
#pragma unroll
        for (int i = 0; i < 8; ++i) {
            const float ev = wave_sum(el[i]) + be[gs * 8 + i];
            if (ev > v0) { v1 = v0; i1 = i0; v0 = ev; i0 = i; } else if (ev > v1) { v1 = ev; i1 = i; }
        }
        const float e1 = __expf(v1 - v0), w0 = 1.f / (1.f + e1), w1 = e1 * w0;
        if (F.lane == 0) {
            const int ea = gs * 8 + i0, eb = gs * 8 + i1;
            toke[n * 2] = ea; toke[n * 2 + 1] = eb; tokc[n * 2] = w0 * gp; tokc[n * 2 + 1] = w1 * gp;
            __hip_atomic_fetch_add(&hist[ea], 1, __ATOMIC_RELAXED, __HIP_MEMORY_SCOPE_WORKGROUP); __hip_atomic_fetch_add(&hist[eb], 1, __ATOMIC_RELAXED, __HIP_MEMORY_SCOPE_WORKGROUP);
        }
    }
    __syncthreads();
    if (rep == 0 && F.tid < 32 && hist[F.tid]) __hip_atomic_fetch_add(F.ctl + CW_CNT + l * 32 + F.tid, (unsigned)hist[F.tid], __ATOMIC_RELAXED, __HIP_MEMORY_SCOPE_AGENT);
}


__device__ __forceinline__ float lane_lo(float x) { auto rr = __builtin_amdgcn_permlane32_swap(__float_as_uint(x), __float_as_uint(x), false, false); return __uint_as_float(rr[0]); }
__device__ __forceinline__ float lane_other(float x, int h) { auto rr = __builtin_amdgcn_permlane32_swap(__float_as_uint(x), __float_as_uint(x), false, false); return __uint_as_float(h ? rr[0] : rr[1]); }
__device__ __forceinline__ void phase_router_mfma(const Frame& F0, int l, int rep = 0) { const Frame F = launder(F0);
    LAS float* part = (LAS float*)F.lds;
    LAS float* rsv = part + 8 * 33 * 64;
    LAS int* hist = (LAS int*)(rsv + 64);
    if (F.tid < 32) hist[F.tid] = 0;
    __syncthreads();
    const int lane = F.lane, r32 = lane & 31, h = lane >> 5, wv = F.wave;
    const bf16* wrh = WSP(bf16, OFF_WR); const bf16* wrl = wrh + 64 * 1024;
    const float* g2 = INP(13) + (size_t)l * D; const float* bgp = INP(15) + (size_t)l * 4; const float* be = INP(17) + (size_t)l * 32;
    bf16* xn = WSP(bf16, OFF_XN); int* toke = WSP(int, OFF_TOKE); float* tokc = WSP(float, OFF_TOKC);
    typedef unsigned u32x4v __attribute__((ext_vector_type(4)));
    for (int tile = F.bid; tile < NTOK / 32; tile += F.G) {
        const int n = tile * 32 + r32;
        const float* xr = (const float*)F.out + (size_t)n * D + wv * 128 + 8 * h;
        f32x16 a1, a2;
#pragma unroll
        for (int i = 0; i < 16; ++i) { a1[i] = 0.f; a2[i] = 0.f; }
        float ss = 0.f;
#pragma unroll 4
        for (int ks = 0; ks < 8; ++ks) {
            const f32x4 x0 = *(const f32x4*)(xr + ks * 16), x1 = *(const f32x4*)(xr + ks * 16 + 4);
            ss += (x0.x * x0.x + x0.y * x0.y) + (x0.z * x0.z + x0.w * x0.w) + (x1.x * x1.x + x1.y * x1.y) + (x1.z * x1.z + x1.w * x1.w);
            u32x4v wh; wh.x = cvtpk(x0.x, x0.y); wh.y = cvtpk(x0.z, x0.w); wh.z = cvtpk(x1.x, x1.y); wh.w = cvtpk(x1.z, x1.w);
            u32x4v wl; wl.x = cvtpk(x0.x - bf2f(wh.x & 0xffffu), x0.y - __uint_as_float(wh.x & 0xffff0000u)); wl.y = cvtpk(x0.z - bf2f(wh.y & 0xffffu), x0.w - __uint_as_float(wh.y & 0xffff0000u));
            wl.z = cvtpk(x1.x - bf2f(wh.z & 0xffffu), x1.y - __uint_as_float(wh.z & 0xffff0000u)); wl.w = cvtpk(x1.z - bf2f(wh.w & 0xffffu), x1.w - __uint_as_float(wh.w & 0xffff0000u));
            const bf16x8 xh = __builtin_bit_cast(bf16x8, wh), xl = __builtin_bit_cast(bf16x8, wl);
            const size_t wo = (size_t)r32 * 1024 + wv * 128 + ks * 16 + 8 * h;
            const bf16x8 ah1 = *(const bf16x8*)(wrh + wo), al1 = *(const bf16x8*)(wrl + wo), ah2 = *(const bf16x8*)(wrh + 32 * 1024 + wo), al2 = *(const bf16x8*)(wrl + 32 * 1024 + wo);
            a1 = __builtin_amdgcn_mfma_f32_32x32x16_bf16(ah1, xh, a1, 0, 0, 0); a2 = __builtin_amdgcn_mfma_f32_32x32x16_bf16(ah2, xh, a2, 0, 0, 0);
            a1 = __builtin_amdgcn_mfma_f32_32x32x16_bf16(ah1, xl, a1, 0, 0, 0); a2 = __builtin_amdgcn_mfma_f32_32x32x16_bf16(ah2, xl, a2, 0, 0, 0);
            a1 = __builtin_amdgcn_mfma_f32_32x32x16_bf16(al1, xh, a1, 0, 0, 0); a2 = __builtin_amdgcn_mfma_f32_32x32x16_bf16(al2, xh, a2, 0, 0, 0);
        }
        {   LAS float* pp = part + (wv * 33) * 64 + lane;
#pragma unroll
            for (int i = 0; i < 16; ++i) pp[i * 64] = a1[i];
#pragma unroll
            for (int i = 0; i < 4; ++i) pp[(16 + i) * 64] = a2[i];
            pp[32 * 64] = ss; }
        __syncthreads();
        if (wv == 0) {
#pragma unroll
            for (int i = 0; i < 16; ++i) { float v = 0.f;
#pragma unroll
                for (int w = 0; w < 8; ++w) v += part[(w * 33 + i) * 64 + lane]; a1[i] = v; }
#pragma unroll
            for (int i = 0; i < 4; ++i) { float v = 0.f;
#pragma unroll
                for (int w = 0; w < 8; ++w) v += part[(w * 33 + 16 + i) * 64 + lane]; a2[i] = v; }
            ss = 0.f;
#pragma unroll
            for (int w = 0; w < 8; ++w) ss += part[(w * 33 + 32) * 64 + lane];
            const float rs = 1.f / sqrtf(psum32(ss) * (1.f / D) + RMS_EPS);
            if (h == 0) rsv[r32] = rs;
            float gl[4]; int gs = 0;
#pragma unroll
            for (int i = 0; i < 4; ++i) gl[i] = a2[i] * rs + bgp[i];
            float gm = gl[0];
#pragma unroll
            for (int i = 1; i < 4; ++i) if (gl[i] > gm) { gm = gl[i]; gs = i; }
            float gsum = 0.f;
#pragma unroll
            for (int i = 0; i < 4; ++i) gsum += __expf(gl[i] - gm);
            const float gp = lane_lo(1.f / gsum); gs = __float_as_int(lane_lo(__int_as_float(gs)));
            float c[4];
#pragma unroll
            for (int i = 0; i < 4; ++i) { const float v = (gs == 0) ? a1[i] : (gs == 1) ? a1[4 + i] : (gs == 2) ? a1[8 + i] : a1[12 + i]; c[i] = v * rs + be[gs * 8 + 4 * h + i]; }
            float v0 = -INFINITY, v1 = -INFINITY; int i0 = 0, i1 = 0;
#pragma unroll
            for (int i = 0; i < 4; ++i) { if (c[i] > v0) { v1 = v0; i1 = i0; v0 = c[i]; i0 = 4 * h + i; } else if (c[i] > v1) { v1 = c[i]; i1 = 4 * h + i; } }
            const float p0 = lane_other(v0, h), p1 = lane_other(v1, h); const int q0 = __float_as_int(lane_other(__int_as_float(i0), h)), q1 = __float_as_int(lane_other(__int_as_float(i1), h));
            const bool mine_first = (v0 > p0) || (v0 == p0 && i0 < q0);
            const float t0 = mine_first ? v0 : p0; const int e0 = mine_first ? i0 : q0;
            const float ca = mine_first ? p0 : v0; const int cia = mine_first ? q0 : i0;
            const float cb2 = mine_first ? v1 : p1; const int cib = mine_first ? i1 : q1;
            const bool a_second = (ca > cb2) || (ca == cb2 && cia < cib);
            const float t1 = a_second ? ca : cb2; const int e1 = a_second ? cia : cib;
            const float ex = __expf(t1 - t0), w0 = 1.f / (1.f + ex), w1 = ex * w0;
            if (h == 0) {
                const int ea = gs * 8 + e0, eb = gs * 8 + e1;
                toke[n * 2] = ea; toke[n * 2 + 1] = eb; tokc[n * 2] = w0 * gp; tokc[n * 2 + 1] = w1 * gp;
                __hip_atomic_fetch_add(&hist[ea], 1, __ATOMIC_RELAXED, __HIP_MEMORY_SCOPE_WORKGROUP); __hip_atomic_fetch_add(&hist[eb], 1, __ATOMIC_RELAXED, __HIP_MEMORY_SCOPE_WORKGROUP);
            }
        }
        __syncthreads();
        {   const float rs = rsv[r32];
#pragma unroll
            for (int ks = 0; ks < 8; ++ks) {
                const f32x4 x0 = *(const f32x4*)(xr + ks * 16), x1 = *(const f32x4*)(xr + ks * 16 + 4);
                const f32x4 g0 = *(const f32x4*)(g2 + wv * 128 + ks * 16 + 8 * h), g1 = *(const f32x4*)(g2 + wv * 128 + ks * 16 + 8 * h + 4);
                *(u32x4*)(xn + (size_t)n * D + wv * 128 + ks * 16 + 8 * h) = pg8::pack8(x0 * rs * g0, x1 * rs * g1);
            } }
    }
    __syncthreads();
    if (rep == 0 && F.tid < 32 && hist[F.tid]) __hip_atomic_fetch_add(F.ctl + CW_CNT + l * 32 + F.tid, (unsigned)hist[F.tid], __ATOMIC_RELAXED, __HIP_MEMORY_SCOPE_AGENT);
}

__device__ __forceinline__ void moe_offsets(const Frame& F, int l, LAS int* off) {
    if (F.tid < 64) {
        int c = 0;
        if (F.tid < NEXP) c = ((int)__hip_atomic_load(F.ctl + CW_CNT + l * 32 + F.tid, __ATOMIC_RELAXED, __HIP_MEMORY_SCOPE_AGENT) + 255) & ~255;
        int incl = c;
#pragma unroll
        for (int o = 1; o < 32; o <<= 1) { const int v = __shfl_up(incl, o); if ((F.tid & 63) >= o) incl += v; }
        if (F.tid < NEXP) off[F.tid] = incl - c;
        if (F.tid == NEXP - 1) off[NEXP] = incl;
    }
    __syncthreads();
}
__device__ __forceinline__ void phase_dispatch(const Frame& F0, int l, int rep = 0) { const Frame F = launder(F0);
    LAS int* off = (LAS int*)F.lds; LAS int* hist = off + 64; LAS int* base = hist + 32; LAS int* pslot = base + 32; LAS int* ptok = pslot + 512;
    moe_offsets(F, l, off);
    const int* toke = WSP(int, OFF_TOKE); const float* tokc = WSP(float, OFF_TOKC); int* toks = WSP(int, OFF_TOKS); float* slotc = WSP(float, OFF_SLOTC);
    const bf16* xn = WSP(bf16, OFF_XN); bf16* xg = WSP(bf16, OFF_XG);
    for (int ch = F.bid; ch < NTOK / 128; ch += F.G) {
        if (F.tid < 32) hist[F.tid] = 0;
        __syncthreads();
        const bool act = F.tid < 256;
        const int pr = ch * 256 + (act ? F.tid : 0), e = toke[pr];
        int r = 0;
        if (act) r = __hip_atomic_fetch_add(&hist[e], 1, __ATOMIC_RELAXED, __HIP_MEMORY_SCOPE_WORKGROUP);
        __syncthreads();
        if (F.tid < 32) base[F.tid] = hist[F.tid] ? (int)__hip_atomic_fetch_add(F.ctl + CW_CUR + (rep * DEPTH + l) * 32 + F.tid, (unsigned)hist[F.tid], __ATOMIC_RELAXED, __HIP_MEMORY_SCOPE_AGENT) : 0;
        __syncthreads();
        if (act) { const int slot = off[e] + base[e] + r; toks[pr] = slot; slotc[slot] = tokc[pr]; pslot[F.tid] = slot; ptok[F.tid] = pr >> 1; }
        __syncthreads();
        for (int i = F.wave * 4; i < 256; i += 32) {
            u32x4 v[4][2];
#pragma unroll
            for (int r4 = 0; r4 < 4; ++r4) { const u32x4* sp = (const u32x4*)(xn + (size_t)ptok[i + r4] * D) + F.lane; v[r4][0] = sp[0]; v[r4][1] = sp[64]; }
#pragma unroll
            for (int r4 = 0; r4 < 4; ++r4) { u32x4* dp = (u32x4*)(xg + (size_t)pslot[i + r4] * D) + F.lane; dp[0] = v[r4][0]; dp[64] = v[r4][1]; }
        }
        __syncthreads();
    }
}
__device__ __forceinline__ int moe_expert_of(const LAS int* off, int row) { int e = 0;
#pragma unroll 1
    for (int i = 1; i < NEXP; ++i) if (row >= off[i]) e = i;
    return e; }
__device__ __forceinline__ void phase_moe1(const Frame& F0, int l) { const Frame F = launder(F0);
    LAS int* off = (LAS int*)(F.lds + 32768); moe_offsets(F, l, off);
    const bf16* xg = WSP(bf16, OFF_XG); bf16* hmid = WSP(bf16, OFF_HMID);
    const int ntile = off[NEXP] / 128;
    for (int it = F.bid; it < ntile * 2; it += F.G) {
        const int rt = it >> 1, u = it & 1, e = moe_expert_of(off, rt * 128);
        const bf16* B = WSP(bf16, OFF_W13) + ((size_t)e * 512 + u * 256) * 1024;
        f32x4 a1[4][2], a3[4][2]; ACC_ZERO(a1); ACC_ZERO(a3);
        gemm_tile_128(a1, xg + (size_t)rt * 128 * 1024, 1024, B, 1024, 1024, F.lds);
        gemm_tile_128(a3, xg + (size_t)rt * 128 * 1024, 1024, B + (size_t)128 * 1024, 1024, 1024, F.lds);
#pragma unroll
        for (int i = 0; i < 4; ++i)
#pragma unroll
            for (int j = 0; j < 2; ++j) { const f32x4 x = a1[i][j], y = a3[i][j]; a1[i][j] = (f32x4){siluf(x.x) * y.x, siluf(x.y) * y.y, siluf(x.z) * y.z, siluf(x.w) * y.w}; }
        TILE_FOREACH(a1, rt * 128, u * 128, { st4bf(hmid + (size_t)ROW * 256 + COL, V); });
    }
}
__device__ __forceinline__ void phase_moe2(const Frame& F0, int l) { const Frame F = launder(F0);
    LAS int* off = (LAS int*)(F.lds + 32768); moe_offsets(F, l, off);
    const bf16* hmid = WSP(bf16, OFF_HMID); bf16* ys = WSP(bf16, OFF_YS); const float* slotc = WSP(float, OFF_SLOTC);
    const int ntile = off[NEXP] / 128;
    for (int it = F.bid; it < ntile * 8; it += F.G) {
        const int rt = it >> 3, ct = it & 7, e = moe_expert_of(off, rt * 128);
        f32x4 acc[4][2]; ACC_ZERO(acc);
        gemm_tile_128(acc, hmid + (size_t)rt * 128 * 256, 256, WSP(bf16, OFF_W2) + ((size_t)e * 1024 + ct * 128) * 256, 256, 256, F.lds);
        TILE_FOREACH(acc, rt * 128, ct * 128, { st4bf(ys + (size_t)ROW * 1024 + COL, V * slotc[ROW]); });
    }
}


#define LDSP (F.lds)
__device__ __forceinline__ void phase_inproj_pg8(const Frame& F0) { const Frame F = launder(F0);
    pg8::Gemm g{WSP(bf16, OFF_XN), WSP(bf16, OFF_WIN), D, D, D}; pg8::StaticOrder S; S.init(NTOK, INP, F.G, F.bid);
    pg8::EpiInproj E{(unsigned char*)F.ws};
    pg8::gemm_phase<pg8::EpiInproj, pg8::StaticOrder, true, true>(LDSP, g, S, E);
}
template <int SRC> __device__ __forceinline__ void phase_merge_pg8(const Frame& F0) { const Frame F = launder(F0);
    pg8::StaticOrder S; S.init(NTOK, D, F.G, F.bid);
    constexpr int K = SRC == 0 ? 512 : 256;
    pg8::Gemm g{WSP(bf16, SRC == 0 ? OFF_O : SRC == 1 ? OFF_PM : OFF_CV), WSP(bf16, SRC == 0 ? OFF_WN : SRC == 1 ? OFF_WP : OFF_WC), K, K, K};
    pg8::EpiMerge<SRC == 0> E{WSP(bf16, OFF_MERGED), WSP(unsigned char, OFF_MG) + SRC * 1024 * (GATE_U8 ? 1 : 2)};
    pg8::gemm_phase<pg8::EpiMerge<SRC == 0>, pg8::StaticOrder, true, true>(LDSP, g, S, E);
}
__device__ __forceinline__ void phase_cmp1_pg8(const Frame& F0) { const Frame F = launder(F0);
    pg8::Gemm g{WSP(bf16, OFF_KVC), WSP(bf16, OFF_CW1), 1024, 2048, 2048}; pg8::CmpOrder S{F.G, F.bid};
    pg8::EpiCmp1 E{WSP(bf16, OFF_HC), WSP(float, OFF_CB1)};
    pg8::gemm_phase<pg8::EpiCmp1, pg8::CmpOrder, true, true>(LDSP, g, S, E);
}
__device__ __forceinline__ void cmp2_tile(const Frame& F, int mt) {
    const bf16* HC = WSP(bf16, OFF_HC);
    const int plane = mt >> 3, s = plane & 1, bg = plane >> 1;
    f32x4 acc[4][2]; ACC_ZERO(acc);
    gemm_tile_128(acc, HC + (size_t)mt * 128 * 256, 256, WSP(bf16, OFF_CW2) + (size_t)s * 128 * 256, 256, 256, F.lds);
    bf16* dst = WSP(bf16, s == 0 ? OFF_KC : OFF_VC) + (size_t)bg * 1024 * 64;
    if (s == 1) {
        TILE_FOREACH(acc, (mt & 7) * 128, 0, { if (COL < 64) { f32x4 o = V; if (ROW == 1023) o = o * 0.f;
            bf16* vb = dst + (size_t)(ROW >> 6) * 4096 + vtile_off(ROW & 63, COL);
            vb[0] = (bf16)f2bf(o.x); vb[8] = (bf16)f2bf(o.y); vb[16] = (bf16)f2bf(o.z); vb[24] = (bf16)f2bf(o.w); } });
    } else {
        TILE_FOREACH(acc, (mt & 7) * 128, 0, { if (COL < 64) { f32x4 o = V; if (ROW == 1023) o = o * 0.f; st4bf(dst + (size_t)(ROW >> 6) * 4096 + ktile_off(ROW & 63, COL & ~7) + (COL & 7), o); } });
    }
}
__device__ __forceinline__ void phase_cmp12(const Frame& F0) { const Frame F = launder(F0);
    {   pg8::Gemm g{WSP(bf16, OFF_KVC), WSP(bf16, OFF_CW1), 1024, 2048, 2048}; pg8::CmpOrder S{F.G, F.bid};
        pg8::EpiCmp1 E{WSP(bf16, OFF_HC), WSP(float, OFF_CB1)};
        pg8::gemm_phase<pg8::EpiCmp1, pg8::CmpOrder, true, true>(LDSP, g, S, E); }
    asm volatile("s_waitcnt vmcnt(0)" ::: "memory");
    __syncthreads();
    for (int L = F.bid; L < 32; L += F.G) { cmp2_tile(F, 2 * L); cmp2_tile(F, 2 * L + 1); }
}
__device__ __forceinline__ void phase_wo_pg8(const Frame& F0) { const Frame F = launder(F0);
    pg8::Gemm g{WSP(bf16, OFF_MERGED), WSP(bf16, OFF_WO), D, D, D}; pg8::StaticOrder S; S.init(NTOK, D, F.G, F.bid);
    pg8::EpiWo E{(float*)F.out};
    pg8::gemm_phase<pg8::EpiWo, pg8::StaticOrder, true, true>(LDSP, g, S, E);
}
__device__ __forceinline__ void phase_moe1_pg8(const Frame& F0, int l) { const Frame F = launder(F0);
    LAS int* off = (LAS int*)(F.lds + pg8::STAGE_BYTES); moe_offsets(F, l, off);
    pg8::Gemm g{WSP(bf16, OFF_XG), WSP(bf16, OFF_W13), D, D, D}; pg8::MoeOrder S{(const LAS int*)(F.lds + pg8::STAGE_BYTES), 2, F.G, F.bid, (size_t)512 * 1024 * 2};
    pg8::EpiMoe1 E{WSP(bf16, OFF_HMID)};
    pg8::gemm_phase<pg8::EpiMoe1, pg8::MoeOrder, true, true>(LDSP, g, S, E);
}
__device__ __forceinline__ void phase_moe2_pg8(const Frame& F0, int l) { const Frame F = launder(F0);
    LAS int* off = (LAS int*)(F.lds + pg8::STAGE_BYTES); moe_offsets(F, l, off);
    pg8::Gemm g{WSP(bf16, OFF_HMID), WSP(bf16, OFF_W2), 256, 256, 256}; pg8::MoeOrder S{(const LAS int*)(F.lds + pg8::STAGE_BYTES), 4, F.G, F.bid, (size_t)1024 * 256 * 2};
    pg8::EpiMoe2 E{WSP(bf16, OFF_YS), WSP(float, OFF_SLOTC)};
    pg8::gemm_phase<pg8::EpiMoe2, pg8::MoeOrder, true, true>(LDSP, g, S, E);
}

constexpr int PPL = 11;
constexpr int NPHASE = DEPTH * PPL + 1;
__global__ void __launch_bounds__(512, 2) nsa_fwd(Args args) {
    extern __shared__ __attribute__((aligned(16))) unsigned char lds[];
    Frame F;
    F.lds = (LAS unsigned char*)lds; F.ws = (GAS unsigned char*)args.ws; F.ctl = (unsigned*)(args.ws + WS_CTL); F.out = (GAS float*)args.out;
    F.tid = threadIdx.x; F.lane = F.tid & 63; F.wave = __builtin_amdgcn_readfirstlane(F.tid >> 6); F.G = gridDim.x; F.bid = blockIdx.x;
    volatile LAS unsigned* MISC = (volatile LAS unsigned*)((LAS unsigned char*)lds + MISC_OFF);
    if (F.tid < 32) MISC[F.tid] = 0u;
    if (F.tid < 22) *(LAS unsigned long long*)((LAS unsigned char*)lds + MISC_OFF + 256 + F.tid * 8) = (unsigned long long)args.in[F.tid];
    __syncthreads();
    const int lo = args.ph_lo, hi = args.ph_hi;
    XcdBarrier bar; bar.bar = F.ctl + CW_BAR; bar.x = 0; bar.st = MISC + 8;
    if (hi - lo > 1) bar = xcd_barrier_post(F.ctl + CW_BAR, MISC + 8);
#ifndef ONLY
#define ONLY -1
#endif
#ifndef PMASK
#define PMASK 0xFFF
#endif
#define IN(k) (lo <= (k) && (k) < hi && ((PMASK >> ((k) == DEPTH * PPL ? 11 : (k) % PPL)) & 1))
#ifndef PROBE_DUP
#define PROBE_DUP 0
#endif
#define DUP(k) (((PROBE_DUP >> (k)) & 1) ? 2 : 1)
#define SEAM(k) do { if (IN(k) && IN((k) + 1)) xcd_barrier(bar); else __syncthreads(); } while (0)
#pragma unroll 1
    for (int l = 0; l < DEPTH; ++l) {
        const int p0 = l * PPL;
        if (IN(p0 + 0)) { for (int rep = 0; rep < DUP(0); ++rep) { phase_weights(F, l); if (rep + 1 < DUP(0)) xcd_barrier(bar); } phase_norm<false>(F, l, INP(1) + (size_t)l * D); } SEAM(p0 + 0);
        if (IN(p0 + 1)) { for (int rep = 0; rep < DUP(1); ++rep) { if (USE_PG8 & 1) phase_inproj_pg8(F); else phase_inproj(F); if (rep + 1 < DUP(1)) xcd_barrier(bar); } } SEAM(p0 + 1);
        if (IN(p0 + 2)) { for (int rep = 0; rep < DUP(2); ++rep) { phase_cmp12(F); __syncthreads(); phase_poolconv(F, l, 32); if (rep + 1 < DUP(2)) xcd_barrier(bar); } } SEAM(p0 + 2);
        if (IN(p0 + 4)) { for (int rep = 0; rep < DUP(4); ++rep) { if (ATTN_MFMA) phase_attn_mfma(F); else phase_attn_valu(F); if (rep + 1 < DUP(4)) xcd_barrier(bar); } } SEAM(p0 + 4);
        if (IN(p0 + 5)) { for (int rep = 0; rep < DUP(5); ++rep) { if (USE_PG8 & 2) { phase_merge_pg8<0>(F); phase_merge_pg8<1>(F); phase_merge_pg8<2>(F); } else phase_merge(F); if (rep + 1 < DUP(5)) xcd_barrier(bar); } } SEAM(p0 + 5);
        if (IN(p0 + 6)) { for (int rep = 0; rep < DUP(6); ++rep) { if (USE_PG8 & 4) phase_wo_pg8(F); else phase_wo(F); if (rep + 1 < DUP(6)) xcd_barrier(bar); } } SEAM(p0 + 6);
        if (IN(p0 + 7)) { for (int rep = 0; rep < DUP(7); ++rep) { if (ROUTER_MFMA) phase_router_mfma(F, l, rep); else phase_router(F, l, rep); if (rep + 1 < DUP(7)) xcd_barrier(bar); } } SEAM(p0 + 7);
        if (IN(p0 + 8)) { for (int rep = 0; rep < DUP(8); ++rep) { phase_dispatch(F, l, rep); if (rep + 1 < DUP(8)) xcd_barrier(bar); } } SEAM(p0 + 8);
        if (IN(p0 + 9)) { for (int rep = 0; rep < DUP(9); ++rep) { if (USE_PG8 & 8) phase_moe1_pg8(F, l); else phase_moe1(F, l); if (rep + 1 < DUP(9)) xcd_barrier(bar); } } SEAM(p0 + 9);
        if (IN(p0 + 10)) { for (int rep = 0; rep < DUP(10); ++rep) { if (USE_PG8 & 16) phase_moe2_pg8(F, l); else phase_moe2(F, l); if (rep + 1 < DUP(10)) xcd_barrier(bar); } } SEAM(p0 + 10);
    }
    if (IN(DEPTH * PPL)) phase_norm<true>(F, DEPTH, INP(21));
#undef IN
#undef SEAM
}

extern "C" void kernel_launch(void* const* d_in, const int* in_sizes, int n_in, void* d_out, int out_size, void* d_ws, size_t ws_size, hipStream_t stream) {
    static int grid = 0;
    if (grid == 0) {
        if (n_in != 22 || out_size != NTOK * D || ws_size < WS_END) { fprintf(stderr, "kernel_launch: unexpected shapes (n_in %d out %d ws %zu, need %zu)\n", n_in, out_size, ws_size, (size_t)WS_END); grid = -1; return; }
        int dev = 0, cus = 0;
        if (hipGetDevice(&dev) != hipSuccess || hipDeviceGetAttribute(&cus, hipDeviceAttributeMultiprocessorCount, dev) != hipSuccess) { grid = -1; return; }
        if (hipFuncSetAttribute((const void*)nsa_fwd, hipFuncAttributeMaxDynamicSharedMemorySize, LDS_BYTES) != hipSuccess) { fprintf(stderr, "kernel_launch: hipFuncSetAttribute failed\n"); grid = -1; return; }
        int per_cu = 0;
        if (hipOccupancyMaxActiveBlocksPerMultiprocessor(&per_cu, (const void*)nsa_fwd, 512, LDS_BYTES) != hipSuccess || per_cu < 1) fprintf(stderr, "kernel_launch: occupancy query says %d\n", per_cu);
        (void)hipGetLastError();
        grid = cus;
    }
    if (grid < 0) return;
    (void)hipMemsetAsync((char*)d_ws + WS_CTL, 0, CTL_BYTES, stream);
    Args a{};
    for (int i = 0; i < 22; ++i) a.in[i] = (const float*)d_in[i];
    a.out = (float*)d_out; a.ws = (unsigned char*)d_ws;
#if MK_PER_PHASE
    for (int p = 0; p < NPHASE; ++p) { a.ph_lo = p; a.ph_hi = p + 1; hipLaunchKernelGGL(nsa_fwd, dim3(grid), dim3(512), LDS_BYTES, stream, a); }
#else
    a.ph_lo = 0; a.ph_hi = NPHASE;
    hipLaunchKernelGGL(nsa_fwd, dim3(grid), dim3(512), LDS_BYTES, stream, a);
#endif
}
```
